# Optimizing an MI355X kernel written in HIP

```python
import jax, jax.numpy as jnp
from jax import lax
import numpy as np

D_MODEL = 1024
BATCH = 32
SEQ = 2048
DEPTH = 4

N_MIXERS = 2
N_LAYERS_A = (DEPTH + 1) // 2
N_LAYERS_B = DEPTH // 2
D_FF = 4 * D_MODEL
EPS = 1e-6
CHUNK = 128
A_WIDTH = 2 * D_MODEL
A_GROUPS = 8
A_GROUP_DIM = A_WIDTH // A_GROUPS
B_HEADS = 16
B_HEAD_DIM = D_MODEL // B_HEADS
Q_BLOCK = 128

kernel_name = "hybrid_gmlp_stickbreaking_trunk"


def rms_norm(x, g):
    xf = x.astype(jnp.float32)
    y = xf * lax.rsqrt(jnp.mean(xf * xf, axis=-1, keepdims=True) + EPS)
    return (y * g.astype(jnp.float32)).astype(x.dtype)


def layer_norm(x, g, b):
    xf = x.astype(jnp.float32)
    mu = jnp.mean(xf, axis=-1, keepdims=True)
    xc = xf - mu
    y = xc * lax.rsqrt(jnp.mean(xc * xc, axis=-1, keepdims=True) + EPS)
    return (y * g.astype(jnp.float32) + b.astype(jnp.float32)).astype(x.dtype)


def chunked_gmlp(x, w_in, v_g, v_b, w_s, b_s, w_out):
    bn, s, _ = x.shape
    z = jax.nn.gelu(x @ w_in, approximate=False)
    u, v = jnp.split(z, 2, axis=-1)
    v = layer_norm(v, v_g, v_b)
    nc = s // CHUNK
    v = v.reshape(bn, nc, CHUNK, A_GROUPS, A_GROUP_DIM)
    causal = jnp.tril(jnp.ones((CHUNK, CHUNK), dtype=bool))
    w_causal = jnp.where(causal[None], w_s, jnp.zeros_like(w_s)).astype(v.dtype)
    mixed = jnp.einsum('gts,bcsgd->bctgd', w_causal, v)
    mixed = mixed + b_s.T.astype(v.dtype)[None, None, :, :, None]
    gated = u * mixed.reshape(bn, s, A_WIDTH)
    return gated @ w_out


def stick_breaking_attention(x, w_qkv, w_out):
    bn, s, _ = x.shape
    qkv = (x @ w_qkv).reshape(bn, s, 3, B_HEADS, B_HEAD_DIM)
    q, k, v = qkv[:, :, 0], qkv[:, :, 1], qkv[:, :, 2]
    scale = B_HEAD_DIM ** -0.5
    outs = []
    for blk in range(s // Q_BLOCK):
        q0 = blk * Q_BLOCK
        kv_len = q0 + Q_BLOCK
        qb = q[:, q0:kv_len]
        kb = k[:, :kv_len]
        vb = v[:, :kv_len]
        z = jnp.einsum('bthd,bshd->bhts', qb, kb).astype(jnp.float32) * scale
        t_pos = q0 + jnp.arange(Q_BLOCK)[:, None]
        s_pos = jnp.arange(kv_len)[None, :]
        causal = s_pos < t_pos
        log_keep = jnp.where(causal, jax.nn.log_sigmoid(-z), 0.0)
        survive = lax.cumsum(log_keep, axis=log_keep.ndim - 1, reverse=True) - log_keep
        log_a = jax.nn.log_sigmoid(z) + survive
        a = jnp.where(causal, jnp.exp(log_a), 0.0)
        outs.append(jnp.einsum('bhts,bshd->bthd', a.astype(vb.dtype), vb))
    o = jnp.concatenate(outs, axis=1).reshape(bn, s, D_MODEL)
    return o @ w_out


def squared_relu_mlp(x, w1, w2):
    return jnp.square(jax.nn.relu(x @ w1)) @ w2


def setup_inputs(seed: int = 0) -> dict:
    key = jax.random.key(seed)
    ks = jax.random.split(key, 16)
    f32 = jnp.float32

    def nrm(k, shape, scale):
        return jax.random.normal(k, shape, f32) * scale

    x = jax.random.normal(ks[0], (BATCH, SEQ, D_MODEL), f32)
    norm_mix_pre = 1.0 + nrm(ks[1], (DEPTH, D_MODEL), 0.02)
    norm_mix_post = 1.0 + nrm(ks[2], (DEPTH, D_MODEL), 0.02)
    norm_ffn_pre = 1.0 + nrm(ks[3], (DEPTH, D_MODEL), 0.02)
    norm_ffn_post = 1.0 + nrm(ks[4], (DEPTH, D_MODEL), 0.02)
    a_w_in = nrm(ks[5], (N_LAYERS_A, D_MODEL, 2 * A_WIDTH), D_MODEL ** -0.5)
    a_v_g = 1.0 + nrm(ks[6], (N_LAYERS_A, A_WIDTH), 0.02)
    a_v_b = nrm(ks[7], (N_LAYERS_A, A_WIDTH), 0.02)
    a_w_s = nrm(ks[8], (N_LAYERS_A, A_GROUPS, CHUNK, CHUNK), CHUNK ** -0.5)
    a_b_s = 1.0 + nrm(ks[9], (N_LAYERS_A, A_GROUPS, CHUNK), 0.01)
    a_w_out = nrm(ks[10], (N_LAYERS_A, A_WIDTH, D_MODEL), A_WIDTH ** -0.5)
    b_w_qkv = nrm(ks[11], (N_LAYERS_B, D_MODEL, 3 * D_MODEL), D_MODEL ** -0.5)
    b_w_out = nrm(ks[12], (N_LAYERS_B, D_MODEL, D_MODEL), D_MODEL ** -0.5)
    mlp_w1 = nrm(ks[13], (DEPTH, D_MODEL, D_FF), D_MODEL ** -0.5)
    mlp_w2 = nrm(ks[14], (DEPTH, D_FF, D_MODEL), D_FF ** -0.5)
    return {"x": x, "norm_mix_pre": norm_mix_pre, "norm_mix_post": norm_mix_post,
            "norm_ffn_pre": norm_ffn_pre, "norm_ffn_post": norm_ffn_post,
            "a_w_in": a_w_in, "a_v_g": a_v_g, "a_v_b": a_v_b, "a_w_s": a_w_s,
            "a_b_s": a_b_s, "a_w_out": a_w_out, "b_w_qkv": b_w_qkv, "b_w_out": b_w_out,
            "mlp_w1": mlp_w1, "mlp_w2": mlp_w2}


def reference(x, norm_mix_pre, norm_mix_post, norm_ffn_pre, norm_ffn_post,
              a_w_in, a_v_g, a_v_b, a_w_s, a_b_s, a_w_out,
              b_w_qkv, b_w_out, mlp_w1, mlp_w2):
    for i in range(DEPTH):
        h = rms_norm(x, norm_mix_pre[i])
        j = i // N_MIXERS
        if i % N_MIXERS == 0:
            m = chunked_gmlp(h, a_w_in[j], a_v_g[j], a_v_b[j], a_w_s[j], a_b_s[j], a_w_out[j])
        else:
            m = stick_breaking_attention(h, b_w_qkv[j], b_w_out[j])
        x = x + rms_norm(m, norm_mix_post[i])
        h = rms_norm(x, norm_ffn_pre[i])
        f = squared_relu_mlp(h, mlp_w1[i], mlp_w2[i])
        x = x + rms_norm(f, norm_ffn_post[i])
    return x
```

```cpp
#include <hip/hip_runtime.h>
#include <hip/hip_cooperative_groups.h>
#include <cstdio>
#include <cstdint>
namespace cg = cooperative_groups;

namespace pg8 {
#define PG8_LAS __attribute__((address_space(3)))
typedef unsigned short bf16_t;
typedef short bf16x8 __attribute__((ext_vector_type(8)));
typedef float f32x4 __attribute__((ext_vector_type(4)));
typedef unsigned u32x4 __attribute__((ext_vector_type(4)));
constexpr int BM = 256, BK = 64, HALF = 128, HTB = HALF * BK * 2  , STAGE_BYTES = 8 * HTB, NXCD = 8, WGM = 8;

__host__ __device__ __forceinline__ int lds_byte(int r, int c) { const int st = (r >> 4) * 2 + (c >> 5), rr = r & 15, cc = c & 31, ob = rr * 64 + cc * 2; return st * 1024 + (ob ^ (((ob >> 9) & 1) << 5)); }
__host__ __device__ __forceinline__ void stage_rc(int b, int& R, int& C) { const int st = b / 1024, sb = b % 1024, swz = sb ^ (((sb >> 9) & 1) << 5); R = (st >> 1) * 16 + swz / 64; C = (st & 1) * 32 + (swz % 64) / 2; }
__host__ __device__ __forceinline__ int perm32(int rho) { const int n = rho >> 4, i = rho & 15; return 8 * (i >> 2) + 4 * n + (i & 3); }

struct Unit { int pm, pn; };
struct Gemm { const bf16_t* A; const bf16_t* Bt; int M, N, K, lda; };

struct StaticOrder {
    int nM, nN, nwg, G, c;
    __host__ __device__ void init(int M, int N, int G_, int c_) { nM = M / BM; nN = N / BM; nwg = nM * nN; G = G_; c = c_; }
    __host__ __device__ bool next(int i, Unit& u) const {
        const long L = (long)i * G + c; if (L >= nwg) return false;
        int wgid = (int)L; { const int q = nwg / NXCD, r = nwg % NXCD, xcd = wgid % NXCD, off = wgid / NXCD; wgid = (xcd < r ? xcd * (q + 1) : r * (q + 1) + (xcd - r) * q) + off; }
        const int nig = WGM * nN, gid = wgid / nig, fm = gid * WGM, gsz = (nM - fm) < WGM ? (nM - fm) : WGM;
        u.pm = fm + ((wgid % nig) % gsz); u.pn = (wgid % nig) / gsz; return true;
    }
    __device__ __forceinline__ void a_ready(const Unit&) const {}
    __device__ __forceinline__ void done(const Unit&) const {}
};

__device__ __forceinline__ unsigned cvt_pk_bf16(float lo, float hi) { unsigned r; asm volatile("v_cvt_pk_bf16_f32 %0, %1, %2" : "=v"(r) : "v"(lo), "v"(hi)); return r; }
typedef float f32x2 __attribute__((ext_vector_type(2)));
__device__ __forceinline__ f32x2 gelu_pk(f32x2 v) {
    const f32x2 av = __builtin_elementwise_abs(v), d = av * 0.2316418882f + 1.0f;
    f32x2 t; t.x = __builtin_amdgcn_rcpf(d.x); t.y = __builtin_amdgcn_rcpf(d.y);
    f32x2 q = t * 0.5307027145f + (-0.7265760135f); q = q * t + 0.7107068705f; q = q * t + (-0.142248368f); q = q * t + 0.127414796f; q = q * t;
    const f32x2 s = (v * v) * (-0.72134752044f);
    f32x2 e; e.x = __builtin_amdgcn_exp2f(s.x); e.y = __builtin_amdgcn_exp2f(s.y);
    const f32x2 m = v * (q * e), r = v - m;
    f32x2 o; o.x = v.x < 0.f ? m.x : r.x; o.y = v.y < 0.f ? m.y : r.y; return o;
}

template <int ACT  > struct EpiBf16 {
    static constexpr bool PERM = true, AFTER_DRAIN = false; static_assert(ACT == 0 || ACT == 1, "EpiBf16: ACT is 0 (none) or 1 (gelu_pk)");
    bf16_t* O; int ldc; const float* bias; int split_cols; size_t split_stride; float scale0;
    __device__ __forceinline__ void operator()(const f32x4 (&acc)[2][2][4][2], const Unit& u, int wr, int wc, int fr, int fq) const {
        const int row0 = u.pm * BM + wr * 64 + fr; int colt = u.pn * BM; bf16_t* base = O;
        float sc = 1.f; if (split_cols) { const int t = colt / split_cols; base += (size_t)t * split_stride; colt -= t * split_cols; if (t == 0) sc = scale0; }
        const int col0 = colt + wc * 32 + 8 * fq, bcol0 = u.pn * BM + wc * 32 + 8 * fq;
        f32x4 bv[2][2];
#pragma unroll
        for (int bj = 0; bj < 2; ++bj)
#pragma unroll
            for (int n = 0; n < 2; ++n) bv[bj][n] = bias ? *(const f32x4*)(bias + bcol0 + bj * HALF + 4 * n) : (f32x4){0.f, 0.f, 0.f, 0.f};
#pragma unroll
        for (int ai = 0; ai < 2; ++ai)
#pragma unroll
            for (int m = 0; m < 4; ++m) { bf16_t* rowp = base + (size_t)(row0 + ai * HALF + m * 16) * ldc + col0;
#pragma unroll
                for (int bj = 0; bj < 2; ++bj) { f32x4 v0 = acc[ai][bj][m][0] + bv[bj][0], v1 = acc[ai][bj][m][1] + bv[bj][1];
                    if (ACT == 1) { f32x2 a = gelu_pk((f32x2){v0[0], v0[1]}), b = gelu_pk((f32x2){v0[2], v0[3]}), c = gelu_pk((f32x2){v1[0], v1[1]}), d = gelu_pk((f32x2){v1[2], v1[3]});
                        v0 = (f32x4){a.x, a.y, b.x, b.y}; v1 = (f32x4){c.x, c.y, d.x, d.y}; }
                    v0 = v0 * sc; v1 = v1 * sc; u32x4 w; w.x = cvt_pk_bf16(v0[0], v0[1]); w.y = cvt_pk_bf16(v0[2], v0[3]); w.z = cvt_pk_bf16(v1[0], v1[1]); w.w = cvt_pk_bf16(v1[2], v1[3]);
                    *(u32x4*)(rowp + bj * HALF) = w; } }
    }
};
template <class Epi, class Sched, bool ALIGN_EPI = false, bool SP2 = false>
__device__ __forceinline__ void gemm_phase(PG8_LAS unsigned char* lds, const Gemm g, const Sched& S, const Epi& E) {
    int tid = threadIdx.x; asm volatile("" : "+v"(tid));
    const int wid = __builtin_amdgcn_readfirstlane(tid >> 6), lane = tid & 63, wr = wid >> 2, wc = wid & 3, fr = lane & 15, fq = lane >> 4;
    const int K = g.K, nt = K / BK;
    unsigned voffA[2], voffB[2];
#pragma unroll
    for (int i = 0; i < 2; ++i) { int R, C; stage_rc(tid * 16 + i * 8192, R, C); const int Rb = Epi::PERM ? ((R & ~31) + perm32(R & 31)) : R;
        voffA[i] = (unsigned)(R * g.lda + C) * 2u; voffB[i] = (unsigned)(Rb * K + C) * 2u; }
    const size_t kstep = (size_t)(BK * 2);
    const size_t hstepA = (size_t)HALF * g.lda * 2, hstepB = (size_t)HALF * K * 2;
    const size_t tstepA = 2 * hstepA, tstepB = 2 * hstepB;
    const unsigned ldsw = (unsigned)wid * 1024u;
    const int aoff = lds_byte(wr * 64 + fr, fq * 8), boff = lds_byte(wc * 32 + fr, fq * 8);
#define PG8_SA(b, h) (((b) * 2 + (h)) * HTB)
#define PG8_SB(b, h) ((4 + (b) * 2 + (h)) * HTB)
#define PG8_STAGE(bufoff, gbase, voff) do { _Pragma("unroll") for (int _i = 0; _i < 2; ++_i) \
        __builtin_amdgcn_global_load_lds((const unsigned*)((const char*)(gbase) + (voff)[_i]), (PG8_LAS unsigned*)(lds + (bufoff) + ldsw + _i * 8192), 16, 0, 0); } while (0)
#define PG8_LDA(dst, b, h) do { _Pragma("unroll") for (int m = 0; m < 4; ++m) _Pragma("unroll") for (int k = 0; k < 2; ++k) dst[m][k] = *(const PG8_LAS bf16x8*)(lds + PG8_SA(b, h) + aoff + m * 2048 + k * 1024); } while (0)
#define PG8_LDB(dst, b, h) do { _Pragma("unroll") for (int n = 0; n < 2; ++n) _Pragma("unroll") for (int k = 0; k < 2; ++k) dst[n][k] = *(const PG8_LAS bf16x8*)(lds + PG8_SB(b, h) + boff + n * 2048 + k * 1024); } while (0)
#define PG8_MMA(ai, bj, At, Bt) do { __builtin_amdgcn_s_setprio(1); _Pragma("unroll") for (int m = 0; m < 4; ++m) _Pragma("unroll") for (int n = 0; n < 2; ++n) _Pragma("unroll") for (int k = 0; k < 2; ++k) \
        acc[ai][bj][m][n] = __builtin_amdgcn_mfma_f32_16x16x32_bf16(Bt[n][k], At[m][k], acc[ai][bj][m][n], 0, 0, 0); __builtin_amdgcn_s_setprio(0); } while (0)
#define PG8_WAIT_V(n) asm volatile("s_waitcnt vmcnt(" #n ")" ::: "memory")
#define PG8_WAIT_L(n) asm volatile("s_waitcnt lgkmcnt(" #n ")" ::: "memory")
#define PG8_BAR __builtin_amdgcn_s_barrier()
#define PG8_SCHED __builtin_amdgcn_sched_barrier(0)
    Unit cur, nxt; int ui = 0;
    if (!S.next(0, cur)) return;
    f32x4 acc[2][2][4][2];
#pragma unroll
    for (int a = 0; a < 2; ++a)
#pragma unroll
        for (int b = 0; b < 2; ++b)
#pragma unroll
            for (int m = 0; m < 4; ++m)
#pragma unroll
                for (int n = 0; n < 2; ++n) acc[a][b][m][n] = (f32x4){0.f, 0.f, 0.f, 0.f};
    bf16x8 At[4][2], B0[2][2], B1[2][2];
    float epre[8];
    const char* cA = (const char*)g.A + (size_t)cur.pm * tstepA; const char* cB = (const char*)g.Bt + (size_t)cur.pn * tstepB;
    S.a_ready(cur);
    if constexpr (SP2) {
        PG8_STAGE(PG8_SB(0, 0), cB, voffB); PG8_STAGE(PG8_SB(0, 1), cB + hstepB, voffB); PG8_STAGE(PG8_SA(0, 0), cA, voffA); PG8_STAGE(PG8_SA(0, 1), cA + hstepA, voffA);
        if (wr == 1) PG8_BAR;
        PG8_WAIT_V(2); PG8_BAR;
        PG8_STAGE(PG8_SB(1, 0), cB + kstep, voffB); PG8_STAGE(PG8_SA(1, 0), cA + kstep, voffA); PG8_STAGE(PG8_SB(1, 1), cB + hstepB + kstep, voffB);
        PG8_WAIT_V(6); PG8_BAR;
    } else {
        PG8_STAGE(PG8_SB(0, 0), cB, voffB); PG8_STAGE(PG8_SA(0, 0), cA, voffA); PG8_STAGE(PG8_SB(0, 1), cB + hstepB, voffB); PG8_STAGE(PG8_SA(0, 1), cA + hstepA, voffA);
        if (wr == 1) PG8_BAR;
        PG8_WAIT_V(4); PG8_BAR;
        PG8_STAGE(PG8_SB(1, 0), cB + kstep, voffB); PG8_STAGE(PG8_SA(1, 0), cA + kstep, voffA); PG8_STAGE(PG8_SB(1, 1), cB + hstepB + kstep, voffB);
        PG8_WAIT_V(6); PG8_BAR;
    }
    for (;;) {
        const bool has_next = S.next(ui + 1, nxt);
        const char* nA = has_next ? (const char*)g.A + (size_t)nxt.pm * tstepA : cA; const char* nB = has_next ? (const char*)g.Bt + (size_t)nxt.pn * tstepB : cB;
        for (int t = 0; t < nt; t += 2) {
            const bool last = (t == nt - 2);
            const char* a1 = cA + (size_t)(t + 1) * kstep;
            const char* a2 = last ? nA : cA + (size_t)(t + 2) * kstep; const char* b2 = last ? nB : cB + (size_t)(t + 2) * kstep;
            const char* a3 = a2 + kstep; const char* b3 = b2 + kstep;
            if (last && has_next) S.a_ready(nxt);
            if (last) E.prefetch(epre, cur, wr, fr);
            if constexpr (SP2) {
            PG8_LDB(B0, 0, 0); PG8_LDB(B1, 0, 1); PG8_SCHED; PG8_LDA(At, 0, 0); PG8_STAGE(PG8_SA(1, 1), a1 + hstepA, voffA);
            PG8_WAIT_V(8); PG8_WAIT_L(0); PG8_BAR; PG8_MMA(0, 0, At, B0); PG8_MMA(0, 1, At, B1); PG8_BAR; PG8_SCHED;
            PG8_LDA(At, 0, 1); PG8_STAGE(PG8_SB(0, 0), b2, voffB); PG8_STAGE(PG8_SB(0, 1), b2 + hstepB, voffB); PG8_STAGE(PG8_SA(0, 0), a2, voffA);
            PG8_WAIT_V(8); PG8_WAIT_L(0); PG8_BAR; PG8_MMA(1, 0, At, B0); PG8_MMA(1, 1, At, B1); PG8_BAR; PG8_SCHED;
            PG8_LDB(B0, 1, 0); PG8_LDB(B1, 1, 1); PG8_SCHED; PG8_LDA(At, 1, 0); PG8_STAGE(PG8_SA(0, 1), a2 + hstepA, voffA);
            PG8_WAIT_V(8); PG8_WAIT_L(0); PG8_BAR; PG8_MMA(0, 0, At, B0); PG8_MMA(0, 1, At, B1); PG8_BAR; PG8_SCHED;
            PG8_LDA(At, 1, 1); PG8_STAGE(PG8_SB(1, 0), b3, voffB); PG8_STAGE(PG8_SB(1, 1), b3 + hstepB, voffB); PG8_STAGE(PG8_SA(1, 0), a3, voffA);
            PG8_WAIT_V(8); PG8_WAIT_L(0); PG8_BAR; PG8_MMA(1, 0, At, B0); PG8_MMA(1, 1, At, B1); PG8_BAR; PG8_SCHED;
            } else {
            PG8_LDB(B0, 0, 0); PG8_SCHED; PG8_LDA(At, 0, 0); PG8_STAGE(PG8_SA(1, 1), a1 + hstepA, voffA);
            PG8_WAIT_L(8); PG8_BAR; PG8_WAIT_L(0); PG8_MMA(0, 0, At, B0); PG8_BAR; PG8_SCHED;
            PG8_LDB(B1, 0, 1); PG8_STAGE(PG8_SB(0, 0), b2, voffB);
            PG8_BAR; PG8_WAIT_L(0); PG8_MMA(0, 1, At, B1); PG8_BAR;
            PG8_LDA(At, 0, 1); PG8_STAGE(PG8_SA(0, 0), a2, voffA);
            PG8_BAR; PG8_WAIT_L(0); PG8_MMA(1, 0, At, B0); PG8_BAR; PG8_SCHED;
            PG8_STAGE(PG8_SB(0, 1), b2 + hstepB, voffB);
            PG8_WAIT_V(6); PG8_BAR; PG8_MMA(1, 1, At, B1); PG8_BAR;
            PG8_LDB(B0, 1, 0); PG8_SCHED; PG8_LDA(At, 1, 0); PG8_STAGE(PG8_SA(0, 1), a2 + hstepA, voffA);
            PG8_WAIT_L(8); PG8_BAR; PG8_WAIT_L(0); PG8_MMA(0, 0, At, B0); PG8_BAR; PG8_SCHED;
            PG8_LDB(B1, 1, 1); PG8_STAGE(PG8_SB(1, 0), b3, voffB);
            PG8_BAR; PG8_WAIT_L(0); PG8_MMA(0, 1, At, B1); PG8_BAR;
            PG8_LDA(At, 1, 1); PG8_STAGE(PG8_SA(1, 0), a3, voffA);
            PG8_BAR; PG8_WAIT_L(0); PG8_MMA(1, 0, At, B0); PG8_BAR; PG8_SCHED;
            PG8_STAGE(PG8_SB(1, 1), b3 + hstepB, voffB);
            PG8_WAIT_V(6); PG8_BAR; PG8_MMA(1, 1, At, B1); PG8_BAR;
            }
        }
        if constexpr (ALIGN_EPI) { if (wr == 0) PG8_BAR; }
        if constexpr (!Epi::AFTER_DRAIN) { E(acc, cur, wr, wc, fr, fq, epre); S.done(cur); }
        if (!has_next) break;
#pragma unroll
        for (int a = 0; a < 2; ++a)
#pragma unroll
            for (int b = 0; b < 2; ++b)
#pragma unroll
                for (int m = 0; m < 4; ++m)
#pragma unroll
                    for (int n = 0; n < 2; ++n) acc[a][b][m][n] = (f32x4){0.f, 0.f, 0.f, 0.f};
        cur = nxt; cA = nA; cB = nB; ++ui;
        if constexpr (ALIGN_EPI) { if (wr == 1) PG8_BAR; }
    }
    PG8_WAIT_V(0);
    if constexpr (!ALIGN_EPI) { if (wr == 0) PG8_BAR; }
    PG8_BAR;
    if constexpr (Epi::AFTER_DRAIN) { E.fused(acc, cur, wr, wc, fr, fq, lds, wid, lane); S.done(cur); }
#undef PG8_SA
#undef PG8_SB
#undef PG8_STAGE
#undef PG8_LDA
#undef PG8_LDB
#undef PG8_MMA
#undef PG8_WAIT_V
#undef PG8_WAIT_L
#undef PG8_BAR
#undef PG8_SCHED
}
}

#define LAS __attribute__((address_space(3)))
typedef unsigned short bf16;
typedef short bf16x8 __attribute__((ext_vector_type(8)));
typedef float f32x4 __attribute__((ext_vector_type(4)));
typedef float f32x16 __attribute__((ext_vector_type(16)));
typedef unsigned u32x4 __attribute__((ext_vector_type(4)));
typedef unsigned u32x2 __attribute__((ext_vector_type(2)));
typedef short v4i16_t __attribute__((ext_vector_type(4)));
typedef float f32x2_t __attribute__((ext_vector_type(2)));
typedef __bf16 bf16x2_t __attribute__((ext_vector_type(2)));

constexpr int D_MODEL = 1024, BATCH = 32, SEQ = 2048, DEPTH = 4, MTOK = BATCH * SEQ, D_FF = 4096, A_WIDTH = 2048, NQKV = 3072;
constexpr float EPS = 1e-6f;
constexpr size_t MiB = 1u << 20;
constexpr size_t WS_WIN = 1 * MiB, WS_WOUTA = 17 * MiB, WS_WQKV = 25 * MiB, WS_WOB = 37 * MiB, WS_W1 = 41 * MiB, WS_W2 = 73 * MiB, WS_WC = 105 * MiB;
constexpr size_t WS_HN = 112 * MiB, WS_Z = 240 * MiB, WS_STAT = 752 * MiB, WS_XCH = 768 * MiB, WS_XSTAT = 769 * MiB, WS_CNT = 770 * MiB, WS_XCH2 = 771 * MiB, WS_END = 772 * MiB;
constexpr int LDS_BYTES = 147456, LDS_BST = 131072 + 1024;
constexpr size_t WS_BAR = 65536;
constexpr int NWAVES = 8;
#ifndef PROBE_MIX
#define PROBE_MIX 0
#endif
#ifndef PROBE_ATTN
#define PROBE_ATTN 0
#endif


__device__ __forceinline__ unsigned cvtpk(float lo, float hi) { f32x2_t v = {lo, hi}; bf16x2_t b = __builtin_convertvector(v, bf16x2_t); return __builtin_bit_cast(unsigned, b); }
__device__ __forceinline__ float bflo(unsigned w) { return __uint_as_float(w << 16); }
__device__ __forceinline__ float bfhi(unsigned w) { return __uint_as_float(w & 0xffff0000u); }
__device__ __forceinline__ float wave_sum(float v) {
#pragma unroll
    for (int o = 1; o < 64; o <<= 1) v += __shfl_xor(v, o);
    return v;
}
__device__ __forceinline__ int crow(int r, int hi) { return (r & 3) + 8 * (r >> 2) + 4 * hi; }
__device__ __forceinline__ v4i16_t tr_read(LAS unsigned char* p) { return __builtin_amdgcn_ds_read_tr16_b64_v4i16((LAS v4i16_t*)p); }

struct EpiAct {
    static constexpr bool PERM = true, AFTER_DRAIN = false;
    bf16* O; int ldc; int act; const float* rowstat; float* stat;
    __device__ __forceinline__ void prefetch(float (&pre)[8], const pg8::Unit& u, int wr, int fr) const {
        const int row0 = u.pm * pg8::BM + wr * 64 + fr;
#pragma unroll
        for (int ai = 0; ai < 2; ++ai)
#pragma unroll
            for (int m = 0; m < 4; ++m) pre[ai * 4 + m] = rowstat ? rowstat[row0 + ai * pg8::HALF + m * 16] : 1.f;
    }
    template <int MODE>
    __device__ __forceinline__ void run(pg8::f32x4 (&acc)[2][2][4][2], const pg8::Unit& u, int wr, int wc, int fr, int fq, const float (&pre)[8], float sc) const {
        using namespace pg8;
        const int row0 = u.pm * BM + wr * 64 + fr; const int col0 = u.pn * BM + wc * 32 + 8 * fq;
#pragma unroll
        for (int ai = 0; ai < 2; ++ai)
#pragma unroll
            for (int m = 0; m < 4; ++m) { bf16* rowp = O + (size_t)(row0 + ai * HALF + m * 16) * ldc + col0;
                float rs = 0.f, rq = 0.f; const float ps = pre[ai * 4 + m] * sc;
#pragma unroll
                for (int bj = 0; bj < 2; ++bj) { pg8::f32x4 v0 = acc[ai][bj][m][0] * ps, v1 = acc[ai][bj][m][1] * ps;
                    if (MODE == 1) { f32x2 a = gelu_pk((f32x2){v0[0], v0[1]}), b = gelu_pk((f32x2){v0[2], v0[3]}), c = gelu_pk((f32x2){v1[0], v1[1]}), d = gelu_pk((f32x2){v1[2], v1[3]});
                        v0 = (pg8::f32x4){a.x, a.y, b.x, b.y}; v1 = (pg8::f32x4){c.x, c.y, d.x, d.y};
                        rs += ((v0[0] + v0[1]) + (v0[2] + v0[3])) + ((v1[0] + v1[1]) + (v1[2] + v1[3]));
                        rq += ((v0[0] * v0[0] + v0[1] * v0[1]) + (v0[2] * v0[2] + v0[3] * v0[3])) + ((v1[0] * v1[0] + v1[1] * v1[1]) + (v1[2] * v1[2] + v1[3] * v1[3])); }
                    else if (MODE == 2) {
#pragma unroll
                        for (int e = 0; e < 4; ++e) { const float a = fmaxf(v0[e], 0.f), b = fmaxf(v1[e], 0.f); v0[e] = a * a; v1[e] = b * b; } }
                    pg8::u32x4 w; w.x = cvtpk(v0[0], v0[1]); w.y = cvtpk(v0[2], v0[3]); w.z = cvtpk(v1[0], v1[1]); w.w = cvtpk(v1[2], v1[3]);
                    *(pg8::u32x4*)(rowp + bj * HALF) = w; }
                if (MODE == 1) { rs += __shfl_xor(rs, 16); rs += __shfl_xor(rs, 32); rq += __shfl_xor(rq, 16); rq += __shfl_xor(rq, 32);
                    if (fq == 0) *(f32x2*)(stat + ((size_t)(row0 + ai * HALF + m * 16) * 32 + (u.pn - 8) * 4 + wc) * 2) = (f32x2){rs, rq}; } }
    }
    __device__ __forceinline__ void operator()(pg8::f32x4 (&acc)[2][2][4][2], const pg8::Unit& u, int wr, int wc, int fr, int fq, const float (&pre)[8]) const {
        asm volatile("" : "+v"(fr), "+v"(fq));
        const float sc = (act == 3 && u.pn * pg8::BM < 1024) ? 0.125f : 1.f;
        if (act == 2) run<2>(acc, u, wr, wc, fr, fq, pre, 1.f);
        else if (act == 1 && u.pn >= 8) run<1>(acc, u, wr, wc, fr, fq, pre, 1.f);
        else run<0>(acc, u, wr, wc, fr, fq, pre, sc);
    }
};

constexpr int LDS_P = 131072 + 2048, LDS_S = LDS_P + 4096, LDS_G = LDS_S + 1024;
struct EpiRes {
    static constexpr bool PERM = true, AFTER_DRAIN = false;
    bf16* XB; float* outf; float* xch; float* xch2; unsigned* cnt; unsigned* cnt2; float* rs; LAS unsigned char* lds;
    __device__ __forceinline__ void prefetch(float (&)[8], const pg8::Unit&, int, int) const {}
    __device__ __forceinline__ void wait32(unsigned* c) const {
        unsigned sp = 0u;
        while ((unsigned)__builtin_amdgcn_readfirstlane(__hip_atomic_load(c, __ATOMIC_RELAXED, __HIP_MEMORY_SCOPE_AGENT)) < 32u) { __builtin_amdgcn_s_sleep(1); if (++sp > (1u << 22)) break; }
        __builtin_amdgcn_fence(__ATOMIC_ACQUIRE, "agent");
    }
    __device__ __forceinline__ void operator()(pg8::f32x4 (&acc)[2][2][4][2], const pg8::Unit& u, int wr, int wc, int fr, int fq, const float (&)[8]) const {
        using namespace pg8;
        asm volatile("" : "+v"(fr), "+v"(fq));
        const int lane = fq * 16 + fr, wid = wr * 4 + wc;
        LAS float* P = (LAS float*)(lds + LDS_P); LAS float* S = (LAS float*)(lds + LDS_S); LAS float* Gs = (LAS float*)(lds + LDS_G);
        const int col0 = u.pn * BM + wc * 32 + 8 * fq;
#pragma unroll
        for (int ai = 0; ai < 2; ++ai)
#pragma unroll
            for (int m = 0; m < 4; ++m) { float q = 0.f;
#pragma unroll
                for (int bj = 0; bj < 2; ++bj)
#pragma unroll
                    for (int n = 0; n < 2; ++n) { const pg8::f32x4 v = acc[ai][bj][m][n]; q += (v[0] * v[0] + v[1] * v[1]) + (v[2] * v[2] + v[3] * v[3]); }
                q += __shfl_xor(q, 16); q += __shfl_xor(q, 32);
                if (fq == 0) P[(ai * HALF + wr * 64 + m * 16 + fr) * 4 + wc] = q; }
        asm volatile("s_waitcnt lgkmcnt(0)" ::: "memory"); __builtin_amdgcn_s_barrier(); asm volatile("" ::: "memory");
        const int row = wid * 32 + (lane & 31);
        if (lane < 32) { const pg8::f32x4 pp = *(LAS pg8::f32x4*)(P + row * 4);
            __hip_atomic_store(xch + ((size_t)(u.pm * BM + row) * 4 + u.pn), (pp[0] + pp[1]) + (pp[2] + pp[3]), __ATOMIC_RELAXED, __HIP_MEMORY_SCOPE_AGENT); }
        asm volatile("" ::: "memory");
        pg8::u32x4 xpre0[4][2], xpre1[4][2];
#pragma unroll
        for (int m = 0; m < 4; ++m)
#pragma unroll
            for (int bj = 0; bj < 2; ++bj) xpre0[m][bj] = *(const pg8::u32x4*)(XB + (size_t)(u.pm * BM + wr * 64 + m * 16 + fr) * 1024 + col0 + bj * HALF);
        asm volatile("" ::: "memory");
        asm volatile("s_waitcnt vmcnt(8)" ::: "memory");
        if (lane == 0) __hip_atomic_fetch_add(cnt + 64 * u.pm, 1u, __ATOMIC_RELAXED, __HIP_MEMORY_SCOPE_AGENT);
        if (wid == 0) wait32(cnt + 64 * u.pm);
        asm volatile("s_waitcnt vmcnt(0) lgkmcnt(0)" ::: "memory"); __builtin_amdgcn_s_barrier(); asm volatile("" ::: "memory");
        if (lane < 32) { const float* sl = xch + (size_t)(u.pm * BM + row) * 4; float t = 0.f;
#pragma unroll
            for (int k = 0; k < 4; ++k) t += __hip_atomic_load(sl + k, __ATOMIC_RELAXED, __HIP_MEMORY_SCOPE_AGENT);
            S[row] = 1.0f / sqrtf(t * (1.f / 1024.f) + 1e-6f); }
        asm volatile("s_waitcnt lgkmcnt(0)" ::: "memory"); __builtin_amdgcn_s_barrier(); asm volatile("" ::: "memory");
        pg8::f32x4 gp[2][2];
#pragma unroll
        for (int bj = 0; bj < 2; ++bj) { gp[bj][0] = *(LAS pg8::f32x4*)(Gs + col0 + bj * HALF); gp[bj][1] = *(LAS pg8::f32x4*)(Gs + col0 + bj * HALF + 4); }
#pragma unroll
        for (int ai = 0; ai < 2; ++ai) {
#pragma unroll
            for (int m = 0; m < 4; ++m) { const int r = ai * HALF + wr * 64 + m * 16 + fr; const float rsm = S[r]; const size_t off = (size_t)(u.pm * BM + r) * 1024 + col0; float q2 = 0.f;
#pragma unroll
                for (int bj = 0; bj < 2; ++bj) { const pg8::u32x4 xw = ai == 0 ? xpre0[m][bj] : xpre1[m][bj];
                    pg8::f32x4 x0 = {__uint_as_float(xw.x << 16), __uint_as_float(xw.x & 0xffff0000u), __uint_as_float(xw.y << 16), __uint_as_float(xw.y & 0xffff0000u)};
                    pg8::f32x4 x1 = {__uint_as_float(xw.z << 16), __uint_as_float(xw.z & 0xffff0000u), __uint_as_float(xw.w << 16), __uint_as_float(xw.w & 0xffff0000u)};
                    x0 = x0 + acc[ai][bj][m][0] * rsm * gp[bj][0]; x1 = x1 + acc[ai][bj][m][1] * rsm * gp[bj][1];
                    q2 += ((x0[0] * x0[0] + x0[1] * x0[1]) + (x0[2] * x0[2] + x0[3] * x0[3])) + ((x1[0] * x1[0] + x1[1] * x1[1]) + (x1[2] * x1[2] + x1[3] * x1[3]));
                    acc[ai][bj][m][0] = x0; acc[ai][bj][m][1] = x1; }
                if (ai == 0) {
#pragma unroll
                    for (int bj = 0; bj < 2; ++bj) xpre1[m][bj] = *(const pg8::u32x4*)(XB + (size_t)(u.pm * BM + HALF + wr * 64 + m * 16 + fr) * 1024 + col0 + bj * HALF);
                    asm volatile("" ::: "memory"); }
                q2 += __shfl_xor(q2, 16); q2 += __shfl_xor(q2, 32);
                if (fq == 0) P[r * 4 + wc] = q2; }
            asm volatile("" ::: "memory"); }
        asm volatile("s_waitcnt lgkmcnt(0)" ::: "memory"); __builtin_amdgcn_s_barrier(); asm volatile("" ::: "memory");
        if (lane < 32) { const pg8::f32x4 pp = *(LAS pg8::f32x4*)(P + row * 4);
            __hip_atomic_store(xch2 + ((size_t)(u.pm * BM + row) * 4 + u.pn), (pp[0] + pp[1]) + (pp[2] + pp[3]), __ATOMIC_RELAXED, __HIP_MEMORY_SCOPE_AGENT); }
        asm volatile("s_waitcnt vmcnt(0)" ::: "memory");
        if (lane == 0) __hip_atomic_fetch_add(cnt2 + 64 * u.pm, 1u, __ATOMIC_RELAXED, __HIP_MEMORY_SCOPE_AGENT);
#pragma unroll
        for (int ai = 0; ai < 2; ++ai)
#pragma unroll
            for (int m = 0; m < 4; ++m) { const size_t off = (size_t)(u.pm * BM + ai * HALF + wr * 64 + m * 16 + fr) * 1024 + col0;
#pragma unroll
                for (int bj = 0; bj < 2; ++bj) { const pg8::f32x4 x0 = acc[ai][bj][m][0], x1 = acc[ai][bj][m][1];
                    if (outf) { *(pg8::f32x4*)(outf + off + bj * HALF) = x0; *(pg8::f32x4*)(outf + off + bj * HALF + 4) = x1; }
                    else { pg8::u32x4 w; w.x = cvtpk(x0[0], x0[1]); w.y = cvtpk(x0[2], x0[3]); w.z = cvtpk(x1[0], x1[1]); w.w = cvtpk(x1[2], x1[3]); *(pg8::u32x4*)(XB + off + bj * HALF) = w; } } }
        if (u.pn == (u.pm & 3)) {
            if (wid == 0) wait32(cnt2 + 64 * u.pm);
            asm volatile("s_waitcnt vmcnt(0) lgkmcnt(0)" ::: "memory"); __builtin_amdgcn_s_barrier(); asm volatile("" ::: "memory");
            if (lane < 32) { const float* sl = xch2 + (size_t)(u.pm * BM + row) * 4; float t = 0.f;
#pragma unroll
                for (int k = 0; k < 4; ++k) t += __hip_atomic_load(sl + k, __ATOMIC_RELAXED, __HIP_MEMORY_SCOPE_AGENT);
                rs[u.pm * BM + row] = 1.0f / sqrtf(t * (1.f / 1024.f) + 1e-6f); }
        }
    }
};

__device__ __forceinline__ void transpose_item(const float* W, const float* gk, int K, int N, bf16* WT, LAS float* scr, int item, int lane) {
    const int nblk = N / 32, kb = item / nblk, nb = item % nblk, k0 = 64 * kb, n0 = 32 * nb;
#pragma unroll
    for (int i = 0; i < 32; ++i) { const int kk = 2 * i + (lane >> 5); const float gv = gk ? gk[k0 + kk] : 1.f; scr[kk * 33 + (lane & 31)] = W[(size_t)(k0 + kk) * N + n0 + (lane & 31)] * gv; }
    asm volatile("s_waitcnt lgkmcnt(0)" ::: "memory");
    const int c = lane & 7;
#pragma unroll
    for (int j = 0; j < 4; ++j) { const int n = (lane >> 3) + 8 * j; const LAS float* s = scr + (8 * c) * 33 + n;
        u32x4 o; o.x = cvtpk(s[0 * 33], s[1 * 33]); o.y = cvtpk(s[2 * 33], s[3 * 33]); o.z = cvtpk(s[4 * 33], s[5 * 33]); o.w = cvtpk(s[6 * 33], s[7 * 33]);
        *(u32x4*)(WT + (size_t)(n0 + n) * K + k0 + 8 * c) = o; }
    asm volatile("s_waitcnt lgkmcnt(0)" ::: "memory");
}
__device__ __forceinline__ void transpose_matrix(const float* W, const float* gk, int K, int N, bf16* WT, LAS float* scr, int gw, int ngw, int lane) {
    const int items = (K / 64) * (N / 32);
    for (int it = gw; it < items; it += ngw) transpose_item(W, gk, K, N, WT, scr, it, lane);
}

__device__ __forceinline__ void x_to_bf16(const float* xin, bf16* xb, float* xstat, int gw, int ngw, int lane) {
    for (int m0 = gw * 4; m0 < MTOK; m0 += ngw * 4) {
        f32x4 v[4][4];
#pragma unroll
        for (int r = 0; r < 4; ++r) { const f32x4* xr = (const f32x4*)(xin + (size_t)(m0 + r) * D_MODEL) + lane;
#pragma unroll
            for (int j = 0; j < 4; ++j) v[r][j] = xr[64 * j]; }
#pragma unroll
        for (int r = 0; r < 4; ++r) { float ss = 0.f;
#pragma unroll
            for (int j = 0; j < 4; ++j) ss += (v[r][j].x * v[r][j].x + v[r][j].y * v[r][j].y) + (v[r][j].z * v[r][j].z + v[r][j].w * v[r][j].w);
            ss = wave_sum(ss);
            u32x2* ho = (u32x2*)(xb + (size_t)(m0 + r) * D_MODEL) + lane;
#pragma unroll
            for (int j = 0; j < 4; ++j) { u32x2 w; w.x = cvtpk(v[r][j].x, v[r][j].y); w.y = cvtpk(v[r][j].z, v[r][j].w); ho[64 * j] = w; }
            if (lane == 0) xstat[m0 + r] = 1.0f / sqrtf(ss * (1.f / D_MODEL) + EPS); }
    }
}

__device__ __forceinline__ void row_pass(bf16* xb, const bf16* mo, const float* gpost, float* outf, float* xstat, int wave, int lane) {
    const int gw = blockIdx.x * NWAVES + wave, ngw = gridDim.x * NWAVES;
    f32x4 gp[4];
#pragma unroll
    for (int j = 0; j < 4; ++j) gp[j] = *((const f32x4*)gpost + lane + 64 * j);
    for (int m0 = gw * 4; m0 < MTOK; m0 += ngw * 4) {
        u32x2 xw[4][4], mw[4][4];
#pragma unroll
        for (int r = 0; r < 4; ++r) { const u32x2* xr = (const u32x2*)(xb + (size_t)(m0 + r) * D_MODEL) + lane; const u32x2* mr = (const u32x2*)(mo + (size_t)(m0 + r) * D_MODEL) + lane;
#pragma unroll
            for (int j = 0; j < 4; ++j) { xw[r][j] = xr[64 * j]; mw[r][j] = mr[64 * j]; } }
#pragma unroll
        for (int r = 0; r < 4; ++r) {
            const int m = m0 + r;
            f32x4 mv[4], v[4]; float ss = 0.f;
#pragma unroll
            for (int j = 0; j < 4; ++j) { mv[j] = (f32x4){bflo(mw[r][j].x), bfhi(mw[r][j].x), bflo(mw[r][j].y), bfhi(mw[r][j].y)}; v[j] = (f32x4){bflo(xw[r][j].x), bfhi(xw[r][j].x), bflo(xw[r][j].y), bfhi(xw[r][j].y)};
                ss += (mv[j].x * mv[j].x + mv[j].y * mv[j].y) + (mv[j].z * mv[j].z + mv[j].w * mv[j].w); }
            const float rstd = 1.0f / sqrtf(wave_sum(ss) * (1.f / D_MODEL) + EPS);
            float s2 = 0.f;
#pragma unroll
            for (int j = 0; j < 4; ++j) { v[j] = v[j] + mv[j] * rstd * gp[j]; s2 += (v[j].x * v[j].x + v[j].y * v[j].y) + (v[j].z * v[j].z + v[j].w * v[j].w); }
            s2 = wave_sum(s2);
            if (outf) { f32x4* xo = (f32x4*)(outf + (size_t)m * D_MODEL) + lane;
#pragma unroll
                for (int j = 0; j < 4; ++j) xo[64 * j] = v[j]; }
            else { u32x2* ho = (u32x2*)(xb + (size_t)m * D_MODEL) + lane;
#pragma unroll
                for (int j = 0; j < 4; ++j) { u32x2 w; w.x = cvtpk(v[j].x, v[j].y); w.y = cvtpk(v[j].z, v[j].w); ho[64 * j] = w; }
                if (lane == 0) xstat[m] = 1.0f / sqrtf(s2 * (1.f / D_MODEL) + EPS); }
        }
    }
}

__device__ __forceinline__ void mix_phase(bf16* Z, bf16* Gout, int ldg, const float* stat, const float* vg, const float* vbias, const bf16* Wc, const float* bs, LAS unsigned char* lds, int tid, int wave, int lane) {
    constexpr int LD = 4096, PITCH = 576, WPITCH = 272, OFF_W = 128 * PITCH, OFF_ST = OFF_W + 128 * WPITCH;
    LAS float* st = (LAS float*)(lds + OFF_ST);
    const int nper = gridDim.x >> 3, g = blockIdx.x & 7, ci = blockIdx.x >> 3;
    if (nper == 0 || ci >= nper) return;
    const int r32 = lane & 31, hi = lane >> 5;
    const int troff = (8 * hi + ((lane & 15) >> 2)) * PITCH + (32 * wave + 16 * ((lane >> 4) & 1) + 4 * (lane & 3)) * 2;
#pragma unroll
    for (int it = 0; it < 4; ++it) { const int idx = it * 512 + tid, row = idx >> 4, ch = idx & 15;
        *(LAS u32x4*)(lds + OFF_W + row * WPITCH + ch * 16) = *(const u32x4*)(Wc + ((size_t)g * 128 + row) * 128 + ch * 8); }
    const int vrow = tid >> 5, vch = tid & 31;
    const f32x4 g0 = *(const f32x4*)(vg + g * 256 + vch * 8), g1 = *(const f32x4*)(vg + g * 256 + vch * 8 + 4);
    const f32x4 b0 = *(const f32x4*)(vbias + g * 256 + vch * 8), b1 = *(const f32x4*)(vbias + g * 256 + vch * 8 + 4);
    const int srow = tid >> 2, sq = tid & 3;
    float bsr[4];
#pragma unroll
    for (int tb = 0; tb < 4; ++tb) bsr[tb] = bs[g * 128 + tb * 32 + r32];
    u32x4 rawv[8]; f32x4 stp[4];
    { const size_t row0 = (size_t)ci * 128;
#pragma unroll
      for (int it = 0; it < 8; ++it) rawv[it] = *(const u32x4*)(Z + (row0 + it * 16 + vrow) * LD + 2048 + g * 256 + vch * 8);
#pragma unroll
      for (int k = 0; k < 4; ++k) stp[k] = *(const f32x4*)(stat + ((row0 + srow) * 32 + sq * 8 + k * 2) * 2); }
    for (int chunk = ci; chunk < MTOK / 128; chunk += nper) {
        const size_t row0 = (size_t)chunk * 128;
        bf16* up = Z + (row0 + r32) * LD + g * 256 + 32 * wave + 4 * hi;
        bf16* gp = Gout + (row0 + r32) * ldg + g * 256 + 32 * wave + 4 * hi;
        u32x2 uw[4][4];
#pragma unroll
        for (int tb = 0; tb < 4; ++tb)
#pragma unroll
            for (int g4 = 0; g4 < 4; ++g4) uw[tb][g4] = *(const u32x2*)(up + (size_t)tb * 32 * LD + 8 * g4);
        { float s = (stp[0].x + stp[0].z) + (stp[1].x + stp[1].z) + (stp[2].x + stp[2].z) + (stp[3].x + stp[3].z);
          float q = (stp[0].y + stp[0].w) + (stp[1].y + stp[1].w) + (stp[2].y + stp[2].w) + (stp[3].y + stp[3].w);
          s += __shfl_xor(s, 1); s += __shfl_xor(s, 2); q += __shfl_xor(q, 1); q += __shfl_xor(q, 2);
          const float mean = s * (1.f / 2048.f), var = fmaxf(q * (1.f / 2048.f) - mean * mean, 0.f);
          if (sq == 0) { st[2 * srow] = mean; st[2 * srow + 1] = 1.0f / sqrtf(var + EPS); } }
        __syncthreads();
#pragma unroll
        for (int it = 0; it < 8; ++it) {
            const int row = it * 16 + vrow; const u32x4 w = rawv[it];
            const float mean = st[2 * row], rstd = st[2 * row + 1];
            u32x4 o;
            o.x = cvtpk((bflo(w.x) - mean) * rstd * g0.x + b0.x, (bfhi(w.x) - mean) * rstd * g0.y + b0.y);
            o.y = cvtpk((bflo(w.y) - mean) * rstd * g0.z + b0.z, (bfhi(w.y) - mean) * rstd * g0.w + b0.w);
            o.z = cvtpk((bflo(w.z) - mean) * rstd * g1.x + b1.x, (bfhi(w.z) - mean) * rstd * g1.y + b1.y);
            o.w = cvtpk((bflo(w.w) - mean) * rstd * g1.z + b1.z, (bfhi(w.w) - mean) * rstd * g1.w + b1.w);
            *(LAS u32x4*)(lds + row * PITCH + vch * 16) = o;
        }
        __syncthreads();
        if (chunk + nper < MTOK / 128) { const size_t nrow0 = (size_t)(chunk + nper) * 128;
#pragma unroll
            for (int it = 0; it < 8; ++it) rawv[it] = *(const u32x4*)(Z + (nrow0 + it * 16 + vrow) * LD + 2048 + g * 256 + vch * 8);
#pragma unroll
            for (int k = 0; k < 4; ++k) stp[k] = *(const f32x4*)(stat + ((nrow0 + srow) * 32 + sq * 8 + k * 2) * 2); }
        bf16x8 af[8];
#pragma unroll
        for (int ks = 0; ks < 8; ++ks) { const v4i16_t lo = tr_read(lds + troff + (16 * ks) * PITCH), h4 = tr_read(lds + troff + (16 * ks + 4) * PITCH);
            af[ks] = (bf16x8){lo[0], lo[1], lo[2], lo[3], h4[0], h4[1], h4[2], h4[3]}; }
#pragma unroll
        for (int tb = 0; tb < 4; ++tb) {
            f32x16 acc = {};
            LAS unsigned char* wp = lds + OFF_W + (tb * 32 + r32) * WPITCH + 16 * hi;
#pragma unroll
            for (int ks = 0; ks < 2 * (tb + 1); ++ks) { const bf16x8 bfrag = *(LAS bf16x8*)(wp + 32 * ks); acc = __builtin_amdgcn_mfma_f32_32x32x16_bf16(af[ks], bfrag, acc, 0, 0, 0); }
            const float bsv = bsr[tb];
#pragma unroll
            for (int g4 = 0; g4 < 4; ++g4) { const u32x2 u2 = uw[tb][g4]; u32x2 ow;
                const pg8::f32x2 ua = pg8::gelu_pk((pg8::f32x2){bflo(u2.x), bfhi(u2.x)}), ub = pg8::gelu_pk((pg8::f32x2){bflo(u2.y), bfhi(u2.y)});
                ow.x = cvtpk(ua.x * (acc[4 * g4] + bsv), ua.y * (acc[4 * g4 + 1] + bsv));
                ow.y = cvtpk(ub.x * (acc[4 * g4 + 2] + bsv), ub.y * (acc[4 * g4 + 3] + bsv));
                *(u32x2*)(gp + (size_t)tb * 32 * ldg + 8 * g4) = ow; }
        }
        __syncthreads();
    }
}

template <bool DIAG>
__device__ __forceinline__ void attn_tile(f32x16& o0, f32x16& o1, float& carry2, const bf16x8 (&qr)[4], bf16x8 (&kf)[4], u32x4 (&vr)[4], const bf16* kpn, const bf16* vpn, bool has_next,
                                          LAS unsigned char* vcur, int troff, int strow, int stch, int r32, int hi) {
    constexpr int LD = NQKV; constexpr float LOG2E = 1.4426950408889634f;
#pragma unroll
    for (int it = 0; it < 4; ++it) *(LAS u32x4*)(vcur + (it * 8 + strow) * 192 + stch * 16) = vr[it];
    f32x16 p = {};
#pragma unroll
    for (int s = 0; s < 4; ++s) p = __builtin_amdgcn_mfma_f32_32x32x16_bf16(kf[s], qr[s], p, 0, 0, 0);
    (void)has_next;
#pragma unroll
    for (int s = 0; s < 4; ++s) { kf[s] = *(const bf16x8*)(kpn + 16 * s); vr[s] = *(const u32x4*)(vpn + (size_t)s * 8 * LD); }
    float kp[16], be[16];
#pragma unroll
    for (int r = 0; r < 16; ++r) { const float z = __builtin_amdgcn_fmed3f(p[r], -80.f, 3.0e38f);
        const float t = __builtin_amdgcn_exp2f(z * -LOG2E); be[r] = __builtin_amdgcn_rcpf(1.f + t); kp[r] = t * be[r];
        if (DIAG) { const bool msk = crow(r, hi) >= r32; kp[r] = msk ? 1.f : kp[r]; be[r] = msk ? 0.f : be[r]; } }
    float se[16], G[4], oth[4], T[4];
#pragma unroll
    for (int g = 0; g < 4; ++g) { se[4 * g + 3] = 1.f; se[4 * g + 2] = kp[4 * g + 3]; se[4 * g + 1] = se[4 * g + 2] * kp[4 * g + 2]; se[4 * g] = se[4 * g + 1] * kp[4 * g + 1]; G[g] = se[4 * g] * kp[4 * g]; }
#pragma unroll
    for (int g = 0; g < 4; ++g) {
        const auto rr = __builtin_amdgcn_permlane32_swap(__float_as_uint(G[g]), __float_as_uint(G[g]), false, false);
        oth[g] = __uint_as_float(rr[1]); T[g] = __uint_as_float(rr[0]) * __uint_as_float(rr[1]); }
    const float C = __builtin_amdgcn_exp2f(carry2);
    float base[4]; const float a2 = T[3], a1 = T[3] * T[2], a0 = a1 * T[1];
    base[3] = C; base[2] = C * a2; base[1] = C * a1; base[0] = C * a0;
    if (hi == 0) {
#pragma unroll
        for (int g = 0; g < 4; ++g) base[g] *= oth[g]; }
    carry2 += __builtin_amdgcn_logf(a0 * T[0]);
    float a[16];
#pragma unroll
    for (int r = 0; r < 16; ++r) a[r] = be[r] * (se[r] * base[r >> 2]);
    u32x4 pw0, pw1;
    pw0.x = cvtpk(a[0], a[1]); pw0.y = cvtpk(a[2], a[3]); pw0.z = cvtpk(a[4], a[5]); pw0.w = cvtpk(a[6], a[7]);
    pw1.x = cvtpk(a[8], a[9]); pw1.y = cvtpk(a[10], a[11]); pw1.z = cvtpk(a[12], a[13]); pw1.w = cvtpk(a[14], a[15]);
    const bf16x8 pf0 = __builtin_bit_cast(bf16x8, pw0), pf1 = __builtin_bit_cast(bf16x8, pw1);
    asm volatile("" ::: "memory");
#pragma unroll
    for (int dh = 0; dh < 2; ++dh)
#pragma unroll
        for (int s = 0; s < 2; ++s) {
            const v4i16_t lo = tr_read(vcur + troff + (16 * s) * 192 + dh * 64), h4 = tr_read(vcur + troff + (16 * s + 8) * 192 + dh * 64);
            const bf16x8 vf = (bf16x8){lo[0], lo[1], lo[2], lo[3], h4[0], h4[1], h4[2], h4[3]};
            if (dh == 0) o0 = __builtin_amdgcn_mfma_f32_32x32x16_bf16(vf, s == 0 ? pf0 : pf1, o0, 0, 0, 0);
            else o1 = __builtin_amdgcn_mfma_f32_32x32x16_bf16(vf, s == 0 ? pf0 : pf1, o1, 0, 0, 0);
        }
    asm volatile("" ::: "memory");
}
__device__ __forceinline__ void attn_phase(bf16* QKV, bf16* Oout, int ldo, LAS unsigned char* lds, int wave, int lane) {
    constexpr int LD = NQKV;
    const int r32 = lane & 31, hi = lane >> 5;
    LAS unsigned char* vb = lds + wave * 12288;
    const int vcu = (gridDim.x % 8 == 0) ? (int)((blockIdx.x & 7) * (gridDim.x >> 3) + (blockIdx.x >> 3)) : (int)blockIdx.x;
    const int gw = vcu * NWAVES + wave, ngw = gridDim.x * NWAVES;
    const int troff = (4 * hi + ((lane & 15) >> 2)) * 192 + (16 * ((lane >> 4) & 1) + 4 * (lane & 3)) * 2;
    const int strow = lane >> 3, stch = lane & 7;
#define ATT_UNIT(unit_) const int bh = (unit_) >> 6, qb = ((unit_) + 8 * (bh >> 5)) & 63, h = bh & 15, b = bh >> 4;     \
        const size_t rowbase = (size_t)b * SEQ; \
        const bf16* qp = QKV + (rowbase + qb * 32 + r32) * LD + h * 64; \
        const bf16* kbase = QKV + (rowbase + r32) * LD + 1024 + h * 64 + 8 * hi; \
        const bf16* vbase = QKV + (rowbase + strow) * LD + 2048 + h * 64 + stch * 8;
#define ATT_LOAD(Q_) do { const bf16* kp = kbase + (size_t)qb * 32 * LD; const bf16* vp = vbase + (size_t)qb * 32 * LD; \
        _Pragma("unroll") for (int s = 0; s < 4; ++s) Q_[s] = *(const bf16x8*)(qp + 16 * s + 8 * hi); \
        _Pragma("unroll") for (int s = 0; s < 4; ++s) { kf[s] = *(const bf16x8*)(kp + 16 * s); vr[s] = *(const u32x4*)(vp + (size_t)s * 8 * LD); } } while (0)
    const int nunits = BATCH * 16 * 64;
    bf16x8 qr[4], kf[4]; u32x4 vr[4];
    if (gw < nunits) { ATT_UNIT(gw) ATT_LOAD(qr); }
    for (int unit = gw; unit < nunits; unit += ngw) {
        ATT_UNIT(unit)
        f32x16 o0 = {}, o1 = {};
        float carry2 = 0.f;
        attn_tile<true>(o0, o1, carry2, qr, kf, vr, kbase + (size_t)(qb > 0 ? qb - 1 : 0) * 32 * LD, vbase + (size_t)(qb > 0 ? qb - 1 : 0) * 32 * LD, qb > 0, vb, troff, strow, stch, r32, hi);
        int buf = 1;
        for (int kt = qb - 1; kt >= 0; --kt) {
            if (__all(carry2 <= -150.f)) break;
            attn_tile<false>(o0, o1, carry2, qr, kf, vr, kbase + (size_t)(kt > 0 ? kt - 1 : 0) * 32 * LD, vbase + (size_t)(kt > 0 ? kt - 1 : 0) * 32 * LD, kt > 0, vb + buf * 6144, troff, strow, stch, r32, hi);
            buf ^= 1;
        }
        if (unit + ngw < nunits) { const int nu = unit + ngw; { ATT_UNIT(nu) ATT_LOAD(qr); } }
        bf16* op = Oout + (rowbase + qb * 32 + r32) * ldo + h * 64;
#pragma unroll
        for (int g = 0; g < 4; ++g) {
            u32x2 w0, w1;
            w0.x = cvtpk(o0[4 * g], o0[4 * g + 1]); w0.y = cvtpk(o0[4 * g + 2], o0[4 * g + 3]);
            w1.x = cvtpk(o1[4 * g], o1[4 * g + 1]); w1.y = cvtpk(o1[4 * g + 2], o1[4 * g + 3]);
            *(u32x2*)(op + 8 * g + 4 * hi) = w0; *(u32x2*)(op + 32 + 8 * g + 4 * hi) = w1;
        }
    }
#undef ATT_UNIT
#undef ATT_LOAD
}

#define XB_TMO      128
#define XB_XCNT(j)  (256  + 64 * (j))
#define XB_XSUB(j)  (1280 + 64 * (j))
#define XB_XGEN(j)  (2304 + 64 * (j))
#define XB_TOP      3328
#define XB_TOPGEN   3392
#define XCD_BAR_WORDS 3456
#define XB_SPIN_CAP (1u << 18)

__device__ __forceinline__ unsigned xb_ld(unsigned* p)              { return __hip_atomic_load(p, __ATOMIC_RELAXED, __HIP_MEMORY_SCOPE_AGENT); }
__device__ __forceinline__ unsigned xb_add(unsigned* p, unsigned v) { return __hip_atomic_fetch_add(p, v, __ATOMIC_RELAXED, __HIP_MEMORY_SCOPE_AGENT); }
__device__ __forceinline__ unsigned xb_xcc_id() { return (unsigned)__builtin_amdgcn_s_getreg((3 << 11) | 20) & 0xFu; }
#define XB_SPIN(cond, bar) do { unsigned _sp = 0; while (cond) { __builtin_amdgcn_s_sleep(1); \
    if ((++_sp & 255u) == 0u) { if (xb_ld(&(bar)[XB_TMO])) break; if (_sp > XB_SPIN_CAP) { atomicAdd(&(bar)[XB_TMO], 1u); break; } } } } while (0)

struct XcdBarrier {
    unsigned* bar; unsigned x;
    volatile LAS unsigned* st;
};

__device__ __forceinline__ XcdBarrier xcd_barrier_post(unsigned* bar, volatile LAS unsigned* st) {
    XcdBarrier b; b.bar = bar; b.x = xb_xcc_id(); b.st = st;
    if (threadIdx.x == 0) (void)xb_add(&bar[XB_XCNT(b.x)], 1u);
    return b;
}
__device__ __forceinline__ void xcd_barrier_complete(unsigned* bar, unsigned x, unsigned& nloc, unsigned& nx) {
    const unsigned G = gridDim.x * gridDim.y * gridDim.z;
    unsigned sum, cnt, mine, sp = 0u;
    for (;;) {
        sum = 0u; cnt = 0u; mine = 0u;
#pragma unroll
        for (unsigned j = 0; j < 16; ++j) { const unsigned c = xb_ld(&bar[XB_XCNT(j)]); sum += c; cnt += (c > 0u) ? 1u : 0u; mine = (j == x) ? c : mine; }
        if (sum == G) break;
        __builtin_amdgcn_s_sleep(1);
        if ((++sp & 255u) == 0u) { if (xb_ld(&bar[XB_TMO])) break; if (sp > XB_SPIN_CAP) { atomicAdd(&bar[XB_TMO], 1u); break; } }
    }
    nloc = mine > 0u ? mine : 1u; nx = cnt > 0u ? cnt : 1u;
}

__device__ __forceinline__ void xcd_barrier(const XcdBarrier& b) {
    asm volatile("s_waitcnt vmcnt(0)" ::: "memory");
    __syncthreads();
    if (threadIdx.x == 0) {
        unsigned* bar = b.bar;
        __builtin_amdgcn_s_waitcnt(0);
        unsigned nloc = b.st[0], nx = b.st[1];
        if (nloc == 0u) { xcd_barrier_complete(bar, b.x, nloc, nx); b.st[0] = nloc; b.st[1] = nx; }
        const unsigned old = xb_add(&bar[XB_XSUB(b.x)], 1u);
        const unsigned gen = old / nloc;
        if (old + 1u == (gen + 1u) * nloc) {
            __builtin_amdgcn_fence(__ATOMIC_RELEASE, "agent");
            asm volatile("s_waitcnt vmcnt(0)" ::: "memory");
            const unsigned og = xb_add(&bar[XB_TOP], 1u);
            const unsigned tg = og / nx;
            if (og + 1u == (tg + 1u) * nx) xb_add(&bar[XB_TOPGEN], 1u);
            else XB_SPIN(xb_ld(&bar[XB_TOPGEN]) == tg, bar);
            __builtin_amdgcn_fence(__ATOMIC_ACQUIRE, "agent");
            xb_add(&bar[XB_XGEN(b.x)], 1u);
            asm volatile("s_waitcnt vmcnt(0)" ::: "memory");
        } else {
            XB_SPIN(xb_ld(&bar[XB_XGEN(b.x)]) == gen, bar);
            __builtin_amdgcn_fence(__ATOMIC_ACQUIRE, "agent");
            asm volatile("s_waitcnt vmcnt(0)" ::: "memory");
        }
    }
    __syncthreads();
}

struct Params { const float* in[15]; float* out; unsigned char* ws; };

__global__ void __launch_bounds__(NWAVES * 64, 2) fwd_kernel(Params p) {
    extern __shared__ __attribute__((aligned(16))) unsigned char lds_raw[];
    cg::grid_group grid = cg::this_grid();
    LAS unsigned char* lds = (LAS unsigned char*)lds_raw;
    unsigned char* ws = p.ws;
    const float* x = p.in[0]; const float* n_mix_pre = p.in[1]; const float* n_mix_post = p.in[2]; const float* n_ffn_pre = p.in[3]; const float* n_ffn_post = p.in[4];
    const float* a_v_g = p.in[6]; const float* a_v_b = p.in[7]; const float* a_w_s = p.in[8]; const float* a_b_s = p.in[9];
    bf16* Win_t = (bf16*)(ws + WS_WIN); bf16* Wouta_t = (bf16*)(ws + WS_WOUTA); bf16* Wqkv_t = (bf16*)(ws + WS_WQKV); bf16* Wob_t = (bf16*)(ws + WS_WOB);
    bf16* W1_t = (bf16*)(ws + WS_W1); bf16* W2_t = (bf16*)(ws + WS_W2); bf16* Wc = (bf16*)(ws + WS_WC);
    bf16* XB = (bf16*)(ws + WS_HN); bf16* Z = (bf16*)(ws + WS_Z); float* STAT = (float*)(ws + WS_STAT);
    float* XCH = (float*)(ws + WS_XCH); float* XCH2 = (float*)(ws + WS_XCH2); float* XSTAT = (float*)(ws + WS_XSTAT); unsigned* CNT = (unsigned*)(ws + WS_CNT);
    float* out = p.out;
    unsigned* barw = (unsigned*)(ws + WS_BAR);
    volatile LAS unsigned* bst = (volatile LAS unsigned*)(lds + LDS_BST);
    if (threadIdx.x == 0) { bst[0] = 0u; bst[1] = 0u; }
    if (blockIdx.x == 0) for (int i = threadIdx.x; i < XCD_BAR_WORDS; i += NWAVES * 64) __hip_atomic_store(barw + i, 0u, __ATOMIC_RELAXED, __HIP_MEMORY_SCOPE_AGENT);
    __syncthreads();

    {
        const int tid = threadIdx.x, lane = tid & 63, wave = __builtin_amdgcn_readfirstlane(tid >> 6);
        const int gw = blockIdx.x * NWAVES + wave, ngw = gridDim.x * NWAVES;
        for (int i = blockIdx.x * 512 + tid; i < 16 * 256 * 64; i += gridDim.x * 512) __hip_atomic_store(CNT + i, 0u, __ATOMIC_RELAXED, __HIP_MEMORY_SCOPE_AGENT);
        LAS float* scr = (LAS float*)(lds + wave * 16384);
        for (int i = blockIdx.x * 512 + tid; i < 2 * 8 * 128 * 128; i += gridDim.x * 512) { const int s = i & 127, t = (i >> 7) & 127; Wc[i] = (s <= t) ? (bf16)(cvtpk(a_w_s[i], 0.f) & 0xffffu) : (bf16)0; }
        if (wave < 4) { const int gw2 = blockIdx.x * 4 + wave, ngw2 = gridDim.x * 4;
        for (int l = 0; l < 2; ++l) {
            transpose_matrix(p.in[5] + (size_t)l * 1024 * 4096, n_mix_pre + (2 * l) * 1024, 1024, 4096, Win_t + (size_t)l * 4096 * 1024, scr, gw2, ngw2, lane);
            transpose_matrix(p.in[10] + (size_t)l * 2048 * 1024, nullptr, 2048, 1024, Wouta_t + (size_t)l * 1024 * 2048, scr, gw2, ngw2, lane);
            transpose_matrix(p.in[11] + (size_t)l * 1024 * 3072, n_mix_pre + (2 * l + 1) * 1024, 1024, 3072, Wqkv_t + (size_t)l * 3072 * 1024, scr, gw2, ngw2, lane);
            transpose_matrix(p.in[12] + (size_t)l * 1024 * 1024, nullptr, 1024, 1024, Wob_t + (size_t)l * 1024 * 1024, scr, gw2, ngw2, lane);
        }
        for (int l = 0; l < 4; ++l) {
            transpose_matrix(p.in[13] + (size_t)l * 1024 * 4096, n_ffn_pre + l * 1024, 1024, 4096, W1_t + (size_t)l * 4096 * 1024, scr, gw2, ngw2, lane);
            transpose_matrix(p.in[14] + (size_t)l * 4096 * 1024, nullptr, 4096, 1024, W2_t + (size_t)l * 1024 * 4096, scr, gw2, ngw2, lane);
        }
        } else { x_to_bf16(x, XB, XSTAT, (int)blockIdx.x * 4 + (wave - 4), (int)gridDim.x * 4, lane); }

    }
    grid.sync();
    const XcdBarrier xbar = xcd_barrier_post(barw, bst);

#pragma unroll 1
    for (int ph = 0; ph < 20; ++ph) {
        const int layer = ph / 5, step = ph % 5, j = layer >> 1; const bool even = (layer & 1) == 0;
        int tid = threadIdx.x; asm volatile("" : "+v"(tid));
        const int lane = tid & 63, wave = __builtin_amdgcn_readfirstlane(tid >> 6);
        if (step == 0 || step == 3) {
            pg8::Gemm g; EpiAct E; E.stat = STAT; E.rowstat = XSTAT; g.A = XB; g.lda = 1024; g.K = 1024; g.M = MTOK; E.O = Z;
            if (step == 0) { g.N = even ? 4096 : 3072; g.Bt = even ? Win_t + (size_t)j * 4096 * 1024 : Wqkv_t + (size_t)j * 3072 * 1024; E.ldc = g.N; E.act = even ? 1 : 3; }
            else { g.N = 4096; g.Bt = W1_t + (size_t)layer * 4096 * 1024; E.ldc = 4096; E.act = 2; }
            pg8::StaticOrder S; S.init(g.M, g.N, (int)gridDim.x, (int)blockIdx.x);
            pg8::gemm_phase<EpiAct, pg8::StaticOrder, true, true>(lds, g, S, E);
        } else if (step == 2 || step == 4) {
            { const float* gsrc = (step == 2 ? n_mix_post : n_ffn_post) + layer * 1024;
              for (int i = tid; i < 1024; i += NWAVES * 64) ((LAS float*)(lds + LDS_G))[i] = gsrc[i];
              __syncthreads(); }
            pg8::Gemm g; EpiRes E; g.A = Z; g.M = MTOK; g.N = 1024;
            if (step == 2) { g.lda = even ? 4096 : 3072; g.K = even ? 2048 : 1024; g.Bt = even ? Wouta_t + (size_t)j * 1024 * 2048 : Wob_t + (size_t)j * 1024 * 1024; }
            else { g.lda = 4096; g.K = 4096; g.Bt = W2_t + (size_t)layer * 1024 * 4096; }
            const int bank = layer * 2 + (step == 4 ? 1 : 0);
            E.XB = XB; E.outf = (ph == 19) ? out : nullptr; E.xch = XCH; E.xch2 = XCH2; E.cnt = CNT + (size_t)bank * 256 * 64; E.cnt2 = CNT + (size_t)(8 + bank) * 256 * 64; E.rs = XSTAT; E.lds = lds;
            pg8::StaticOrder S; S.init(g.M, g.N, (int)gridDim.x, (int)blockIdx.x);
            pg8::gemm_phase<EpiRes, pg8::StaticOrder, true, true>(lds, g, S, E);
        } else {
#if PROBE_MIX
            if (even) { mix_phase(Z, (bf16*)(ws + 900 * MiB), 2048, STAT, a_v_g + (size_t)j * 2048, a_v_b + (size_t)j * 2048, Wc + (size_t)j * 8 * 128 * 128, a_b_s + (size_t)j * 8 * 128, lds, tid, wave, lane); __syncthreads(); }
#endif
#if PROBE_ATTN
            if (!even) attn_phase(Z, (bf16*)(ws + 900 * MiB), 1024, lds, wave, lane);
#endif
            if (even) mix_phase(Z, Z, 4096, STAT, a_v_g + (size_t)j * 2048, a_v_b + (size_t)j * 2048, Wc + (size_t)j * 8 * 128 * 128, a_b_s + (size_t)j * 8 * 128, lds, tid, wave, lane);
            else attn_phase(Z, Z, NQKV, lds, wave, lane);
        }
        if (ph != 19) xcd_barrier(xbar);
    }
}

extern "C" void kernel_launch(void* const* d_in, const int* in_sizes, int n_in, void* d_out, int out_size, void* d_ws, size_t ws_size, hipStream_t stream) {
    static int grid = 0;
    if (grid == 0) {
        if (n_in != 15 || out_size != MTOK * D_MODEL || ws_size < WS_END) { fprintf(stderr, "kernel_launch: unexpected sizes (n_in %d out %d ws %zu)\n", n_in, out_size, ws_size); grid = -1; return; }
        int dev = 0, cus = 0, per_cu = 0;
        hipGetDevice(&dev); hipDeviceGetAttribute(&cus, hipDeviceAttributeMultiprocessorCount, dev);
        if (hipFuncSetAttribute((const void*)fwd_kernel, hipFuncAttributeMaxDynamicSharedMemorySize, LDS_BYTES) != hipSuccess) fprintf(stderr, "kernel_launch: hipFuncSetAttribute failed\n");
        if (hipOccupancyMaxActiveBlocksPerMultiprocessor(&per_cu, (const void*)fwd_kernel, NWAVES * 64, LDS_BYTES) != hipSuccess || per_cu < 1) { fprintf(stderr, "kernel_launch: occupancy query gave %d\n", per_cu); per_cu = 1; }
        (void)hipGetLastError();
        grid = cus * per_cu;
    }
    if (grid < 0) return;
    Params p{};
    for (int i = 0; i < 15; ++i) p.in[i] = (const float*)d_in[i];
    p.out = (float*)d_out; p.ws = (unsigned char*)d_ws;
    void* args[] = {&p};
    hipError_t e = hipLaunchCooperativeKernel((const void*)fwd_kernel, dim3(grid), dim3(NWAVES * 64), args, LDS_BYTES, stream);
    if (e != hipSuccess) fprintf(stderr, "kernel_launch: cooperative launch failed: %s (grid %d)\n", hipGetErrorString(e), grid);
}
```

```cpp
#include <hip/hip_runtime.h>
#include <hip/hip_cooperative_groups.h>
#include <cstdio>
#include <cstdint>
namespace cg = cooperative_groups;

namespace pg8 {
#define PG8_LAS __attribute__((address_space(3)))
typedef unsigned short bf16_t;
typedef short bf16x8 __attribute__((ext_vector_type(8)));
typedef float f32x4 __attribute__((ext_vector_type(4)));
typedef unsigned u32x4 __attribute__((ext_vector_type(4)));
constexpr int BM = 256, BK = 64, HALF = 128, HTB = HALF * BK * 2  , STAGE_BYTES = 8 * HTB, NXCD = 8, WGM = 8;

__host__ __device__ __forceinline__ int lds_byte(int r, int c) { const int st = (r >> 4) * 2 + (c >> 5), rr = r & 15, cc = c & 31, ob = rr * 64 + cc * 2; return st * 1024 + (ob ^ (((ob >> 9) & 1) << 5)); }
__host__ __device__ __forceinline__ void stage_rc(int b, int& R, int& C) { const int st = b / 1024, sb = b % 1024, swz = sb ^ (((sb >> 9) & 1) << 5); R = (st >> 1) * 16 + swz / 64; C = (st & 1) * 32 + (swz % 64) / 2; }
__host__ __device__ __forceinline__ int perm32(int rho) { const int n = rho >> 4, i = rho & 15; return 8 * (i >> 2) + 4 * n + (i & 3); }

struct Unit { int pm, pn; };
struct Gemm { const bf16_t* A; const bf16_t* Bt; int M, N, K, lda; };

struct StaticOrder {
    int nM, nN, nwg, G, c;
    __host__ __device__ void init(int M, int N, int G_, int c_) { nM = M / BM; nN = N / BM; nwg = nM * nN; G = G_; c = c_; }
    __host__ __device__ bool next(int i, Unit& u) const {
        const long L = (long)i * G + c; if (L >= nwg) return false;
        int wgid = (int)L; { const int q = nwg / NXCD, r = nwg % NXCD, xcd = wgid % NXCD, off = wgid / NXCD; wgid = (xcd < r ? xcd * (q + 1) : r * (q + 1) + (xcd - r) * q) + off; }
        const int nig = WGM * nN, gid = wgid / nig, fm = gid * WGM, gsz = (nM - fm) < WGM ? (nM - fm) : WGM;
        u.pm = fm + ((wgid % nig) % gsz); u.pn = (wgid % nig) / gsz; return true;
    }
    __device__ __forceinline__ void a_ready(const Unit&) const {}
    __device__ __forceinline__ void done(const Unit&) const {}
};

__device__ __forceinline__ unsigned cvt_pk_bf16(float lo, float hi) { unsigned r; asm volatile("v_cvt_pk_bf16_f32 %0, %1, %2" : "=v"(r) : "v"(lo), "v"(hi)); return r; }
typedef float f32x2 __attribute__((ext_vector_type(2)));
__device__ __forceinline__ f32x2 gelu_pk(f32x2 v) {
    const f32x2 av = __builtin_elementwise_abs(v), d = av * 0.2316418882f + 1.0f;
    f32x2 t; t.x = __builtin_amdgcn_rcpf(d.x); t.y = __builtin_amdgcn_rcpf(d.y);
    f32x2 q = t * 0.5307027145f + (-0.7265760135f); q = q * t + 0.7107068705f; q = q * t + (-0.142248368f); q = q * t + 0.127414796f; q = q * t;
    const f32x2 s = (v * v) * (-0.72134752044f);
    f32x2 e; e.x = __builtin_amdgcn_exp2f(s.x); e.y = __builtin_amdgcn_exp2f(s.y);
    const f32x2 m = v * (q * e), r = v - m;
    f32x2 o; o.x = v.x < 0.f ? m.x : r.x; o.y = v.y < 0.f ? m.y : r.y; return o;
}

template <int ACT  > struct EpiBf16 {
    static constexpr bool PERM = true, AFTER_DRAIN = false; static_assert(ACT == 0 || ACT == 1, "EpiBf16: ACT is 0 (none) or 1 (gelu_pk)");
    bf16_t* O; int ldc; const float* bias; int split_cols; size_t split_stride; float scale0;
    __device__ __forceinline__ void operator()(const f32x4 (&acc)[2][2][4][2], const Unit& u, int wr, int wc, int fr, int fq) const {
        const int row0 = u.pm * BM + wr * 64 + fr; int colt = u.pn * BM; bf16_t* base = O;
        float sc = 1.f; if (split_cols) { const int t = colt / split_cols; base += (size_t)t * split_stride; colt -= t * split_cols; if (t == 0) sc = scale0; }
        const int col0 = colt + wc * 32 + 8 * fq, bcol0 = u.pn * BM + wc * 32 + 8 * fq;
        f32x4 bv[2][2];
#pragma unroll
        for (int bj = 0; bj < 2; ++bj)
#pragma unroll
            for (int n = 0; n < 2; ++n) bv[bj][n] = bias ? *(const f32x4*)(bias + bcol0 + bj * HALF + 4 * n) : (f32x4){0.f, 0.f, 0.f, 0.f};
#pragma unroll
        for (int ai = 0; ai < 2; ++ai)
#pragma unroll
            for (int m = 0; m < 4; ++m) { bf16_t* rowp = base + (size_t)(row0 + ai * HALF + m * 16) * ldc + col0;
#pragma unroll
                for (int bj = 0; bj < 2; ++bj) { f32x4 v0 = acc[ai][bj][m][0] + bv[bj][0], v1 = acc[ai][bj][m][1] + bv[bj][1];
                    if (ACT == 1) { f32x2 a = gelu_pk((f32x2){v0[0], v0[1]}), b = gelu_pk((f32x2){v0[2], v0[3]}), c = gelu_pk((f32x2){v1[0], v1[1]}), d = gelu_pk((f32x2){v1[2], v1[3]});
                        v0 = (f32x4){a.x, a.y, b.x, b.y}; v1 = (f32x4){c.x, c.y, d.x, d.y}; }
                    v0 = v0 * sc; v1 = v1 * sc; u32x4 w; w.x = cvt_pk_bf16(v0[0], v0[1]); w.y = cvt_pk_bf16(v0[2], v0[3]); w.z = cvt_pk_bf16(v1[0], v1[1]); w.w = cvt_pk_bf16(v1[2], v1[3]);
                    *(u32x4*)(rowp + bj * HALF) = w; } }
    }
};
template <class Epi, class Sched, bool ALIGN_EPI = false, bool SP2 = false>
__device__ __forceinline__ void gemm_phase(PG8_LAS unsigned char* lds, const Gemm g, const Sched& S, const Epi& E) {
    int tid = threadIdx.x; asm volatile("" : "+v"(tid));
    const int wid = __builtin_amdgcn_readfirstlane(tid >> 6), lane = tid & 63, wr = wid >> 2, wc = wid & 3, fr = lane & 15, fq = lane >> 4;
    const int K = g.K, nt = K / BK;
    unsigned voffA[2], voffB[2];
#pragma unroll
    for (int i = 0; i < 2; ++i) { int R, C; stage_rc(tid * 16 + i * 8192, R, C); const int Rb = Epi::PERM ? ((R & ~31) + perm32(R & 31)) : R;
        voffA[i] = (unsigned)(R * g.lda + C) * 2u; voffB[i] = (unsigned)(Rb * K + C) * 2u; }
    const size_t kstep = (size_t)(BK * 2);
    const size_t hstepA = (size_t)HALF * g.lda * 2, hstepB = (size_t)HALF * K * 2;
    const size_t tstepA = 2 * hstepA, tstepB = 2 * hstepB;
    const unsigned ldsw = (unsigned)wid * 1024u;
    const int aoff = lds_byte(wr * 64 + fr, fq * 8), boff = lds_byte(wc * 32 + fr, fq * 8);
#define PG8_SA(b, h) (((b) * 2 + (h)) * HTB)
#define PG8_SB(b, h) ((4 + (b) * 2 + (h)) * HTB)
#define PG8_STAGE(bufoff, gbase, voff) do { _Pragma("unroll") for (int _i = 0; _i < 2; ++_i) \
        __builtin_amdgcn_global_load_lds((const unsigned*)((const char*)(gbase) + (voff)[_i]), (PG8_LAS unsigned*)(lds + (bufoff) + ldsw + _i * 8192), 16, 0, 0); } while (0)
#define PG8_LDA(dst, b, h) do { _Pragma("unroll") for (int m = 0; m < 4; ++m) _Pragma("unroll") for (int k = 0; k < 2; ++k) dst[m][k] = *(const PG8_LAS bf16x8*)(lds + PG8_SA(b, h) + aoff + m * 2048 + k * 1024); } while (0)
#define PG8_LDB(dst, b, h) do { _Pragma("unroll") for (int n = 0; n < 2; ++n) _Pragma("unroll") for (int k = 0; k < 2; ++k) dst[n][k] = *(const PG8_LAS bf16x8*)(lds + PG8_SB(b, h) + boff + n * 2048 + k * 1024); } while (0)
#define PG8_MMA(ai, bj, At, Bt) do { __builtin_amdgcn_s_setprio(1); _Pragma("unroll") for (int m = 0; m < 4; ++m) _Pragma("unroll") for (int n = 0; n < 2; ++n) _Pragma("unroll") for (int k = 0; k < 2; ++k) \
        acc[ai][bj][m][n] = __builtin_amdgcn_mfma_f32_16x16x32_bf16(Bt[n][k], At[m][k], acc[ai][bj][m][n], 0, 0, 0); __builtin_amdgcn_s_setprio(0); } while (0)
#define PG8_WAIT_V(n) asm volatile("s_waitcnt vmcnt(" #n ")" ::: "memory")
#define PG8_WAIT_L(n) asm volatile("s_waitcnt lgkmcnt(" #n ")" ::: "memory")
#define PG8_BAR __builtin_amdgcn_s_barrier()
#define PG8_SCHED __builtin_amdgcn_sched_barrier(0)
    Unit cur, nxt; int ui = 0;
    if (!S.next(0, cur)) return;
    f32x4 acc[2][2][4][2];
#pragma unroll
    for (int a = 0; a < 2; ++a)
#pragma unroll
        for (int b = 0; b < 2; ++b)
#pragma unroll
            for (int m = 0; m < 4; ++m)
#pragma unroll
                for (int n = 0; n < 2; ++n) acc[a][b][m][n] = (f32x4){0.f, 0.f, 0.f, 0.f};
    bf16x8 At[4][2], B0[2][2], B1[2][2];
    float epre[8];
    E.prefetch(epre, cur, wr, fr);
    const char* cA = (const char*)g.A + (size_t)cur.pm * tstepA; const char* cB = (const char*)g.Bt + (size_t)cur.pn * tstepB;
    S.a_ready(cur);
    if constexpr (SP2) {
        PG8_STAGE(PG8_SB(0, 0), cB, voffB); PG8_STAGE(PG8_SB(0, 1), cB + hstepB, voffB); PG8_STAGE(PG8_SA(0, 0), cA, voffA); PG8_STAGE(PG8_SA(0, 1), cA + hstepA, voffA);
        if (wr == 1) PG8_BAR;
        PG8_WAIT_V(2); PG8_BAR;
        PG8_STAGE(PG8_SB(1, 0), cB + kstep, voffB); PG8_STAGE(PG8_SA(1, 0), cA + kstep, voffA); PG8_STAGE(PG8_SB(1, 1), cB + hstepB + kstep, voffB);
        PG8_WAIT_V(6); PG8_BAR;
    } else {
        PG8_STAGE(PG8_SB(0, 0), cB, voffB); PG8_STAGE(PG8_SA(0, 0), cA, voffA); PG8_STAGE(PG8_SB(0, 1), cB + hstepB, voffB); PG8_STAGE(PG8_SA(0, 1), cA + hstepA, voffA);
        if (wr == 1) PG8_BAR;
        PG8_WAIT_V(4); PG8_BAR;
        PG8_STAGE(PG8_SB(1, 0), cB + kstep, voffB); PG8_STAGE(PG8_SA(1, 0), cA + kstep, voffA); PG8_STAGE(PG8_SB(1, 1), cB + hstepB + kstep, voffB);
        PG8_WAIT_V(6); PG8_BAR;
    }
    for (;;) {
        const bool has_next = S.next(ui + 1, nxt);
        const char* nA = has_next ? (const char*)g.A + (size_t)nxt.pm * tstepA : cA; const char* nB = has_next ? (const char*)g.Bt + (size_t)nxt.pn * tstepB : cB;
        for (int t = 0; t < nt; t += 2) {
            const bool last = (t == nt - 2);
            const char* a1 = cA + (size_t)(t + 1) * kstep;
            const char* a2 = last ? nA : cA + (size_t)(t + 2) * kstep; const char* b2 = last ? nB : cB + (size_t)(t + 2) * kstep;
            const char* a3 = a2 + kstep; const char* b3 = b2 + kstep;
            if (last && has_next) S.a_ready(nxt);
            if constexpr (SP2) {
            PG8_LDB(B0, 0, 0); PG8_LDB(B1, 0, 1); PG8_SCHED; PG8_LDA(At, 0, 0); PG8_STAGE(PG8_SA(1, 1), a1 + hstepA, voffA);
            PG8_WAIT_V(8); PG8_WAIT_L(0); PG8_BAR; PG8_MMA(0, 0, At, B0); PG8_MMA(0, 1, At, B1); PG8_BAR; PG8_SCHED;
            PG8_LDA(At, 0, 1); PG8_STAGE(PG8_SB(0, 0), b2, voffB); PG8_STAGE(PG8_SB(0, 1), b2 + hstepB, voffB); PG8_STAGE(PG8_SA(0, 0), a2, voffA);
            PG8_WAIT_V(8); PG8_WAIT_L(0); PG8_BAR; PG8_MMA(1, 0, At, B0); PG8_MMA(1, 1, At, B1); PG8_BAR; PG8_SCHED;
            PG8_LDB(B0, 1, 0); PG8_LDB(B1, 1, 1); PG8_SCHED; PG8_LDA(At, 1, 0); PG8_STAGE(PG8_SA(0, 1), a2 + hstepA, voffA);
            PG8_WAIT_V(8); PG8_WAIT_L(0); PG8_BAR; PG8_MMA(0, 0, At, B0); PG8_MMA(0, 1, At, B1); PG8_BAR; PG8_SCHED;
            PG8_LDA(At, 1, 1); PG8_STAGE(PG8_SB(1, 0), b3, voffB); PG8_STAGE(PG8_SB(1, 1), b3 + hstepB, voffB); PG8_STAGE(PG8_SA(1, 0), a3, voffA);
            PG8_WAIT_V(8); PG8_WAIT_L(0); PG8_BAR; PG8_MMA(1, 0, At, B0); PG8_MMA(1, 1, At, B1); PG8_BAR; PG8_SCHED;
            } else {
            PG8_LDB(B0, 0, 0); PG8_SCHED; PG8_LDA(At, 0, 0); PG8_STAGE(PG8_SA(1, 1), a1 + hstepA, voffA);
            PG8_WAIT_L(8); PG8_BAR; PG8_WAIT_L(0); PG8_MMA(0, 0, At, B0); PG8_BAR; PG8_SCHED;
            PG8_LDB(B1, 0, 1); PG8_STAGE(PG8_SB(0, 0), b2, voffB);
            PG8_BAR; PG8_WAIT_L(0); PG8_MMA(0, 1, At, B1); PG8_BAR;
            PG8_LDA(At, 0, 1); PG8_STAGE(PG8_SA(0, 0), a2, voffA);
            PG8_BAR; PG8_WAIT_L(0); PG8_MMA(1, 0, At, B0); PG8_BAR; PG8_SCHED;
            PG8_STAGE(PG8_SB(0, 1), b2 + hstepB, voffB);
            PG8_WAIT_V(6); PG8_BAR; PG8_MMA(1, 1, At, B1); PG8_BAR;
            PG8_LDB(B0, 1, 0); PG8_SCHED; PG8_LDA(At, 1, 0); PG8_STAGE(PG8_SA(0, 1), a2 + hstepA, voffA);
            PG8_WAIT_L(8); PG8_BAR; PG8_WAIT_L(0); PG8_MMA(0, 0, At, B0); PG8_BAR; PG8_SCHED;
            PG8_LDB(B1, 1, 1); PG8_STAGE(PG8_SB(1, 0), b3, voffB);
            PG8_BAR; PG8_WAIT_L(0); PG8_MMA(0, 1, At, B1); PG8_BAR;
            PG8_LDA(At, 1, 1); PG8_STAGE(PG8_SA(1, 0), a3, voffA);
            PG8_BAR; PG8_WAIT_L(0); PG8_MMA(1, 0, At, B0); PG8_BAR; PG8_SCHED;
            PG8_STAGE(PG8_SB(1, 1), b3 + hstepB, voffB);
            PG8_WAIT_V(6); PG8_BAR; PG8_MMA(1, 1, At, B1); PG8_BAR;
            }
        }
        if constexpr (ALIGN_EPI) { if (wr == 0) PG8_BAR; }
        if constexpr (!Epi::AFTER_DRAIN) { E(acc, cur, wr, wc, fr, fq, epre); S.done(cur); if (has_next) E.prefetch(epre, nxt, wr, fr); }
        if (!has_next) break;
#pragma unroll
        for (int a = 0; a < 2; ++a)
#pragma unroll
            for (int b = 0; b < 2; ++b)
#pragma unroll
                for (int m = 0; m < 4; ++m)
#pragma unroll
                    for (int n = 0; n < 2; ++n) acc[a][b][m][n] = (f32x4){0.f, 0.f, 0.f, 0.f};
        cur = nxt; cA = nA; cB = nB; ++ui;
        if constexpr (ALIGN_EPI) { if (wr == 1) PG8_BAR; }
    }
    PG8_WAIT_V(0);
    if constexpr (!ALIGN_EPI) { if (wr == 0) PG8_BAR; }
    PG8_BAR;
    if constexpr (Epi::AFTER_DRAIN) { E.fused(acc, cur, wr, wc, fr, fq, lds, wid, lane); S.done(cur); }
#undef PG8_SA
#undef PG8_SB
#undef PG8_STAGE
#undef PG8_LDA
#undef PG8_LDB
#undef PG8_MMA
#undef PG8_WAIT_V
#undef PG8_WAIT_L
#undef PG8_BAR
#undef PG8_SCHED
}
}

#define LAS __attribute__((address_space(3)))
typedef unsigned short bf16;
typedef short bf16x8 __attribute__((ext_vector_type(8)));
typedef float f32x4 __attribute__((ext_vector_type(4)));
typedef float f32x16 __attribute__((ext_vector_type(16)));
typedef unsigned u32x4 __attribute__((ext_vector_type(4)));
typedef unsigned u32x2 __attribute__((ext_vector_type(2)));
typedef short v4i16_t __attribute__((ext_vector_type(4)));
typedef float f32x2_t __attribute__((ext_vector_type(2)));
typedef __bf16 bf16x2_t __attribute__((ext_vector_type(2)));

constexpr int D_MODEL = 1024, BATCH = 32, SEQ = 2048, DEPTH = 4, MTOK = BATCH * SEQ, D_FF = 4096, A_WIDTH = 2048, NQKV = 3072;
constexpr float EPS = 1e-6f;
constexpr size_t MiB = 1u << 20;
constexpr size_t WS_WIN = 1 * MiB, WS_WOUTA = 17 * MiB, WS_WQKV = 25 * MiB, WS_WOB = 37 * MiB, WS_W1 = 41 * MiB, WS_W2 = 73 * MiB, WS_WC = 105 * MiB;
constexpr size_t WS_HN = 112 * MiB, WS_Z = 240 * MiB, WS_STAT = 752 * MiB, WS_XCH = 768 * MiB, WS_XSTAT = 769 * MiB, WS_CNT = 770 * MiB, WS_XCH2 = 771 * MiB, WS_END = 772 * MiB;
constexpr int LDS_BYTES = 147456, LDS_BST = 131072 + 1024;
constexpr size_t WS_BAR = 65536;
constexpr int NWAVES = 8;
#ifndef PROBE_MIX
#define PROBE_MIX 0
#endif
#ifndef PROBE_ATTN
#define PROBE_ATTN 0
#endif


__device__ __forceinline__ unsigned cvtpk(float lo, float hi) { f32x2_t v = {lo, hi}; bf16x2_t b = __builtin_convertvector(v, bf16x2_t); return __builtin_bit_cast(unsigned, b); }
__device__ __forceinline__ float bflo(unsigned w) { return __uint_as_float(w << 16); }
__device__ __forceinline__ float bfhi(unsigned w) { return __uint_as_float(w & 0xffff0000u); }
__device__ __forceinline__ float wave_sum(float v) {
#pragma unroll
    for (int o = 1; o < 64; o <<= 1) v += __shfl_xor(v, o);
    return v;
}
__device__ __forceinline__ int crow(int r, int hi) { return (r & 3) + 8 * (r >> 2) + 4 * hi; }
__device__ __forceinline__ v4i16_t tr_read(LAS unsigned char* p) { return __builtin_amdgcn_ds_read_tr16_b64_v4i16((LAS v4i16_t*)p); }

struct EpiAct {
    static constexpr bool PERM = true, AFTER_DRAIN = false;
    bf16* O; int ldc; int act; const float* rowstat; float* stat;
    __device__ __forceinline__ void prefetch(float (&pre)[8], const pg8::Unit& u, int wr, int fr) const {
        const int row0 = u.pm * pg8::BM + wr * 64 + fr;
#pragma unroll
        for (int ai = 0; ai < 2; ++ai)
#pragma unroll
            for (int m = 0; m < 4; ++m) pre[ai * 4 + m] = rowstat ? rowstat[row0 + ai * pg8::HALF + m * 16] : 1.f;
    }
    template <int MODE>
    __device__ __forceinline__ void run(pg8::f32x4 (&acc)[2][2][4][2], const pg8::Unit& u, int wr, int wc, int fr, int fq, const float (&pre)[8], float sc) const {
        using namespace pg8;
        const int row0 = u.pm * BM + wr * 64 + fr; const int col0 = u.pn * BM + wc * 32 + 8 * fq;
#pragma unroll
        for (int ai = 0; ai < 2; ++ai)
#pragma unroll
            for (int m = 0; m < 4; ++m) { bf16* rowp = O + (size_t)(row0 + ai * HALF + m * 16) * ldc + col0;
                float rs = 0.f, rq = 0.f; const float ps = pre[ai * 4 + m] * sc;
#pragma unroll
                for (int bj = 0; bj < 2; ++bj) { pg8::f32x4 v0 = acc[ai][bj][m][0] * ps, v1 = acc[ai][bj][m][1] * ps;
                    if (MODE == 1) { f32x2 a = gelu_pk((f32x2){v0[0], v0[1]}), b = gelu_pk((f32x2){v0[2], v0[3]}), c = gelu_pk((f32x2){v1[0], v1[1]}), d = gelu_pk((f32x2){v1[2], v1[3]});
                        v0 = (pg8::f32x4){a.x, a.y, b.x, b.y}; v1 = (pg8::f32x4){c.x, c.y, d.x, d.y};
                        rs += ((v0[0] + v0[1]) + (v0[2] + v0[3])) + ((v1[0] + v1[1]) + (v1[2] + v1[3]));
                        rq += ((v0[0] * v0[0] + v0[1] * v0[1]) + (v0[2] * v0[2] + v0[3] * v0[3])) + ((v1[0] * v1[0] + v1[1] * v1[1]) + (v1[2] * v1[2] + v1[3] * v1[3])); }
                    else if (MODE == 2) {
#pragma unroll
                        for (int e = 0; e < 4; ++e) { const float a = fmaxf(v0[e], 0.f), b = fmaxf(v1[e], 0.f); v0[e] = a * a; v1[e] = b * b; } }
                    pg8::u32x4 w; w.x = cvtpk(v0[0], v0[1]); w.y = cvtpk(v0[2], v0[3]); w.z = cvtpk(v1[0], v1[1]); w.w = cvtpk(v1[2], v1[3]);
                    *(pg8::u32x4*)(rowp + bj * HALF) = w; }
                if (MODE == 1) { rs += __shfl_xor(rs, 16); rs += __shfl_xor(rs, 32); rq += __shfl_xor(rq, 16); rq += __shfl_xor(rq, 32);
                    if (fq == 0) *(f32x2*)(stat + ((size_t)(row0 + ai * HALF + m * 16) * 32 + (u.pn - 8) * 4 + wc) * 2) = (f32x2){rs, rq}; } }
    }
    __device__ __forceinline__ void operator()(pg8::f32x4 (&acc)[2][2][4][2], const pg8::Unit& u, int wr, int wc, int fr, int fq, const float (&pre)[8]) const {
        asm volatile("" : "+v"(fr), "+v"(fq));
        const float sc = (act == 3 && u.pn * pg8::BM < 1024) ? 0.125f : 1.f;
        if (act == 2) run<2>(acc, u, wr, wc, fr, fq, pre, 1.f);
        else if (act == 1 && u.pn >= 8) run<1>(acc, u, wr, wc, fr, fq, pre, 1.f);
        else run<0>(acc, u, wr, wc, fr, fq, pre, sc);
    }
};

constexpr int LDS_P = 131072 + 2048, LDS_S = LDS_P + 4096, LDS_G = LDS_S + 1024;
struct EpiRes {
    static constexpr bool PERM = true, AFTER_DRAIN = false;
    bf16* XB; float* outf; float* xch; float* xch2; unsigned* cnt; unsigned* cnt2; float* rs; LAS unsigned char* lds;
    __device__ __forceinline__ void prefetch(float (&)[8], const pg8::Unit&, int, int) const {}
    __device__ __forceinline__ void wait32(unsigned* c) const {
        unsigned sp = 0u;
        while ((unsigned)__builtin_amdgcn_readfirstlane(__hip_atomic_load(c, __ATOMIC_RELAXED, __HIP_MEMORY_SCOPE_AGENT)) < 32u) { __builtin_amdgcn_s_sleep(1); if (++sp > (1u << 22)) break; }
        __builtin_amdgcn_fence(__ATOMIC_ACQUIRE, "agent");
    }
    __device__ __forceinline__ void operator()(pg8::f32x4 (&acc)[2][2][4][2], const pg8::Unit& u, int wr, int wc, int fr, int fq, const float (&)[8]) const {
        using namespace pg8;
        asm volatile("" : "+v"(fr), "+v"(fq));
        const int lane = fq * 16 + fr, wid = wr * 4 + wc;
        LAS float* P = (LAS float*)(lds + LDS_P); LAS float* S = (LAS float*)(lds + LDS_S); LAS float* Gs = (LAS float*)(lds + LDS_G);
        const int col0 = u.pn * BM + wc * 32 + 8 * fq;
#pragma unroll
        for (int ai = 0; ai < 2; ++ai)
#pragma unroll
            for (int m = 0; m < 4; ++m) { float q = 0.f;
#pragma unroll
                for (int bj = 0; bj < 2; ++bj)
#pragma unroll
                    for (int n = 0; n < 2; ++n) { const pg8::f32x4 v = acc[ai][bj][m][n]; q += (v[0] * v[0] + v[1] * v[1]) + (v[2] * v[2] + v[3] * v[3]); }
                q += __shfl_xor(q, 16); q += __shfl_xor(q, 32);
                if (fq == 0) P[(ai * HALF + wr * 64 + m * 16 + fr) * 4 + wc] = q; }
        asm volatile("s_waitcnt lgkmcnt(0)" ::: "memory"); __builtin_amdgcn_s_barrier(); asm volatile("" ::: "memory");
        const int row = wid * 32 + (lane & 31);
        if (lane < 32) { const pg8::f32x4 pp = *(LAS pg8::f32x4*)(P + row * 4);
            __hip_atomic_store(xch + ((size_t)(u.pm * BM + row) * 4 + u.pn), (pp[0] + pp[1]) + (pp[2] + pp[3]), __ATOMIC_RELAXED, __HIP_MEMORY_SCOPE_AGENT); }
        asm volatile("" ::: "memory");
        pg8::u32x4 xpre0[4][2], xpre1[4][2];
#pragma unroll
        for (int m = 0; m < 4; ++m)
#pragma unroll
            for (int bj = 0; bj < 2; ++bj) xpre0[m][bj] = *(const pg8::u32x4*)(XB + (size_t)(u.pm * BM + wr * 64 + m * 16 + fr) * 1024 + col0 + bj * HALF);
        asm volatile("" ::: "memory");
        asm volatile("s_waitcnt vmcnt(8)" ::: "memory");
        if (lane == 0) __hip_atomic_fetch_add(cnt + 64 * u.pm, 1u, __ATOMIC_RELAXED, __HIP_MEMORY_SCOPE_AGENT);
        if (wid == 0) wait32(cnt + 64 * u.pm);
        asm volatile("s_waitcnt vmcnt(0) lgkmcnt(0)" ::: "memory"); __builtin_amdgcn_s_barrier(); asm volatile("" ::: "memory");
        if (lane < 32) { const float* sl = xch + (size_t)(u.pm * BM + row) * 4; float t = 0.f;
#pragma unroll
            for (int k = 0; k < 4; ++k) t += __hip_atomic_load(sl + k, __ATOMIC_RELAXED, __HIP_MEMORY_SCOPE_AGENT);
            S[row] = 1.0f / sqrtf(t * (1.f / 1024.f) + 1e-6f); }
        asm volatile("s_waitcnt lgkmcnt(0)" ::: "memory"); __builtin_amdgcn_s_barrier(); asm volatile("" ::: "memory");
        pg8::f32x4 gp[2][2];
#pragma unroll
        for (int bj = 0; bj < 2; ++bj) { gp[bj][0] = *(LAS pg8::f32x4*)(Gs + col0 + bj * HALF); gp[bj][1] = *(LAS pg8::f32x4*)(Gs + col0 + bj * HALF + 4); }
#pragma unroll
        for (int ai = 0; ai < 2; ++ai) {
#pragma unroll
            for (int m = 0; m < 4; ++m) { const int r = ai * HALF + wr * 64 + m * 16 + fr; const float rsm = S[r]; const size_t off = (size_t)(u.pm * BM + r) * 1024 + col0; float q2 = 0.f;
#pragma unroll
                for (int bj = 0; bj < 2; ++bj) { const pg8::u32x4 xw = ai == 0 ? xpre0[m][bj] : xpre1[m][bj];
                    pg8::f32x4 x0 = {__uint_as_float(xw.x << 16), __uint_as_float(xw.x & 0xffff0000u), __uint_as_float(xw.y << 16), __uint_as_float(xw.y & 0xffff0000u)};
                    pg8::f32x4 x1 = {__uint_as_float(xw.z << 16), __uint_as_float(xw.z & 0xffff0000u), __uint_as_float(xw.w << 16), __uint_as_float(xw.w & 0xffff0000u)};
                    x0 = x0 + acc[ai][bj][m][0] * rsm * gp[bj][0]; x1 = x1 + acc[ai][bj][m][1] * rsm * gp[bj][1];
                    q2 += ((x0[0] * x0[0] + x0[1] * x0[1]) + (x0[2] * x0[2] + x0[3] * x0[3])) + ((x1[0] * x1[0] + x1[1] * x1[1]) + (x1[2] * x1[2] + x1[3] * x1[3]));
                    acc[ai][bj][m][0] = x0; acc[ai][bj][m][1] = x1; }
                if (ai == 0) {
#pragma unroll
                    for (int bj = 0; bj < 2; ++bj) xpre1[m][bj] = *(const pg8::u32x4*)(XB + (size_t)(u.pm * BM + HALF + wr * 64 + m * 16 + fr) * 1024 + col0 + bj * HALF);
                    asm volatile("" ::: "memory"); }
                q2 += __shfl_xor(q2, 16); q2 += __shfl_xor(q2, 32);
                if (fq == 0) P[r * 4 + wc] = q2; }
            asm volatile("" ::: "memory"); }
        asm volatile("s_waitcnt lgkmcnt(0)" ::: "memory"); __builtin_amdgcn_s_barrier(); asm volatile("" ::: "memory");
        if (lane < 32) { const pg8::f32x4 pp = *(LAS pg8::f32x4*)(P + row * 4);
            __hip_atomic_store(xch2 + ((size_t)(u.pm * BM + row) * 4 + u.pn), (pp[0] + pp[1]) + (pp[2] + pp[3]), __ATOMIC_RELAXED, __HIP_MEMORY_SCOPE_AGENT); }
        asm volatile("s_waitcnt vmcnt(0)" ::: "memory");
        if (lane == 0) __hip_atomic_fetch_add(cnt2 + 64 * u.pm, 1u, __ATOMIC_RELAXED, __HIP_MEMORY_SCOPE_AGENT);
#pragma unroll
        for (int ai = 0; ai < 2; ++ai)
#pragma unroll
            for (int m = 0; m < 4; ++m) { const size_t off = (size_t)(u.pm * BM + ai * HALF + wr * 64 + m * 16 + fr) * 1024 + col0;
#pragma unroll
                for (int bj = 0; bj < 2; ++bj) { const pg8::f32x4 x0 = acc[ai][bj][m][0], x1 = acc[ai][bj][m][1];
                    if (outf) { *(pg8::f32x4*)(outf + off + bj * HALF) = x0; *(pg8::f32x4*)(outf + off + bj * HALF + 4) = x1; }
                    else { pg8::u32x4 w; w.x = cvtpk(x0[0], x0[1]); w.y = cvtpk(x0[2], x0[3]); w.z = cvtpk(x1[0], x1[1]); w.w = cvtpk(x1[2], x1[3]); *(pg8::u32x4*)(XB + off + bj * HALF) = w; } } }
        if (u.pn == (u.pm & 3)) {
            if (wid == 0) wait32(cnt2 + 64 * u.pm);
            asm volatile("s_waitcnt vmcnt(0) lgkmcnt(0)" ::: "memory"); __builtin_amdgcn_s_barrier(); asm volatile("" ::: "memory");
            if (lane < 32) { const float* sl = xch2 + (size_t)(u.pm * BM + row) * 4; float t = 0.f;
#pragma unroll
                for (int k = 0; k < 4; ++k) t += __hip_atomic_load(sl + k, __ATOMIC_RELAXED, __HIP_MEMORY_SCOPE_AGENT);
                rs[u.pm * BM + row] = 1.0f / sqrtf(t * (1.f / 1024.f) + 1e-6f); }
        }
    }
};

__device__ __forceinline__ void transpose_item(const float* W, const float* gk, int K, int N, bf16* WT, LAS float* scr, int item, int lane) {
    const int nblk = N / 32, kb = item / nblk, nb = item % nblk, k0 = 64 * kb, n0 = 32 * nb;
#pragma unroll
    for (int i = 0; i < 32; ++i) { const int kk = 2 * i + (lane >> 5); const float gv = gk ? gk[k0 + kk] : 1.f; scr[kk * 33 + (lane & 31)] = W[(size_t)(k0 + kk) * N + n0 + (lane & 31)] * gv; }
    asm volatile("s_waitcnt lgkmcnt(0)" ::: "memory");
    const int c = lane & 7;
#pragma unroll
    for (int j = 0; j < 4; ++j) { const int n = (lane >> 3) + 8 * j; const LAS float* s = scr + (8 * c) * 33 + n;
        u32x4 o; o.x = cvtpk(s[0 * 33], s[1 * 33]); o.y = cvtpk(s[2 * 33], s[3 * 33]); o.z = cvtpk(s[4 * 33], s[5 * 33]); o.w = cvtpk(s[6 * 33], s[7 * 33]);
        *(u32x4*)(WT + (size_t)(n0 + n) * K + k0 + 8 * c) = o; }
    asm volatile("s_waitcnt lgkmcnt(0)" ::: "memory");
}
__device__ __forceinline__ void transpose_matrix(const float* W, const float* gk, int K, int N, bf16* WT, LAS float* scr, int gw, int ngw, int lane) {
    const int items = (K / 64) * (N / 32);
    for (int it = gw; it < items; it += ngw) transpose_item(W, gk, K, N, WT, scr, it, lane);
}

__device__ __forceinline__ void x_to_bf16(const float* xin, bf16* xb, float* xstat, int wave, int lane) {
    const int gw = blockIdx.x * NWAVES + wave, ngw = gridDim.x * NWAVES;
    for (int m0 = gw * 4; m0 < MTOK; m0 += ngw * 4) {
        f32x4 v[4][4];
#pragma unroll
        for (int r = 0; r < 4; ++r) { const f32x4* xr = (const f32x4*)(xin + (size_t)(m0 + r) * D_MODEL) + lane;
#pragma unroll
            for (int j = 0; j < 4; ++j) v[r][j] = xr[64 * j]; }
#pragma unroll
        for (int r = 0; r < 4; ++r) { float ss = 0.f;
#pragma unroll
            for (int j = 0; j < 4; ++j) ss += (v[r][j].x * v[r][j].x + v[r][j].y * v[r][j].y) + (v[r][j].z * v[r][j].z + v[r][j].w * v[r][j].w);
            ss = wave_sum(ss);
            u32x2* ho = (u32x2*)(xb + (size_t)(m0 + r) * D_MODEL) + lane;
#pragma unroll
            for (int j = 0; j < 4; ++j) { u32x2 w; w.x = cvtpk(v[r][j].x, v[r][j].y); w.y = cvtpk(v[r][j].z, v[r][j].w); ho[64 * j] = w; }
            if (lane == 0) xstat[m0 + r] = 1.0f / sqrtf(ss * (1.f / D_MODEL) + EPS); }
    }
}

__device__ __forceinline__ void row_pass(bf16* xb, const bf16* mo, const float* gpost, float* outf, float* xstat, int wave, int lane) {
    const int gw = blockIdx.x * NWAVES + wave, ngw = gridDim.x * NWAVES;
    f32x4 gp[4];
#pragma unroll
    for (int j = 0; j < 4; ++j) gp[j] = *((const f32x4*)gpost + lane + 64 * j);
    for (int m0 = gw * 4; m0 < MTOK; m0 += ngw * 4) {
        u32x2 xw[4][4], mw[4][4];
#pragma unroll
        for (int r = 0; r < 4; ++r) { const u32x2* xr = (const u32x2*)(xb + (size_t)(m0 + r) * D_MODEL) + lane; const u32x2* mr = (const u32x2*)(mo + (size_t)(m0 + r) * D_MODEL) + lane;
#pragma unroll
            for (int j = 0; j < 4; ++j) { xw[r][j] = xr[64 * j]; mw[r][j] = mr[64 * j]; } }
#pragma unroll
        for (int r = 0; r < 4; ++r) {
            const int m = m0 + r;
            f32x4 mv[4], v[4]; float ss = 0.f;
#pragma unroll
            for (int j = 0; j < 4; ++j) { mv[j] = (f32x4){bflo(mw[r][j].x), bfhi(mw[r][j].x), bflo(mw[r][j].y), bfhi(mw[r][j].y)}; v[j] = (f32x4){bflo(xw[r][j].x), bfhi(xw[r][j].x), bflo(xw[r][j].y), bfhi(xw[r][j].y)};
                ss += (mv[j].x * mv[j].x + mv[j].y * mv[j].y) + (mv[j].z * mv[j].z + mv[j].w * mv[j].w); }
            const float rstd = 1.0f / sqrtf(wave_sum(ss) * (1.f / D_MODEL) + EPS);
            float s2 = 0.f;
#pragma unroll
            for (int j = 0; j < 4; ++j) { v[j] = v[j] + mv[j] * rstd * gp[j]; s2 += (v[j].x * v[j].x + v[j].y * v[j].y) + (v[j].z * v[j].z + v[j].w * v[j].w); }
            s2 = wave_sum(s2);
            if (outf) { f32x4* xo = (f32x4*)(outf + (size_t)m * D_MODEL) + lane;
#pragma unroll
                for (int j = 0; j < 4; ++j) xo[64 * j] = v[j]; }
            else { u32x2* ho = (u32x2*)(xb + (size_t)m * D_MODEL) + lane;
#pragma unroll
                for (int j = 0; j < 4; ++j) { u32x2 w; w.x = cvtpk(v[j].x, v[j].y); w.y = cvtpk(v[j].z, v[j].w); ho[64 * j] = w; }
                if (lane == 0) xstat[m] = 1.0f / sqrtf(s2 * (1.f / D_MODEL) + EPS); }
        }
    }
}

__device__ __forceinline__ void mix_phase(bf16* Z, bf16* Gout, int ldg, const float* stat, const float* vg, const float* vbias, const bf16* Wc, const float* bs, LAS unsigned char* lds, int tid, int wave, int lane) {
    constexpr int LD = 4096, PITCH = 576, WPITCH = 272, OFF_W = 128 * PITCH, OFF_ST = OFF_W + 128 * WPITCH;
    LAS float* st = (LAS float*)(lds + OFF_ST);
    const int nper = gridDim.x >> 3, g = blockIdx.x & 7, ci = blockIdx.x >> 3;
    if (nper == 0 || ci >= nper) return;
    const int r32 = lane & 31, hi = lane >> 5;
    const int troff = (8 * hi + ((lane & 15) >> 2)) * PITCH + (32 * wave + 16 * ((lane >> 4) & 1) + 4 * (lane & 3)) * 2;
#pragma unroll
    for (int it = 0; it < 4; ++it) { const int idx = it * 512 + tid, row = idx >> 4, ch = idx & 15;
        *(LAS u32x4*)(lds + OFF_W + row * WPITCH + ch * 16) = *(const u32x4*)(Wc + ((size_t)g * 128 + row) * 128 + ch * 8); }
    const int vrow = tid >> 5, vch = tid & 31;
    const f32x4 g0 = *(const f32x4*)(vg + g * 256 + vch * 8), g1 = *(const f32x4*)(vg + g * 256 + vch * 8 + 4);
    const f32x4 b0 = *(const f32x4*)(vbias + g * 256 + vch * 8), b1 = *(const f32x4*)(vbias + g * 256 + vch * 8 + 4);
    const int srow = tid >> 2, sq = tid & 3;
    float bsr[4];
#pragma unroll
    for (int tb = 0; tb < 4; ++tb) bsr[tb] = bs[g * 128 + tb * 32 + r32];
    u32x4 rawv[8]; f32x4 stp[4];
    { const size_t row0 = (size_t)ci * 128;
#pragma unroll
      for (int it = 0; it < 8; ++it) rawv[it] = *(const u32x4*)(Z + (row0 + it * 16 + vrow) * LD + 2048 + g * 256 + vch * 8);
#pragma unroll
      for (int k = 0; k < 4; ++k) stp[k] = *(const f32x4*)(stat + ((row0 + srow) * 32 + sq * 8 + k * 2) * 2); }
    for (int chunk = ci; chunk < MTOK / 128; chunk += nper) {
        const size_t row0 = (size_t)chunk * 128;
        bf16* up = Z + (row0 + r32) * LD + g * 256 + 32 * wave + 4 * hi;
        bf16* gp = Gout + (row0 + r32) * ldg + g * 256 + 32 * wave + 4 * hi;
        u32x2 uw[4][4];
#pragma unroll
        for (int tb = 0; tb < 4; ++tb)
#pragma unroll
            for (int g4 = 0; g4 < 4; ++g4) uw[tb][g4] = *(const u32x2*)(up + (size_t)tb * 32 * LD + 8 * g4);
        { float s = (stp[0].x + stp[0].z) + (stp[1].x + stp[1].z) + (stp[2].x + stp[2].z) + (stp[3].x + stp[3].z);
          float q = (stp[0].y + stp[0].w) + (stp[1].y + stp[1].w) + (stp[2].y + stp[2].w) + (stp[3].y + stp[3].w);
          s += __shfl_xor(s, 1); s += __shfl_xor(s, 2); q += __shfl_xor(q, 1); q += __shfl_xor(q, 2);
          const float mean = s * (1.f / 2048.f), var = fmaxf(q * (1.f / 2048.f) - mean * mean, 0.f);
          if (sq == 0) { st[2 * srow] = mean; st[2 * srow + 1] = 1.0f / sqrtf(var + EPS); } }
        __syncthreads();
#pragma unroll
        for (int it = 0; it < 8; ++it) {
            const int row = it * 16 + vrow; const u32x4 w = rawv[it];
            const float mean = st[2 * row], rstd = st[2 * row + 1];
            u32x4 o;
            o.x = cvtpk((bflo(w.x) - mean) * rstd * g0.x + b0.x, (bfhi(w.x) - mean) * rstd * g0.y + b0.y);
            o.y = cvtpk((bflo(w.y) - mean) * rstd * g0.z + b0.z, (bfhi(w.y) - mean) * rstd * g0.w + b0.w);
            o.z = cvtpk((bflo(w.z) - mean) * rstd * g1.x + b1.x, (bfhi(w.z) - mean) * rstd * g1.y + b1.y);
            o.w = cvtpk((bflo(w.w) - mean) * rstd * g1.z + b1.z, (bfhi(w.w) - mean) * rstd * g1.w + b1.w);
            *(LAS u32x4*)(lds + row * PITCH + vch * 16) = o;
        }
        __syncthreads();
        if (chunk + nper < MTOK / 128) { const size_t nrow0 = (size_t)(chunk + nper) * 128;
#pragma unroll
            for (int it = 0; it < 8; ++it) rawv[it] = *(const u32x4*)(Z + (nrow0 + it * 16 + vrow) * LD + 2048 + g * 256 + vch * 8);
#pragma unroll
            for (int k = 0; k < 4; ++k) stp[k] = *(const f32x4*)(stat + ((nrow0 + srow) * 32 + sq * 8 + k * 2) * 2); }
        bf16x8 af[8];
#pragma unroll
        for (int ks = 0; ks < 8; ++ks) { const v4i16_t lo = tr_read(lds + troff + (16 * ks) * PITCH), h4 = tr_read(lds + troff + (16 * ks + 4) * PITCH);
            af[ks] = (bf16x8){lo[0], lo[1], lo[2], lo[3], h4[0], h4[1], h4[2], h4[3]}; }
#pragma unroll
        for (int tb = 0; tb < 4; ++tb) {
            f32x16 acc = {};
            LAS unsigned char* wp = lds + OFF_W + (tb * 32 + r32) * WPITCH + 16 * hi;
#pragma unroll
            for (int ks = 0; ks < 2 * (tb + 1); ++ks) { const bf16x8 bfrag = *(LAS bf16x8*)(wp + 32 * ks); acc = __builtin_amdgcn_mfma_f32_32x32x16_bf16(af[ks], bfrag, acc, 0, 0, 0); }
            const float bsv = bsr[tb];
#pragma unroll
            for (int g4 = 0; g4 < 4; ++g4) { const u32x2 u2 = uw[tb][g4]; u32x2 ow;
                const pg8::f32x2 ua = pg8::gelu_pk((pg8::f32x2){bflo(u2.x), bfhi(u2.x)}), ub = pg8::gelu_pk((pg8::f32x2){bflo(u2.y), bfhi(u2.y)});
                ow.x = cvtpk(ua.x * (acc[4 * g4] + bsv), ua.y * (acc[4 * g4 + 1] + bsv));
                ow.y = cvtpk(ub.x * (acc[4 * g4 + 2] + bsv), ub.y * (acc[4 * g4 + 3] + bsv));
                *(u32x2*)(gp + (size_t)tb * 32 * ldg + 8 * g4) = ow; }
        }
        __syncthreads();
    }
}

template <bool DIAG>
__device__ __forceinline__ void attn_tile(f32x16& o0, f32x16& o1, float& carry2, const bf16x8 (&qr)[4], bf16x8 (&kf)[4], u32x4 (&vr)[4], const bf16* kpn, const bf16* vpn, bool has_next,
                                          LAS unsigned char* vcur, int troff, int strow, int stch, int r32, int hi) {
    constexpr int LD = NQKV; constexpr float LOG2E = 1.4426950408889634f;
#pragma unroll
    for (int it = 0; it < 4; ++it) *(LAS u32x4*)(vcur + (it * 8 + strow) * 192 + stch * 16) = vr[it];
    f32x16 p = {};
#pragma unroll
    for (int s = 0; s < 4; ++s) p = __builtin_amdgcn_mfma_f32_32x32x16_bf16(kf[s], qr[s], p, 0, 0, 0);
    (void)has_next;
#pragma unroll
    for (int s = 0; s < 4; ++s) { kf[s] = *(const bf16x8*)(kpn + 16 * s); vr[s] = *(const u32x4*)(vpn + (size_t)s * 8 * LD); }
    float kp[16], be[16];
#pragma unroll
    for (int r = 0; r < 16; ++r) { const float z = __builtin_amdgcn_fmed3f(p[r], -80.f, 3.0e38f);
        const float t = __builtin_amdgcn_exp2f(z * -LOG2E); be[r] = __builtin_amdgcn_rcpf(1.f + t); kp[r] = t * be[r];
        if (DIAG) { const bool msk = crow(r, hi) >= r32; kp[r] = msk ? 1.f : kp[r]; be[r] = msk ? 0.f : be[r]; } }
    float se[16], G[4], oth[4], T[4];
#pragma unroll
    for (int g = 0; g < 4; ++g) { se[4 * g + 3] = 1.f; se[4 * g + 2] = kp[4 * g + 3]; se[4 * g + 1] = se[4 * g + 2] * kp[4 * g + 2]; se[4 * g] = se[4 * g + 1] * kp[4 * g + 1]; G[g] = se[4 * g] * kp[4 * g]; }
#pragma unroll
    for (int g = 0; g < 4; ++g) {
        const auto rr = __builtin_amdgcn_permlane32_swap(__float_as_uint(G[g]), __float_as_uint(G[g]), false, false);
        oth[g] = __uint_as_float(rr[1]); T[g] = __uint_as_float(rr[0]) * __uint_as_float(rr[1]); }
    const float C = __builtin_amdgcn_exp2f(carry2);
    float base[4]; const float a2 = T[3], a1 = T[3] * T[2], a0 = a1 * T[1];
    base[3] = C; base[2] = C * a2; base[1] = C * a1; base[0] = C * a0;
    if (hi == 0) {
#pragma unroll
        for (int g = 0; g < 4; ++g) base[g] *= oth[g]; }
    carry2 += __builtin_amdgcn_logf(a0 * T[0]);
    float a[16];
#pragma unroll
    for (int r = 0; r < 16; ++r) a[r] = be[r] * (se[r] * base[r >> 2]);
    u32x4 pw0, pw1;
    pw0.x = cvtpk(a[0], a[1]); pw0.y = cvtpk(a[2], a[3]); pw0.z = cvtpk(a[4], a[5]); pw0.w = cvtpk(a[6], a[7]);
    pw1.x = cvtpk(a[8], a[9]); pw1.y = cvtpk(a[10], a[11]); pw1.z = cvtpk(a[12], a[13]); pw1.w = cvtpk(a[14], a[15]);
    const bf16x8 pf0 = __builtin_bit_cast(bf16x8, pw0), pf1 = __builtin_bit_cast(bf16x8, pw1);
    asm volatile("" ::: "memory");
#pragma unroll
    for (int dh = 0; dh < 2; ++dh)
#pragma unroll
        for (int s = 0; s < 2; ++s) {
            const v4i16_t lo = tr_read(vcur + troff + (16 * s) * 192 + dh * 64), h4 = tr_read(vcur + troff + (16 * s + 8) * 192 + dh * 64);
            const bf16x8 vf = (bf16x8){lo[0], lo[1], lo[2], lo[3], h4[0], h4[1], h4[2], h4[3]};
            if (dh == 0) o0 = __builtin_amdgcn_mfma_f32_32x32x16_bf16(vf, s == 0 ? pf0 : pf1, o0, 0, 0, 0);
            else o1 = __builtin_amdgcn_mfma_f32_32x32x16_bf16(vf, s == 0 ? pf0 : pf1, o1, 0, 0, 0);
        }
    asm volatile("" ::: "memory");
}
__device__ __forceinline__ void attn_phase(bf16* QKV, bf16* Oout, int ldo, LAS unsigned char* lds, int wave, int lane) {
    constexpr int LD = NQKV;
    const int r32 = lane & 31, hi = lane >> 5;
    LAS unsigned char* vb = lds + wave * 12288;
    const int vcu = (gridDim.x % 8 == 0) ? (int)((blockIdx.x & 7) * (gridDim.x >> 3) + (blockIdx.x >> 3)) : (int)blockIdx.x;
    const int gw = vcu * NWAVES + wave, ngw = gridDim.x * NWAVES;
    const int troff = (4 * hi + ((lane & 15) >> 2)) * 192 + (16 * ((lane >> 4) & 1) + 4 * (lane & 3)) * 2;
    const int strow = lane >> 3, stch = lane & 7;
#define ATT_UNIT(unit_) const int bh = (unit_) >> 6, qb = ((unit_) + 8 * (bh >> 5)) & 63, h = bh & 15, b = bh >> 4;     \
        const size_t rowbase = (size_t)b * SEQ; \
        const bf16* qp = QKV + (rowbase + qb * 32 + r32) * LD + h * 64; \
        const bf16* kbase = QKV + (rowbase + r32) * LD + 1024 + h * 64 + 8 * hi; \
        const bf16* vbase = QKV + (rowbase + strow) * LD + 2048 + h * 64 + stch * 8;
#define ATT_LOAD(Q_) do { const bf16* kp = kbase + (size_t)qb * 32 * LD; const bf16* vp = vbase + (size_t)qb * 32 * LD; \
        _Pragma("unroll") for (int s = 0; s < 4; ++s) Q_[s] = *(const bf16x8*)(qp + 16 * s + 8 * hi); \
        _Pragma("unroll") for (int s = 0; s < 4; ++s) { kf[s] = *(const bf16x8*)(kp + 16 * s); vr[s] = *(const u32x4*)(vp + (size_t)s * 8 * LD); } } while (0)
    const int nunits = BATCH * 16 * 64;
    bf16x8 qr[4], kf[4]; u32x4 vr[4];
    if (gw < nunits) { ATT_UNIT(gw) ATT_LOAD(qr); }
    for (int unit = gw; unit < nunits; unit += ngw) {
        ATT_UNIT(unit)
        f32x16 o0 = {}, o1 = {};
        float carry2 = 0.f;
        attn_tile<true>(o0, o1, carry2, qr, kf, vr, kbase + (size_t)(qb > 0 ? qb - 1 : 0) * 32 * LD, vbase + (size_t)(qb > 0 ? qb - 1 : 0) * 32 * LD, qb > 0, vb, troff, strow, stch, r32, hi);
        int buf = 1;
        for (int kt = qb - 1; kt >= 0; --kt) {
            if (__all(carry2 <= -150.f)) break;
            attn_tile<false>(o0, o1, carry2, qr, kf, vr, kbase + (size_t)(kt > 0 ? kt - 1 : 0) * 32 * LD, vbase + (size_t)(kt > 0 ? kt - 1 : 0) * 32 * LD, kt > 0, vb + buf * 6144, troff, strow, stch, r32, hi);
            buf ^= 1;
        }
        if (unit + ngw < nunits) { const int nu = unit + ngw; { ATT_UNIT(nu) ATT_LOAD(qr); } }
        bf16* op = Oout + (rowbase + qb * 32 + r32) * ldo + h * 64;
#pragma unroll
        for (int g = 0; g < 4; ++g) {
            u32x2 w0, w1;
            w0.x = cvtpk(o0[4 * g], o0[4 * g + 1]); w0.y = cvtpk(o0[4 * g + 2], o0[4 * g + 3]);
            w1.x = cvtpk(o1[4 * g], o1[4 * g + 1]); w1.y = cvtpk(o1[4 * g + 2], o1[4 * g + 3]);
            *(u32x2*)(op + 8 * g + 4 * hi) = w0; *(u32x2*)(op + 32 + 8 * g + 4 * hi) = w1;
        }
    }
#undef ATT_UNIT
#undef ATT_LOAD
}

#define XB_TMO      128
#define XB_XCNT(j)  (256  + 64 * (j))
#define XB_XSUB(j)  (1280 + 64 * (j))
#define XB_XGEN(j)  (2304 + 64 * (j))
#define XB_TOP      3328
#define XB_TOPGEN   3392
#define XCD_BAR_WORDS 3456
#define XB_SPIN_CAP (1u << 18)

__device__ __forceinline__ unsigned xb_ld(unsigned* p)              { return __hip_atomic_load(p, __ATOMIC_RELAXED, __HIP_MEMORY_SCOPE_AGENT); }
__device__ __forceinline__ unsigned xb_add(unsigned* p, unsigned v) { return __hip_atomic_fetch_add(p, v, __ATOMIC_RELAXED, __HIP_MEMORY_SCOPE_AGENT); }
__device__ __forceinline__ unsigned xb_xcc_id() { return (unsigned)__builtin_amdgcn_s_getreg((3 << 11) | 20) & 0xFu; }
#define XB_SPIN(cond, bar) do { unsigned _sp = 0; while (cond) { __builtin_amdgcn_s_sleep(1); \
    if ((++_sp & 255u) == 0u) { if (xb_ld(&(bar)[XB_TMO])) break; if (_sp > XB_SPIN_CAP) { atomicAdd(&(bar)[XB_TMO], 1u); break; } } } } while (0)

struct XcdBarrier {
    unsigned* bar; unsigned x;
    volatile LAS unsigned* st;
};

__device__ __forceinline__ XcdBarrier xcd_barrier_post(unsigned* bar, volatile LAS unsigned* st) {
    XcdBarrier b; b.bar = bar; b.x = xb_xcc_id(); b.st = st;
    if (threadIdx.x == 0) (void)xb_add(&bar[XB_XCNT(b.x)], 1u);
    return b;
}
__device__ __forceinline__ void xcd_barrier_complete(unsigned* bar, unsigned x, unsigned& nloc, unsigned& nx) {
    const unsigned G = gridDim.x * gridDim.y * gridDim.z;
    unsigned sum, cnt, mine, sp = 0u;
    for (;;) {
        sum = 0u; cnt = 0u; mine = 0u;
#pragma unroll
        for (unsigned j = 0; j < 16; ++j) { const unsigned c = xb_ld(&bar[XB_XCNT(j)]); sum += c; cnt += (c > 0u) ? 1u : 0u; mine = (j == x) ? c : mine; }
        if (sum == G) break;
        __builtin_amdgcn_s_sleep(1);
        if ((++sp & 255u) == 0u) { if (xb_ld(&bar[XB_TMO])) break; if (sp > XB_SPIN_CAP) { atomicAdd(&bar[XB_TMO], 1u); break; } }
    }
    nloc = mine > 0u ? mine : 1u; nx = cnt > 0u ? cnt : 1u;
}

__device__ __forceinline__ void xcd_barrier(const XcdBarrier& b) {
    asm volatile("s_waitcnt vmcnt(0)" ::: "memory");
    __syncthreads();
    if (threadIdx.x == 0) {
        unsigned* bar = b.bar;
        __builtin_amdgcn_s_waitcnt(0);
        unsigned nloc = b.st[0], nx = b.st[1];
        if (nloc == 0u) { xcd_barrier_complete(bar, b.x, nloc, nx); b.st[0] = nloc; b.st[1] = nx; }
        const unsigned old = xb_add(&bar[XB_XSUB(b.x)], 1u);
        const unsigned gen = old / nloc;
        if (old + 1u == (gen + 1u) * nloc) {
            __builtin_amdgcn_fence(__ATOMIC_RELEASE, "agent");
            asm volatile("s_waitcnt vmcnt(0)" ::: "memory");
            const unsigned og = xb_add(&bar[XB_TOP], 1u);
            const unsigned tg = og / nx;
            if (og + 1u == (tg + 1u) * nx) xb_add(&bar[XB_TOPGEN], 1u);
            else XB_SPIN(xb_ld(&bar[XB_TOPGEN]) == tg, bar);
            __builtin_amdgcn_fence(__ATOMIC_ACQUIRE, "agent");
            xb_add(&bar[XB_XGEN(b.x)], 1u);
            asm volatile("s_waitcnt vmcnt(0)" ::: "memory");
        } else {
            XB_SPIN(xb_ld(&bar[XB_XGEN(b.x)]) == gen, bar);
            __builtin_amdgcn_fence(__ATOMIC_ACQUIRE, "agent");
            asm volatile("s_waitcnt vmcnt(0)" ::: "memory");
        }
    }
    __syncthreads();
}

struct Params { const float* in[15]; float* out; unsigned char* ws; };

__global__ void __launch_bounds__(NWAVES * 64, 2) fwd_kernel(Params p) {
    extern __shared__ __attribute__((aligned(16))) unsigned char lds_raw[];
    cg::grid_group grid = cg::this_grid();
    LAS unsigned char* lds = (LAS unsigned char*)lds_raw;
    unsigned char* ws = p.ws;
    const float* x = p.in[0]; const float* n_mix_pre = p.in[1]; const float* n_mix_post = p.in[2]; const float* n_ffn_pre = p.in[3]; const float* n_ffn_post = p.in[4];
    const float* a_v_g = p.in[6]; const float* a_v_b = p.in[7]; const float* a_w_s = p.in[8]; const float* a_b_s = p.in[9];
    bf16* Win_t = (bf16*)(ws + WS_WIN); bf16* Wouta_t = (bf16*)(ws + WS_WOUTA); bf16* Wqkv_t = (bf16*)(ws + WS_WQKV); bf16* Wob_t = (bf16*)(ws + WS_WOB);
    bf16* W1_t = (bf16*)(ws + WS_W1); bf16* W2_t = (bf16*)(ws + WS_W2); bf16* Wc = (bf16*)(ws + WS_WC);
    bf16* XB = (bf16*)(ws + WS_HN); bf16* Z = (bf16*)(ws + WS_Z); float* STAT = (float*)(ws + WS_STAT);
    float* XCH = (float*)(ws + WS_XCH); float* XCH2 = (float*)(ws + WS_XCH2); float* XSTAT = (float*)(ws + WS_XSTAT); unsigned* CNT = (unsigned*)(ws + WS_CNT);
    float* out = p.out;
    unsigned* barw = (unsigned*)(ws + WS_BAR);
    volatile LAS unsigned* bst = (volatile LAS unsigned*)(lds + LDS_BST);
    if (threadIdx.x == 0) { bst[0] = 0u; bst[1] = 0u; }
    if (blockIdx.x == 0) for (int i = threadIdx.x; i < XCD_BAR_WORDS; i += NWAVES * 64) __hip_atomic_store(barw + i, 0u, __ATOMIC_RELAXED, __HIP_MEMORY_SCOPE_AGENT);
    __syncthreads();

    {
        const int tid = threadIdx.x, lane = tid & 63, wave = __builtin_amdgcn_readfirstlane(tid >> 6);
        const int gw = blockIdx.x * NWAVES + wave, ngw = gridDim.x * NWAVES;
        for (int i = blockIdx.x * 512 + tid; i < 16 * 256 * 64; i += gridDim.x * 512) __hip_atomic_store(CNT + i, 0u, __ATOMIC_RELAXED, __HIP_MEMORY_SCOPE_AGENT);
        LAS float* scr = (LAS float*)(lds + wave * 16384);
        for (int l = 0; l < 2; ++l) {
            transpose_matrix(p.in[5] + (size_t)l * 1024 * 4096, n_mix_pre + (2 * l) * 1024, 1024, 4096, Win_t + (size_t)l * 4096 * 1024, scr, gw, ngw, lane);
            transpose_matrix(p.in[10] + (size_t)l * 2048 * 1024, nullptr, 2048, 1024, Wouta_t + (size_t)l * 1024 * 2048, scr, gw, ngw, lane);
            transpose_matrix(p.in[11] + (size_t)l * 1024 * 3072, n_mix_pre + (2 * l + 1) * 1024, 1024, 3072, Wqkv_t + (size_t)l * 3072 * 1024, scr, gw, ngw, lane);
            transpose_matrix(p.in[12] + (size_t)l * 1024 * 1024, nullptr, 1024, 1024, Wob_t + (size_t)l * 1024 * 1024, scr, gw, ngw, lane);
        }
        for (int l = 0; l < 4; ++l) {
            transpose_matrix(p.in[13] + (size_t)l * 1024 * 4096, n_ffn_pre + l * 1024, 1024, 4096, W1_t + (size_t)l * 4096 * 1024, scr, gw, ngw, lane);
            transpose_matrix(p.in[14] + (size_t)l * 4096 * 1024, nullptr, 4096, 1024, W2_t + (size_t)l * 1024 * 4096, scr, gw, ngw, lane);
        }
        for (int i = blockIdx.x * 512 + tid; i < 2 * 8 * 128 * 128; i += gridDim.x * 512) { const int s = i & 127, t = (i >> 7) & 127; Wc[i] = (s <= t) ? (bf16)(cvtpk(a_w_s[i], 0.f) & 0xffffu) : (bf16)0; }
        x_to_bf16(x, XB, XSTAT, wave, lane);
    }
    grid.sync();
    const XcdBarrier xbar = xcd_barrier_post(barw, bst);

#pragma unroll 1
    for (int ph = 0; ph < 20; ++ph) {
        const int layer = ph / 5, step = ph % 5, j = layer >> 1; const bool even = (layer & 1) == 0;
        int tid = threadIdx.x; asm volatile("" : "+v"(tid));
        const int lane = tid & 63, wave = __builtin_amdgcn_readfirstlane(tid >> 6);
        if (step == 0 || step == 3) {
            pg8::Gemm g; EpiAct E; E.stat = STAT; E.rowstat = XSTAT; g.A = XB; g.lda = 1024; g.K = 1024; g.M = MTOK; E.O = Z;
            if (step == 0) { g.N = even ? 4096 : 3072; g.Bt = even ? Win_t + (size_t)j * 4096 * 1024 : Wqkv_t + (size_t)j * 3072 * 1024; E.ldc = g.N; E.act = even ? 1 : 3; }
            else { g.N = 4096; g.Bt = W1_t + (size_t)layer * 4096 * 1024; E.ldc = 4096; E.act = 2; }
            pg8::StaticOrder S; S.init(g.M, g.N, (int)gridDim.x, (int)blockIdx.x);
            pg8::gemm_phase<EpiAct, pg8::StaticOrder, true, true>(lds, g, S, E);
        } else if (step == 2 || step == 4) {
            { const float* gsrc = (step == 2 ? n_mix_post : n_ffn_post) + layer * 1024;
              for (int i = tid; i < 1024; i += NWAVES * 64) ((LAS float*)(lds + LDS_G))[i] = gsrc[i];
              __syncthreads(); }
            pg8::Gemm g; EpiRes E; g.A = Z; g.M = MTOK; g.N = 1024;
            if (step == 2) { g.lda = even ? 4096 : 3072; g.K = even ? 2048 : 1024; g.Bt = even ? Wouta_t + (size_t)j * 1024 * 2048 : Wob_t + (size_t)j * 1024 * 1024; }
            else { g.lda = 4096; g.K = 4096; g.Bt = W2_t + (size_t)layer * 1024 * 4096; }
            const int bank = layer * 2 + (step == 4 ? 1 : 0);
            E.XB = XB; E.outf = (ph == 19) ? out : nullptr; E.xch = XCH; E.xch2 = XCH2; E.cnt = CNT + (size_t)bank * 256 * 64; E.cnt2 = CNT + (size_t)(8 + bank) * 256 * 64; E.rs = XSTAT; E.lds = lds;
            pg8::StaticOrder S; S.init(g.M, g.N, (int)gridDim.x, (int)blockIdx.x);
            pg8::gemm_phase<EpiRes, pg8::StaticOrder, true, true>(lds, g, S, E);
        } else {
#if PROBE_MIX
            if (even) { mix_phase(Z, (bf16*)(ws + 900 * MiB), 2048, STAT, a_v_g + (size_t)j * 2048, a_v_b + (size_t)j * 2048, Wc + (size_t)j * 8 * 128 * 128, a_b_s + (size_t)j * 8 * 128, lds, tid, wave, lane); __syncthreads(); }
#endif
#if PROBE_ATTN
            if (!even) attn_phase(Z, (bf16*)(ws + 900 * MiB), 1024, lds, wave, lane);
#endif
            if (even) mix_phase(Z, Z, 4096, STAT, a_v_g + (size_t)j * 2048, a_v_b + (size_t)j * 2048, Wc + (size_t)j * 8 * 128 * 128, a_b_s + (size_t)j * 8 * 128, lds, tid, wave, lane);
            else attn_phase(Z, Z, NQKV, lds, wave, lane);
        }
        if (ph != 19) xcd_barrier(xbar);
    }
}

extern "C" void kernel_launch(void* const* d_in, const int* in_sizes, int n_in, void* d_out, int out_size, void* d_ws, size_t ws_size, hipStream_t stream) {
    static int grid = 0;
    if (grid == 0) {
        if (n_in != 15 || out_size != MTOK * D_MODEL || ws_size < WS_END) { fprintf(stderr, "kernel_launch: unexpected sizes (n_in %d out %d ws %zu)\n", n_in, out_size, ws_size); grid = -1; return; }
        int dev = 0, cus = 0, per_cu = 0;
        hipGetDevice(&dev); hipDeviceGetAttribute(&cus, hipDeviceAttributeMultiprocessorCount, dev);
        if (hipFuncSetAttribute((const void*)fwd_kernel, hipFuncAttributeMaxDynamicSharedMemorySize, LDS_BYTES) != hipSuccess) fprintf(stderr, "kernel_launch: hipFuncSetAttribute failed\n");
        if (hipOccupancyMaxActiveBlocksPerMultiprocessor(&per_cu, (const void*)fwd_kernel, NWAVES * 64, LDS_BYTES) != hipSuccess || per_cu < 1) { fprintf(stderr, "kernel_launch: occupancy query gave %d\n", per_cu); per_cu = 1; }
        (void)hipGetLastError();
        grid = cus * per_cu;
    }
    if (grid < 0) return;
    Params p{};
    for (int i = 0; i < 15; ++i) p.in[i] = (const float*)d_in[i];
    p.out = (float*)d_out; p.ws = (unsigned char*)d_ws;
    void* args[] = {&p};
    hipError_t e = hipLaunchCooperativeKernel((const void*)fwd_kernel, dim3(grid), dim3(NWAVES * 64), args, LDS_BYTES, stream);
    if (e != hipSuccess) fprintf(stderr, "kernel_launch: cooperative launch failed: %s (grid %d)\n", hipGetErrorString(e), grid);
}
```

```cpp
#include <hip/hip_runtime.h>
#include <hip/hip_cooperative_groups.h>
#include <cstdio>
#include <cstdint>
namespace cg = cooperative_groups;

namespace pg8 {
#define PG8_LAS __attribute__((address_space(3)))
typedef unsigned short bf16_t;
typedef short bf16x8 __attribute__((ext_vector_type(8)));
typedef float f32x4 __attribute__((ext_vector_type(4)));
typedef unsigned u32x4 __attribute__((ext_vector_type(4)));
constexpr int BM = 256, BK = 64, HALF = 128, HTB = HALF * BK * 2  , STAGE_BYTES = 8 * HTB, NXCD = 8, WGM = 8;

__host__ __device__ __forceinline__ int lds_byte(int r, int c) { const int st = (r >> 4) * 2 + (c >> 5), rr = r & 15, cc = c & 31, ob = rr * 64 + cc * 2; return st * 1024 + (ob ^ (((ob >> 9) & 1) << 5)); }
__host__ __device__ __forceinline__ void stage_rc(int b, int& R, int& C) { const int st = b / 1024, sb = b % 1024, swz = sb ^ (((sb >> 9) & 1) << 5); R = (st >> 1) * 16 + swz / 64; C = (st & 1) * 32 + (swz % 64) / 2; }
__host__ __device__ __forceinline__ int perm32(int rho) { const int n = rho >> 4, i = rho & 15; return 8 * (i >> 2) + 4 * n + (i & 3); }

struct Unit { int pm, pn; };
struct Gemm { const bf16_t* A; const bf16_t* Bt; int M, N, K, lda; };

struct StaticOrder {
    int nM, nN, nwg, G, c;
    __host__ __device__ void init(int M, int N, int G_, int c_) { nM = M / BM; nN = N / BM; nwg = nM * nN; G = G_; c = c_; }
    __host__ __device__ bool next(int i, Unit& u) const {
        const long L = (long)i * G + c; if (L >= nwg) return false;
        int wgid = (int)L; { const int q = nwg / NXCD, r = nwg % NXCD, xcd = wgid % NXCD, off = wgid / NXCD; wgid = (xcd < r ? xcd * (q + 1) : r * (q + 1) + (xcd - r) * q) + off; }
        const int nig = WGM * nN, gid = wgid / nig, fm = gid * WGM, gsz = (nM - fm) < WGM ? (nM - fm) : WGM;
        u.pm = fm + ((wgid % nig) % gsz); u.pn = (wgid % nig) / gsz; return true;
    }
    __device__ __forceinline__ void a_ready(const Unit&) const {}
    __device__ __forceinline__ void done(const Unit&) const {}
};

__device__ __forceinline__ unsigned cvt_pk_bf16(float lo, float hi) { unsigned r; asm volatile("v_cvt_pk_bf16_f32 %0, %1, %2" : "=v"(r) : "v"(lo), "v"(hi)); return r; }
typedef float f32x2 __attribute__((ext_vector_type(2)));
__device__ __forceinline__ f32x2 gelu_pk(f32x2 v) {
    const f32x2 av = __builtin_elementwise_abs(v), d = av * 0.2316418882f + 1.0f;
    f32x2 t; t.x = __builtin_amdgcn_rcpf(d.x); t.y = __builtin_amdgcn_rcpf(d.y);
    f32x2 q = t * 0.5307027145f + (-0.7265760135f); q = q * t + 0.7107068705f; q = q * t + (-0.142248368f); q = q * t + 0.127414796f; q = q * t;
    const f32x2 s = (v * v) * (-0.72134752044f);
    f32x2 e; e.x = __builtin_amdgcn_exp2f(s.x); e.y = __builtin_amdgcn_exp2f(s.y);
    const f32x2 m = v * (q * e), r = v - m;
    f32x2 o; o.x = v.x < 0.f ? m.x : r.x; o.y = v.y < 0.f ? m.y : r.y; return o;
}

template <int ACT  > struct EpiBf16 {
    static constexpr bool PERM = true, AFTER_DRAIN = false; static_assert(ACT == 0 || ACT == 1, "EpiBf16: ACT is 0 (none) or 1 (gelu_pk)");
    bf16_t* O; int ldc; const float* bias; int split_cols; size_t split_stride; float scale0;
    __device__ __forceinline__ void operator()(const f32x4 (&acc)[2][2][4][2], const Unit& u, int wr, int wc, int fr, int fq) const {
        const int row0 = u.pm * BM + wr * 64 + fr; int colt = u.pn * BM; bf16_t* base = O;
        float sc = 1.f; if (split_cols) { const int t = colt / split_cols; base += (size_t)t * split_stride; colt -= t * split_cols; if (t == 0) sc = scale0; }
        const int col0 = colt + wc * 32 + 8 * fq, bcol0 = u.pn * BM + wc * 32 + 8 * fq;
        f32x4 bv[2][2];
#pragma unroll
        for (int bj = 0; bj < 2; ++bj)
#pragma unroll
            for (int n = 0; n < 2; ++n) bv[bj][n] = bias ? *(const f32x4*)(bias + bcol0 + bj * HALF + 4 * n) : (f32x4){0.f, 0.f, 0.f, 0.f};
#pragma unroll
        for (int ai = 0; ai < 2; ++ai)
#pragma unroll
            for (int m = 0; m < 4; ++m) { bf16_t* rowp = base + (size_t)(row0 + ai * HALF + m * 16) * ldc + col0;
#pragma unroll
                for (int bj = 0; bj < 2; ++bj) { f32x4 v0 = acc[ai][bj][m][0] + bv[bj][0], v1 = acc[ai][bj][m][1] + bv[bj][1];
                    if (ACT == 1) { f32x2 a = gelu_pk((f32x2){v0[0], v0[1]}), b = gelu_pk((f32x2){v0[2], v0[3]}), c = gelu_pk((f32x2){v1[0], v1[1]}), d = gelu_pk((f32x2){v1[2], v1[3]});
                        v0 = (f32x4){a.x, a.y, b.x, b.y}; v1 = (f32x4){c.x, c.y, d.x, d.y}; }
                    v0 = v0 * sc; v1 = v1 * sc; u32x4 w; w.x = cvt_pk_bf16(v0[0], v0[1]); w.y = cvt_pk_bf16(v0[2], v0[3]); w.z = cvt_pk_bf16(v1[0], v1[1]); w.w = cvt_pk_bf16(v1[2], v1[3]);
                    *(u32x4*)(rowp + bj * HALF) = w; } }
    }
};
template <class Epi, class Sched, bool ALIGN_EPI = false, bool SP2 = false>
__device__ __forceinline__ void gemm_phase(PG8_LAS unsigned char* lds, const Gemm g, const Sched& S, const Epi& E) {
    int tid = threadIdx.x; asm volatile("" : "+v"(tid));
    const int wid = __builtin_amdgcn_readfirstlane(tid >> 6), lane = tid & 63, wr = wid >> 2, wc = wid & 3, fr = lane & 15, fq = lane >> 4;
    const int K = g.K, nt = K / BK;
    unsigned voffA[2], voffB[2];
#pragma unroll
    for (int i = 0; i < 2; ++i) { int R, C; stage_rc(tid * 16 + i * 8192, R, C); const int Rb = Epi::PERM ? ((R & ~31) + perm32(R & 31)) : R;
        voffA[i] = (unsigned)(R * g.lda + C) * 2u; voffB[i] = (unsigned)(Rb * K + C) * 2u; }
    const size_t kstep = (size_t)(BK * 2);
    const size_t hstepA = (size_t)HALF * g.lda * 2, hstepB = (size_t)HALF * K * 2;
    const size_t tstepA = 2 * hstepA, tstepB = 2 * hstepB;
    const unsigned ldsw = (unsigned)wid * 1024u;
    const int aoff = lds_byte(wr * 64 + fr, fq * 8), boff = lds_byte(wc * 32 + fr, fq * 8);
#define PG8_SA(b, h) (((b) * 2 + (h)) * HTB)
#define PG8_SB(b, h) ((4 + (b) * 2 + (h)) * HTB)
#define PG8_STAGE(bufoff, gbase, voff) do { _Pragma("unroll") for (int _i = 0; _i < 2; ++_i) \
        __builtin_amdgcn_global_load_lds((const unsigned*)((const char*)(gbase) + (voff)[_i]), (PG8_LAS unsigned*)(lds + (bufoff) + ldsw + _i * 8192), 16, 0, 0); } while (0)
#define PG8_LDA(dst, b, h) do { _Pragma("unroll") for (int m = 0; m < 4; ++m) _Pragma("unroll") for (int k = 0; k < 2; ++k) dst[m][k] = *(const PG8_LAS bf16x8*)(lds + PG8_SA(b, h) + aoff + m * 2048 + k * 1024); } while (0)
#define PG8_LDB(dst, b, h) do { _Pragma("unroll") for (int n = 0; n < 2; ++n) _Pragma("unroll") for (int k = 0; k < 2; ++k) dst[n][k] = *(const PG8_LAS bf16x8*)(lds + PG8_SB(b, h) + boff + n * 2048 + k * 1024); } while (0)
#define PG8_MMA(ai, bj, At, Bt) do { __builtin_amdgcn_s_setprio(1); _Pragma("unroll") for (int m = 0; m < 4; ++m) _Pragma("unroll") for (int n = 0; n < 2; ++n) _Pragma("unroll") for (int k = 0; k < 2; ++k) \
        acc[ai][bj][m][n] = __builtin_amdgcn_mfma_f32_16x16x32_bf16(Bt[n][k], At[m][k], acc[ai][bj][m][n], 0, 0, 0); __builtin_amdgcn_s_setprio(0); } while (0)
#define PG8_WAIT_V(n) asm volatile("s_waitcnt vmcnt(" #n ")" ::: "memory")
#define PG8_WAIT_L(n) asm volatile("s_waitcnt lgkmcnt(" #n ")" ::: "memory")
#define PG8_BAR __builtin_amdgcn_s_barrier()
#define PG8_SCHED __builtin_amdgcn_sched_barrier(0)
    Unit cur, nxt; int ui = 0;
    if (!S.next(0, cur)) return;
    f32x4 acc[2][2][4][2];
#pragma unroll
    for (int a = 0; a < 2; ++a)
#pragma unroll
        for (int b = 0; b < 2; ++b)
#pragma unroll
            for (int m = 0; m < 4; ++m)
#pragma unroll
                for (int n = 0; n < 2; ++n) acc[a][b][m][n] = (f32x4){0.f, 0.f, 0.f, 0.f};
    bf16x8 At[4][2], B0[2][2], B1[2][2];
    float epre[8];
    const char* cA = (const char*)g.A + (size_t)cur.pm * tstepA; const char* cB = (const char*)g.Bt + (size_t)cur.pn * tstepB;
    S.a_ready(cur);
    if constexpr (SP2) {
        PG8_STAGE(PG8_SB(0, 0), cB, voffB); PG8_STAGE(PG8_SB(0, 1), cB + hstepB, voffB); PG8_STAGE(PG8_SA(0, 0), cA, voffA); PG8_STAGE(PG8_SA(0, 1), cA + hstepA, voffA);
        if (wr == 1) PG8_BAR;
        PG8_WAIT_V(2); PG8_BAR;
        PG8_STAGE(PG8_SB(1, 0), cB + kstep, voffB); PG8_STAGE(PG8_SA(1, 0), cA + kstep, voffA); PG8_STAGE(PG8_SB(1, 1), cB + hstepB + kstep, voffB);
        PG8_WAIT_V(6); PG8_BAR;
    } else {
        PG8_STAGE(PG8_SB(0, 0), cB, voffB); PG8_STAGE(PG8_SA(0, 0), cA, voffA); PG8_STAGE(PG8_SB(0, 1), cB + hstepB, voffB); PG8_STAGE(PG8_SA(0, 1), cA + hstepA, voffA);
        if (wr == 1) PG8_BAR;
        PG8_WAIT_V(4); PG8_BAR;
        PG8_STAGE(PG8_SB(1, 0), cB + kstep, voffB); PG8_STAGE(PG8_SA(1, 0), cA + kstep, voffA); PG8_STAGE(PG8_SB(1, 1), cB + hstepB + kstep, voffB);
        PG8_WAIT_V(6); PG8_BAR;
    }
    for (;;) {
        const bool has_next = S.next(ui + 1, nxt);
        const char* nA = has_next ? (const char*)g.A + (size_t)nxt.pm * tstepA : cA; const char* nB = has_next ? (const char*)g.Bt + (size_t)nxt.pn * tstepB : cB;
        for (int t = 0; t < nt; t += 2) {
            const bool last = (t == nt - 2);
            const char* a1 = cA + (size_t)(t + 1) * kstep;
            const char* a2 = last ? nA : cA + (size_t)(t + 2) * kstep; const char* b2 = last ? nB : cB + (size_t)(t + 2) * kstep;
            const char* a3 = a2 + kstep; const char* b3 = b2 + kstep;
            if (last && has_next) S.a_ready(nxt);
            if (last) E.prefetch(epre, cur, wr, fr);
            if constexpr (SP2) {
            PG8_LDB(B0, 0, 0); PG8_LDB(B1, 0, 1); PG8_SCHED; PG8_LDA(At, 0, 0); PG8_STAGE(PG8_SA(1, 1), a1 + hstepA, voffA);
            PG8_WAIT_V(8); PG8_WAIT_L(0); PG8_BAR; PG8_MMA(0, 0, At, B0); PG8_MMA(0, 1, At, B1); PG8_BAR; PG8_SCHED;
            PG8_LDA(At, 0, 1); PG8_STAGE(PG8_SB(0, 0), b2, voffB); PG8_STAGE(PG8_SB(0, 1), b2 + hstepB, voffB); PG8_STAGE(PG8_SA(0, 0), a2, voffA);
            PG8_WAIT_V(8); PG8_WAIT_L(0); PG8_BAR; PG8_MMA(1, 0, At, B0); PG8_MMA(1, 1, At, B1); PG8_BAR; PG8_SCHED;
            PG8_LDB(B0, 1, 0); PG8_LDB(B1, 1, 1); PG8_SCHED; PG8_LDA(At, 1, 0); PG8_STAGE(PG8_SA(0, 1), a2 + hstepA, voffA);
            PG8_WAIT_V(8); PG8_WAIT_L(0); PG8_BAR; PG8_MMA(0, 0, At, B0); PG8_MMA(0, 1, At, B1); PG8_BAR; PG8_SCHED;
            PG8_LDA(At, 1, 1); PG8_STAGE(PG8_SB(1, 0), b3, voffB); PG8_STAGE(PG8_SB(1, 1), b3 + hstepB, voffB); PG8_STAGE(PG8_SA(1, 0), a3, voffA);
            PG8_WAIT_V(8); PG8_WAIT_L(0); PG8_BAR; PG8_MMA(1, 0, At, B0); PG8_MMA(1, 1, At, B1); PG8_BAR; PG8_SCHED;
            } else {
            PG8_LDB(B0, 0, 0); PG8_SCHED; PG8_LDA(At, 0, 0); PG8_STAGE(PG8_SA(1, 1), a1 + hstepA, voffA);
            PG8_WAIT_L(8); PG8_BAR; PG8_WAIT_L(0); PG8_MMA(0, 0, At, B0); PG8_BAR; PG8_SCHED;
            PG8_LDB(B1, 0, 1); PG8_STAGE(PG8_SB(0, 0), b2, voffB);
            PG8_BAR; PG8_WAIT_L(0); PG8_MMA(0, 1, At, B1); PG8_BAR;
            PG8_LDA(At, 0, 1); PG8_STAGE(PG8_SA(0, 0), a2, voffA);
            PG8_BAR; PG8_WAIT_L(0); PG8_MMA(1, 0, At, B0); PG8_BAR; PG8_SCHED;
            PG8_STAGE(PG8_SB(0, 1), b2 + hstepB, voffB);
            PG8_WAIT_V(6); PG8_BAR; PG8_MMA(1, 1, At, B1); PG8_BAR;
            PG8_LDB(B0, 1, 0); PG8_SCHED; PG8_LDA(At, 1, 0); PG8_STAGE(PG8_SA(0, 1), a2 + hstepA, voffA);
            PG8_WAIT_L(8); PG8_BAR; PG8_WAIT_L(0); PG8_MMA(0, 0, At, B0); PG8_BAR; PG8_SCHED;
            PG8_LDB(B1, 1, 1); PG8_STAGE(PG8_SB(1, 0), b3, voffB);
            PG8_BAR; PG8_WAIT_L(0); PG8_MMA(0, 1, At, B1); PG8_BAR;
            PG8_LDA(At, 1, 1); PG8_STAGE(PG8_SA(1, 0), a3, voffA);
            PG8_BAR; PG8_WAIT_L(0); PG8_MMA(1, 0, At, B0); PG8_BAR; PG8_SCHED;
            PG8_STAGE(PG8_SB(1, 1), b3 + hstepB, voffB);
            PG8_WAIT_V(6); PG8_BAR; PG8_MMA(1, 1, At, B1); PG8_BAR;
            }
        }
        if constexpr (ALIGN_EPI) { if (wr == 0) PG8_BAR; }
        if constexpr (!Epi::AFTER_DRAIN) { E(acc, cur, wr, wc, fr, fq, epre); S.done(cur); }
        if (!has_next) break;
#pragma unroll
        for (int a = 0; a < 2; ++a)
#pragma unroll
            for (int b = 0; b < 2; ++b)
#pragma unroll
                for (int m = 0; m < 4; ++m)
#pragma unroll
                    for (int n = 0; n < 2; ++n) acc[a][b][m][n] = (f32x4){0.f, 0.f, 0.f, 0.f};
        cur = nxt; cA = nA; cB = nB; ++ui;
        if constexpr (ALIGN_EPI) { if (wr == 1) PG8_BAR; }
    }
    PG8_WAIT_V(0);
    if constexpr (!ALIGN_EPI) { if (wr == 0) PG8_BAR; }
    PG8_BAR;
    if constexpr (Epi::AFTER_DRAIN) { E.fused(acc, cur, wr, wc, fr, fq, lds, wid, lane); S.done(cur); }
#undef PG8_SA
#undef PG8_SB
#undef PG8_STAGE
#undef PG8_LDA
#undef PG8_LDB
#undef PG8_MMA
#undef PG8_WAIT_V
#undef PG8_WAIT_L
#undef PG8_BAR
#undef PG8_SCHED
}
}

#define LAS __attribute__((address_space(3)))
typedef unsigned short bf16;
typedef short bf16x8 __attribute__((ext_vector_type(8)));
typedef float f32x4 __attribute__((ext_vector_type(4)));
typedef float f32x16 __attribute__((ext_vector_type(16)));
typedef unsigned u32x4 __attribute__((ext_vector_type(4)));
typedef unsigned u32x2 __attribute__((ext_vector_type(2)));
typedef short v4i16_t __attribute__((ext_vector_type(4)));
typedef float f32x2_t __attribute__((ext_vector_type(2)));
typedef __bf16 bf16x2_t __attribute__((ext_vector_type(2)));

constexpr int D_MODEL = 1024, BATCH = 32, SEQ = 2048, DEPTH = 4, MTOK = BATCH * SEQ, D_FF = 4096, A_WIDTH = 2048, NQKV = 3072;
constexpr float EPS = 1e-6f;
constexpr size_t MiB = 1u << 20;
constexpr size_t WS_WIN = 1 * MiB, WS_WOUTA = 17 * MiB, WS_WQKV = 25 * MiB, WS_WOB = 37 * MiB, WS_W1 = 41 * MiB, WS_W2 = 73 * MiB, WS_WC = 105 * MiB;
constexpr size_t WS_HN = 112 * MiB, WS_Z = 240 * MiB, WS_STAT = 752 * MiB, WS_XCH = 768 * MiB, WS_XSTAT = 769 * MiB, WS_CNT = 770 * MiB, WS_XCH2 = 771 * MiB, WS_END = 772 * MiB;
constexpr int LDS_BYTES = 147456, LDS_BST = 131072 + 1024;
constexpr size_t WS_BAR = 65536;
constexpr int NWAVES = 8;
#ifndef PROBE_MIX
#define PROBE_MIX 0
#endif
#ifndef PROBE_ATTN
#define PROBE_ATTN 0
#endif


__device__ __forceinline__ unsigned cvtpk(float lo, float hi) { f32x2_t v = {lo, hi}; bf16x2_t b = __builtin_convertvector(v, bf16x2_t); return __builtin_bit_cast(unsigned, b); }
__device__ __forceinline__ float bflo(unsigned w) { return __uint_as_float(w << 16); }
__device__ __forceinline__ float bfhi(unsigned w) { return __uint_as_float(w & 0xffff0000u); }
__device__ __forceinline__ float wave_sum(float v) {
#pragma unroll
    for (int o = 1; o < 64; o <<= 1) v += __shfl_xor(v, o);
    return v;
}
__device__ __forceinline__ int crow(int r, int hi) { return (r & 3) + 8 * (r >> 2) + 4 * hi; }
__device__ __forceinline__ v4i16_t tr_read(LAS unsigned char* p) { return __builtin_amdgcn_ds_read_tr16_b64_v4i16((LAS v4i16_t*)p); }

struct EpiAct {
    static constexpr bool PERM = true, AFTER_DRAIN = false;
    bf16* O; int ldc; int act; const float* rowstat; float* stat;
    __device__ __forceinline__ void prefetch(float (&pre)[8], const pg8::Unit& u, int wr, int fr) const {
        const int row0 = u.pm * pg8::BM + wr * 64 + fr;
#pragma unroll
        for (int ai = 0; ai < 2; ++ai)
#pragma unroll
            for (int m = 0; m < 4; ++m) pre[ai * 4 + m] = rowstat ? rowstat[row0 + ai * pg8::HALF + m * 16] : 1.f;
    }
    template <int MODE>
    __device__ __forceinline__ void run(pg8::f32x4 (&acc)[2][2][4][2], const pg8::Unit& u, int wr, int wc, int fr, int fq, const float (&pre)[8], float sc) const {
        using namespace pg8;
        const int row0 = u.pm * BM + wr * 64 + fr; const int col0 = u.pn * BM + wc * 32 + 8 * fq;
#pragma unroll
        for (int ai = 0; ai < 2; ++ai)
#pragma unroll
            for (int m = 0; m < 4; ++m) { bf16* rowp = O + (size_t)(row0 + ai * HALF + m * 16) * ldc + col0;
                float rs = 0.f, rq = 0.f; const float ps = pre[ai * 4 + m] * sc;
#pragma unroll
                for (int bj = 0; bj < 2; ++bj) { pg8::f32x4 v0 = acc[ai][bj][m][0] * ps, v1 = acc[ai][bj][m][1] * ps;
                    if (MODE == 1) { f32x2 a = gelu_pk((f32x2){v0[0], v0[1]}), b = gelu_pk((f32x2){v0[2], v0[3]}), c = gelu_pk((f32x2){v1[0], v1[1]}), d = gelu_pk((f32x2){v1[2], v1[3]});
                        v0 = (pg8::f32x4){a.x, a.y, b.x, b.y}; v1 = (pg8::f32x4){c.x, c.y, d.x, d.y};
                        rs += ((v0[0] + v0[1]) + (v0[2] + v0[3])) + ((v1[0] + v1[1]) + (v1[2] + v1[3]));
                        rq += ((v0[0] * v0[0] + v0[1] * v0[1]) + (v0[2] * v0[2] + v0[3] * v0[3])) + ((v1[0] * v1[0] + v1[1] * v1[1]) + (v1[2] * v1[2] + v1[3] * v1[3])); }
                    else if (MODE == 2) {
#pragma unroll
                        for (int e = 0; e < 4; ++e) { const float a = fmaxf(v0[e], 0.f), b = fmaxf(v1[e], 0.f); v0[e] = a * a; v1[e] = b * b; } }
                    pg8::u32x4 w; w.x = cvtpk(v0[0], v0[1]); w.y = cvtpk(v0[2], v0[3]); w.z = cvtpk(v1[0], v1[1]); w.w = cvtpk(v1[2], v1[3]);
                    *(pg8::u32x4*)(rowp + bj * HALF) = w; }
                if (MODE == 1) { rs += __shfl_xor(rs, 16); rs += __shfl_xor(rs, 32); rq += __shfl_xor(rq, 16); rq += __shfl_xor(rq, 32);
                    if (fq == 0) *(f32x2*)(stat + ((size_t)(row0 + ai * HALF + m * 16) * 32 + (u.pn - 8) * 4 + wc) * 2) = (f32x2){rs, rq}; } }
    }
    __device__ __forceinline__ void operator()(pg8::f32x4 (&acc)[2][2][4][2], const pg8::Unit& u, int wr, int wc, int fr, int fq, const float (&pre)[8]) const {
        asm volatile("" : "+v"(fr), "+v"(fq));
        const float sc = (act == 3 && u.pn * pg8::BM < 1024) ? 0.125f : 1.f;
        if (act == 2) run<2>(acc, u, wr, wc, fr, fq, pre, 1.f);
        else if (act == 1 && u.pn >= 8) run<1>(acc, u, wr, wc, fr, fq, pre, 1.f);
        else run<0>(acc, u, wr, wc, fr, fq, pre, sc);
    }
};

constexpr int LDS_P = 131072 + 2048, LDS_S = LDS_P + 4096, LDS_G = LDS_S + 1024;
struct EpiRes {
    static constexpr bool PERM = true, AFTER_DRAIN = false;
    bf16* XB; float* outf; float* xch; float* xch2; unsigned* cnt; unsigned* cnt2; float* rs; LAS unsigned char* lds;
    __device__ __forceinline__ void prefetch(float (&)[8], const pg8::Unit&, int, int) const {}
    __device__ __forceinline__ void wait32(unsigned* c) const {
        unsigned sp = 0u;
        while ((unsigned)__builtin_amdgcn_readfirstlane(__hip_atomic_load(c, __ATOMIC_RELAXED, __HIP_MEMORY_SCOPE_AGENT)) < 32u) { __builtin_amdgcn_s_sleep(1); if (++sp > (1u << 22)) break; }
        __builtin_amdgcn_fence(__ATOMIC_ACQUIRE, "agent");
    }
    __device__ __forceinline__ void operator()(pg8::f32x4 (&acc)[2][2][4][2], const pg8::Unit& u, int wr, int wc, int fr, int fq, const float (&)[8]) const {
        using namespace pg8;
        asm volatile("" : "+v"(fr), "+v"(fq));
        const int lane = fq * 16 + fr, wid = wr * 4 + wc;
        LAS float* P = (LAS float*)(lds + LDS_P); LAS float* S = (LAS float*)(lds + LDS_S); LAS float* Gs = (LAS float*)(lds + LDS_G);
        const int col0 = u.pn * BM + wc * 32 + 8 * fq;
#pragma unroll
        for (int ai = 0; ai < 2; ++ai)
#pragma unroll
            for (int m = 0; m < 4; ++m) { float q = 0.f;
#pragma unroll
                for (int bj = 0; bj < 2; ++bj)
#pragma unroll
                    for (int n = 0; n < 2; ++n) { const pg8::f32x4 v = acc[ai][bj][m][n]; q += (v[0] * v[0] + v[1] * v[1]) + (v[2] * v[2] + v[3] * v[3]); }
                q += __shfl_xor(q, 16); q += __shfl_xor(q, 32);
                if (fq == 0) P[(ai * HALF + wr * 64 + m * 16 + fr) * 4 + wc] = q; }
        asm volatile("s_waitcnt lgkmcnt(0)" ::: "memory"); __builtin_amdgcn_s_barrier(); asm volatile("" ::: "memory");
        const int row = wid * 32 + (lane & 31);
        if (lane < 32) { const pg8::f32x4 pp = *(LAS pg8::f32x4*)(P + row * 4);
            __hip_atomic_store(xch + ((size_t)(u.pm * BM + row) * 4 + u.pn), (pp[0] + pp[1]) + (pp[2] + pp[3]), __ATOMIC_RELAXED, __HIP_MEMORY_SCOPE_AGENT); }
        asm volatile("" ::: "memory");
        pg8::u32x4 xpre0[4][2], xpre1[4][2];
#pragma unroll
        for (int m = 0; m < 4; ++m)
#pragma unroll
            for (int bj = 0; bj < 2; ++bj) xpre0[m][bj] = *(const pg8::u32x4*)(XB + (size_t)(u.pm * BM + wr * 64 + m * 16 + fr) * 1024 + col0 + bj * HALF);
        asm volatile("" ::: "memory");
        asm volatile("s_waitcnt vmcnt(8)" ::: "memory");
        if (lane == 0) __hip_atomic_fetch_add(cnt + 64 * u.pm, 1u, __ATOMIC_RELAXED, __HIP_MEMORY_SCOPE_AGENT);
        if (wid == 0) wait32(cnt + 64 * u.pm);
        asm volatile("s_waitcnt vmcnt(0) lgkmcnt(0)" ::: "memory"); __builtin_amdgcn_s_barrier(); asm volatile("" ::: "memory");
        if (lane < 32) { const float* sl = xch + (size_t)(u.pm * BM + row) * 4; float t = 0.f;
#pragma unroll
            for (int k = 0; k < 4; ++k) t += __hip_atomic_load(sl + k, __ATOMIC_RELAXED, __HIP_MEMORY_SCOPE_AGENT);
            S[row] = 1.0f / sqrtf(t * (1.f / 1024.f) + 1e-6f); }
        asm volatile("s_waitcnt lgkmcnt(0)" ::: "memory"); __builtin_amdgcn_s_barrier(); asm volatile("" ::: "memory");
        pg8::f32x4 gp[2][2];
#pragma unroll
        for (int bj = 0; bj < 2; ++bj) { gp[bj][0] = *(LAS pg8::f32x4*)(Gs + col0 + bj * HALF); gp[bj][1] = *(LAS pg8::f32x4*)(Gs + col0 + bj * HALF + 4); }
#pragma unroll
        for (int ai = 0; ai < 2; ++ai) {
#pragma unroll
            for (int m = 0; m < 4; ++m) { const int r = ai * HALF + wr * 64 + m * 16 + fr; const float rsm = S[r]; const size_t off = (size_t)(u.pm * BM + r) * 1024 + col0; float q2 = 0.f;
#pragma unroll
                for (int bj = 0; bj < 2; ++bj) { const pg8::u32x4 xw = ai == 0 ? xpre0[m][bj] : xpre1[m][bj];
                    pg8::f32x4 x0 = {__uint_as_float(xw.x << 16), __uint_as_float(xw.x & 0xffff0000u), __uint_as_float(xw.y << 16), __uint_as_float(xw.y & 0xffff0000u)};
                    pg8::f32x4 x1 = {__uint_as_float(xw.z << 16), __uint_as_float(xw.z & 0xffff0000u), __uint_as_float(xw.w << 16), __uint_as_float(xw.w & 0xffff0000u)};
                    x0 = x0 + acc[ai][bj][m][0] * rsm * gp[bj][0]; x1 = x1 + acc[ai][bj][m][1] * rsm * gp[bj][1];
                    q2 += ((x0[0] * x0[0] + x0[1] * x0[1]) + (x0[2] * x0[2] + x0[3] * x0[3])) + ((x1[0] * x1[0] + x1[1] * x1[1]) + (x1[2] * x1[2] + x1[3] * x1[3]));
                    acc[ai][bj][m][0] = x0; acc[ai][bj][m][1] = x1; }
                if (ai == 0) {
#pragma unroll
                    for (int bj = 0; bj < 2; ++bj) xpre1[m][bj] = *(const pg8::u32x4*)(XB + (size_t)(u.pm * BM + HALF + wr * 64 + m * 16 + fr) * 1024 + col0 + bj * HALF);
                    asm volatile("" ::: "memory"); }
                q2 += __shfl_xor(q2, 16); q2 += __shfl_xor(q2, 32);
                if (fq == 0) P[r * 4 + wc] = q2; }
            asm volatile("" ::: "memory"); }
        asm volatile("s_waitcnt lgkmcnt(0)" ::: "memory"); __builtin_amdgcn_s_barrier(); asm volatile("" ::: "memory");
        if (lane < 32) { const pg8::f32x4 pp = *(LAS pg8::f32x4*)(P + row * 4);
            __hip_atomic_store(xch2 + ((size_t)(u.pm * BM + row) * 4 + u.pn), (pp[0] + pp[1]) + (pp[2] + pp[3]), __ATOMIC_RELAXED, __HIP_MEMORY_SCOPE_AGENT); }
        asm volatile("s_waitcnt vmcnt(0)" ::: "memory");
        if (lane == 0) __hip_atomic_fetch_add(cnt2 + 64 * u.pm, 1u, __ATOMIC_RELAXED, __HIP_MEMORY_SCOPE_AGENT);
#pragma unroll
        for (int ai = 0; ai < 2; ++ai)
#pragma unroll
            for (int m = 0; m < 4; ++m) { const size_t off = (size_t)(u.pm * BM + ai * HALF + wr * 64 + m * 16 + fr) * 1024 + col0;
#pragma unroll
                for (int bj = 0; bj < 2; ++bj) { const pg8::f32x4 x0 = acc[ai][bj][m][0], x1 = acc[ai][bj][m][1];
                    if (outf) { *(pg8::f32x4*)(outf + off + bj * HALF) = x0; *(pg8::f32x4*)(outf + off + bj * HALF + 4) = x1; }
                    else { pg8::u32x4 w; w.x = cvtpk(x0[0], x0[1]); w.y = cvtpk(x0[2], x0[3]); w.z = cvtpk(x1[0], x1[1]); w.w = cvtpk(x1[2], x1[3]); *(pg8::u32x4*)(XB + off + bj * HALF) = w; } } }
        if (u.pn == (u.pm & 3)) {
            if (wid == 0) wait32(cnt2 + 64 * u.pm);
            asm volatile("s_waitcnt vmcnt(0) lgkmcnt(0)" ::: "memory"); __builtin_amdgcn_s_barrier(); asm volatile("" ::: "memory");
            if (lane < 32) { const float* sl = xch2 + (size_t)(u.pm * BM + row) * 4; float t = 0.f;
#pragma unroll
                for (int k = 0; k < 4; ++k) t += __hip_atomic_load(sl + k, __ATOMIC_RELAXED, __HIP_MEMORY_SCOPE_AGENT);
                rs[u.pm * BM + row] = 1.0f / sqrtf(t * (1.f / 1024.f) + 1e-6f); }
        }
    }
};

__device__ __forceinline__ void transpose_item(const float* W, const float* gk, int K, int N, bf16* WT, LAS float* scr, int item, int lane) {
    const int nblk = N / 32, kb = item / nblk, nb = item % nblk, k0 = 64 * kb, n0 = 32 * nb;
#pragma unroll
    for (int i = 0; i < 32; ++i) { const int kk = 2 * i + (lane >> 5); scr[kk * 33 + (lane & 31)] = W[(size_t)(k0 + kk) * N + n0 + (lane & 31)]; }
    const int c = lane & 7;
    f32x4 ga = {1.f, 1.f, 1.f, 1.f}, gb = ga;
    if (gk) { ga = *(const f32x4*)(gk + k0 + 8 * c); gb = *(const f32x4*)(gk + k0 + 8 * c + 4); }
    asm volatile("s_waitcnt lgkmcnt(0)" ::: "memory");
#pragma unroll
    for (int j = 0; j < 4; ++j) { const int n = (lane >> 3) + 8 * j; const LAS float* s = scr + (8 * c) * 33 + n;
        u32x4 o; o.x = cvtpk(s[0 * 33] * ga.x, s[1 * 33] * ga.y); o.y = cvtpk(s[2 * 33] * ga.z, s[3 * 33] * ga.w); o.z = cvtpk(s[4 * 33] * gb.x, s[5 * 33] * gb.y); o.w = cvtpk(s[6 * 33] * gb.z, s[7 * 33] * gb.w);
        *(u32x4*)(WT + (size_t)(n0 + n) * K + k0 + 8 * c) = o; }
    asm volatile("s_waitcnt lgkmcnt(0)" ::: "memory");
}
__device__ __forceinline__ void transpose_matrix(const float* W, const float* gk, int K, int N, bf16* WT, LAS float* scr, int gw, int ngw, int lane) {
    const int items = (K / 64) * (N / 32);
    for (int it = gw; it < items; it += ngw) transpose_item(W, gk, K, N, WT, scr, it, lane);
}

__device__ __forceinline__ void x_to_bf16(const float* xin, bf16* xb, float* xstat, int wave, int lane) {
    const int gw = blockIdx.x * NWAVES + wave, ngw = gridDim.x * NWAVES;
    for (int m0 = gw * 4; m0 < MTOK; m0 += ngw * 4) {
        f32x4 v[4][4];
#pragma unroll
        for (int r = 0; r < 4; ++r) { const f32x4* xr = (const f32x4*)(xin + (size_t)(m0 + r) * D_MODEL) + lane;
#pragma unroll
            for (int j = 0; j < 4; ++j) v[r][j] = xr[64 * j]; }
#pragma unroll
        for (int r = 0; r < 4; ++r) { float ss = 0.f;
#pragma unroll
            for (int j = 0; j < 4; ++j) ss += (v[r][j].x * v[r][j].x + v[r][j].y * v[r][j].y) + (v[r][j].z * v[r][j].z + v[r][j].w * v[r][j].w);
            ss = wave_sum(ss);
            u32x2* ho = (u32x2*)(xb + (size_t)(m0 + r) * D_MODEL) + lane;
#pragma unroll
            for (int j = 0; j < 4; ++j) { u32x2 w; w.x = cvtpk(v[r][j].x, v[r][j].y); w.y = cvtpk(v[r][j].z, v[r][j].w); ho[64 * j] = w; }
            if (lane == 0) xstat[m0 + r] = 1.0f / sqrtf(ss * (1.f / D_MODEL) + EPS); }
    }
}

__device__ __forceinline__ void row_pass(bf16* xb, const bf16* mo, const float* gpost, float* outf, float* xstat, int wave, int lane) {
    const int gw = blockIdx.x * NWAVES + wave, ngw = gridDim.x * NWAVES;
    f32x4 gp[4];
#pragma unroll
    for (int j = 0; j < 4; ++j) gp[j] = *((const f32x4*)gpost + lane + 64 * j);
    for (int m0 = gw * 4; m0 < MTOK; m0 += ngw * 4) {
        u32x2 xw[4][4], mw[4][4];
#pragma unroll
        for (int r = 0; r < 4; ++r) { const u32x2* xr = (const u32x2*)(xb + (size_t)(m0 + r) * D_MODEL) + lane; const u32x2* mr = (const u32x2*)(mo + (size_t)(m0 + r) * D_MODEL) + lane;
#pragma unroll
            for (int j = 0; j < 4; ++j) { xw[r][j] = xr[64 * j]; mw[r][j] = mr[64 * j]; } }
#pragma unroll
        for (int r = 0; r < 4; ++r) {
            const int m = m0 + r;
            f32x4 mv[4], v[4]; float ss = 0.f;
#pragma unroll
            for (int j = 0; j < 4; ++j) { mv[j] = (f32x4){bflo(mw[r][j].x), bfhi(mw[r][j].x), bflo(mw[r][j].y), bfhi(mw[r][j].y)}; v[j] = (f32x4){bflo(xw[r][j].x), bfhi(xw[r][j].x), bflo(xw[r][j].y), bfhi(xw[r][j].y)};
                ss += (mv[j].x * mv[j].x + mv[j].y * mv[j].y) + (mv[j].z * mv[j].z + mv[j].w * mv[j].w); }
            const float rstd = 1.0f / sqrtf(wave_sum(ss) * (1.f / D_MODEL) + EPS);
            float s2 = 0.f;
#pragma unroll
            for (int j = 0; j < 4; ++j) { v[j] = v[j] + mv[j] * rstd * gp[j]; s2 += (v[j].x * v[j].x + v[j].y * v[j].y) + (v[j].z * v[j].z + v[j].w * v[j].w); }
            s2 = wave_sum(s2);
            if (outf) { f32x4* xo = (f32x4*)(outf + (size_t)m * D_MODEL) + lane;
#pragma unroll
                for (int j = 0; j < 4; ++j) xo[64 * j] = v[j]; }
            else { u32x2* ho = (u32x2*)(xb + (size_t)m * D_MODEL) + lane;
#pragma unroll
                for (int j = 0; j < 4; ++j) { u32x2 w; w.x = cvtpk(v[j].x, v[j].y); w.y = cvtpk(v[j].z, v[j].w); ho[64 * j] = w; }
                if (lane == 0) xstat[m] = 1.0f / sqrtf(s2 * (1.f / D_MODEL) + EPS); }
        }
    }
}

__device__ __forceinline__ void mix_phase(bf16* Z, bf16* Gout, int ldg, const float* stat, const float* vg, const float* vbias, const bf16* Wc, const float* bs, LAS unsigned char* lds, int tid, int wave, int lane) {
    constexpr int LD = 4096, PITCH = 576, WPITCH = 272, OFF_W = 128 * PITCH, OFF_ST = OFF_W + 128 * WPITCH;
    LAS float* st = (LAS float*)(lds + OFF_ST);
    const int nper = gridDim.x >> 3, g = blockIdx.x & 7, ci = blockIdx.x >> 3;
    if (nper == 0 || ci >= nper) return;
    const int r32 = lane & 31, hi = lane >> 5;
    const int troff = (8 * hi + ((lane & 15) >> 2)) * PITCH + (32 * wave + 16 * ((lane >> 4) & 1) + 4 * (lane & 3)) * 2;
#pragma unroll
    for (int it = 0; it < 4; ++it) { const int idx = it * 512 + tid, row = idx >> 4, ch = idx & 15;
        *(LAS u32x4*)(lds + OFF_W + row * WPITCH + ch * 16) = *(const u32x4*)(Wc + ((size_t)g * 128 + row) * 128 + ch * 8); }
    const int vrow = tid >> 5, vch = tid & 31;
    const f32x4 g0 = *(const f32x4*)(vg + g * 256 + vch * 8), g1 = *(const f32x4*)(vg + g * 256 + vch * 8 + 4);
    const f32x4 b0 = *(const f32x4*)(vbias + g * 256 + vch * 8), b1 = *(const f32x4*)(vbias + g * 256 + vch * 8 + 4);
    const int srow = tid >> 2, sq = tid & 3;
    float bsr[4];
#pragma unroll
    for (int tb = 0; tb < 4; ++tb) bsr[tb] = bs[g * 128 + tb * 32 + r32];
    u32x4 rawv[8]; f32x4 stp[4];
    { const size_t row0 = (size_t)ci * 128;
#pragma unroll
      for (int it = 0; it < 8; ++it) rawv[it] = *(const u32x4*)(Z + (row0 + it * 16 + vrow) * LD + 2048 + g * 256 + vch * 8);
#pragma unroll
      for (int k = 0; k < 4; ++k) stp[k] = *(const f32x4*)(stat + ((row0 + srow) * 32 + sq * 8 + k * 2) * 2); }
    for (int chunk = ci; chunk < MTOK / 128; chunk += nper) {
        const size_t row0 = (size_t)chunk * 128;
        bf16* up = Z + (row0 + r32) * LD + g * 256 + 32 * wave + 4 * hi;
        bf16* gp = Gout + (row0 + r32) * ldg + g * 256 + 32 * wave + 4 * hi;
        u32x2 uw[4][4];
#pragma unroll
        for (int tb = 0; tb < 4; ++tb)
#pragma unroll
            for (int g4 = 0; g4 < 4; ++g4) uw[tb][g4] = *(const u32x2*)(up + (size_t)tb * 32 * LD + 8 * g4);
        { float s = (stp[0].x + stp[0].z) + (stp[1].x + stp[1].z) + (stp[2].x + stp[2].z) + (stp[3].x + stp[3].z);
          float q = (stp[0].y + stp[0].w) + (stp[1].y + stp[1].w) + (stp[2].y + stp[2].w) + (stp[3].y + stp[3].w);
          s += __shfl_xor(s, 1); s += __shfl_xor(s, 2); q += __shfl_xor(q, 1); q += __shfl_xor(q, 2);
          const float mean = s * (1.f / 2048.f), var = fmaxf(q * (1.f / 2048.f) - mean * mean, 0.f);
          if (sq == 0) { st[2 * srow] = mean; st[2 * srow + 1] = 1.0f / sqrtf(var + EPS); } }
        __syncthreads();
#pragma unroll
        for (int it = 0; it < 8; ++it) {
            const int row = it * 16 + vrow; const u32x4 w = rawv[it];
            const float mean = st[2 * row], rstd = st[2 * row + 1];
            u32x4 o;
            o.x = cvtpk((bflo(w.x) - mean) * rstd * g0.x + b0.x, (bfhi(w.x) - mean) * rstd * g0.y + b0.y);
            o.y = cvtpk((bflo(w.y) - mean) * rstd * g0.z + b0.z, (bfhi(w.y) - mean) * rstd * g0.w + b0.w);
            o.z = cvtpk((bflo(w.z) - mean) * rstd * g1.x + b1.x, (bfhi(w.z) - mean) * rstd * g1.y + b1.y);
            o.w = cvtpk((bflo(w.w) - mean) * rstd * g1.z + b1.z, (bfhi(w.w) - mean) * rstd * g1.w + b1.w);
            *(LAS u32x4*)(lds + row * PITCH + vch * 16) = o;
        }
        __syncthreads();
        if (chunk + nper < MTOK / 128) { const size_t nrow0 = (size_t)(chunk + nper) * 128;
#pragma unroll
            for (int it = 0; it < 8; ++it) rawv[it] = *(const u32x4*)(Z + (nrow0 + it * 16 + vrow) * LD + 2048 + g * 256 + vch * 8);
#pragma unroll
            for (int k = 0; k < 4; ++k) stp[k] = *(const f32x4*)(stat + ((nrow0 + srow) * 32 + sq * 8 + k * 2) * 2); }
        bf16x8 af[8];
#pragma unroll
        for (int ks = 0; ks < 8; ++ks) { const v4i16_t lo = tr_read(lds + troff + (16 * ks) * PITCH), h4 = tr_read(lds + troff + (16 * ks + 4) * PITCH);
            af[ks] = (bf16x8){lo[0], lo[1], lo[2], lo[3], h4[0], h4[1], h4[2], h4[3]}; }
#pragma unroll
        for (int tb = 0; tb < 4; ++tb) {
            f32x16 acc = {};
            LAS unsigned char* wp = lds + OFF_W + (tb * 32 + r32) * WPITCH + 16 * hi;
#pragma unroll
            for (int ks = 0; ks < 2 * (tb + 1); ++ks) { const bf16x8 bfrag = *(LAS bf16x8*)(wp + 32 * ks); acc = __builtin_amdgcn_mfma_f32_32x32x16_bf16(af[ks], bfrag, acc, 0, 0, 0); }
            const float bsv = bsr[tb];
#pragma unroll
            for (int g4 = 0; g4 < 4; ++g4) { const u32x2 u2 = uw[tb][g4]; u32x2 ow;
                const pg8::f32x2 ua = pg8::gelu_pk((pg8::f32x2){bflo(u2.x), bfhi(u2.x)}), ub = pg8::gelu_pk((pg8::f32x2){bflo(u2.y), bfhi(u2.y)});
                ow.x = cvtpk(ua.x * (acc[4 * g4] + bsv), ua.y * (acc[4 * g4 + 1] + bsv));
                ow.y = cvtpk(ub.x * (acc[4 * g4 + 2] + bsv), ub.y * (acc[4 * g4 + 3] + bsv));
                *(u32x2*)(gp + (size_t)tb * 32 * ldg + 8 * g4) = ow; }
        }
        __syncthreads();
    }
}

template <bool DIAG>
__device__ __forceinline__ void attn_tile(f32x16& o0, f32x16& o1, float& carry2, const bf16x8 (&qr)[4], bf16x8 (&kf)[4], u32x4 (&vr)[4], const bf16* kpn, const bf16* vpn, bool has_next,
                                          LAS unsigned char* vcur, int troff, int strow, int stch, int r32, int hi) {
    constexpr int LD = NQKV; constexpr float LOG2E = 1.4426950408889634f;
#pragma unroll
    for (int it = 0; it < 4; ++it) *(LAS u32x4*)(vcur + (it * 8 + strow) * 192 + stch * 16) = vr[it];
    f32x16 p = {};
#pragma unroll
    for (int s = 0; s < 4; ++s) p = __builtin_amdgcn_mfma_f32_32x32x16_bf16(kf[s], qr[s], p, 0, 0, 0);
    (void)has_next;
#pragma unroll
    for (int s = 0; s < 4; ++s) { kf[s] = *(const bf16x8*)(kpn + 16 * s); vr[s] = *(const u32x4*)(vpn + (size_t)s * 8 * LD); }
    float kp[16], be[16];
#pragma unroll
    for (int r = 0; r < 16; ++r) { const float z = __builtin_amdgcn_fmed3f(p[r], -80.f, 3.0e38f);
        const float t = __builtin_amdgcn_exp2f(z * -LOG2E); be[r] = __builtin_amdgcn_rcpf(1.f + t); kp[r] = t * be[r];
        if (DIAG) { const bool msk = crow(r, hi) >= r32; kp[r] = msk ? 1.f : kp[r]; be[r] = msk ? 0.f : be[r]; } }
    float se[16], G[4], oth[4], T[4];
#pragma unroll
    for (int g = 0; g < 4; ++g) { se[4 * g + 3] = 1.f; se[4 * g + 2] = kp[4 * g + 3]; se[4 * g + 1] = se[4 * g + 2] * kp[4 * g + 2]; se[4 * g] = se[4 * g + 1] * kp[4 * g + 1]; G[g] = se[4 * g] * kp[4 * g]; }
#pragma unroll
    for (int g = 0; g < 4; ++g) {
        const auto rr = __builtin_amdgcn_permlane32_swap(__float_as_uint(G[g]), __float_as_uint(G[g]), false, false);
        oth[g] = __uint_as_float(rr[1]); T[g] = __uint_as_float(rr[0]) * __uint_as_float(rr[1]); }
    const float C = __builtin_amdgcn_exp2f(carry2);
    float base[4]; const float a2 = T[3], a1 = T[3] * T[2], a0 = a1 * T[1];
    base[3] = C; base[2] = C * a2; base[1] = C * a1; base[0] = C * a0;
    if (hi == 0) {
#pragma unroll
        for (int g = 0; g < 4; ++g) base[g] *= oth[g]; }
    carry2 += __builtin_amdgcn_logf(a0 * T[0]);
    float a[16];
#pragma unroll
    for (int r = 0; r < 16; ++r) a[r] = be[r] * (se[r] * base[r >> 2]);
    u32x4 pw0, pw1;
    pw0.x = cvtpk(a[0], a[1]); pw0.y = cvtpk(a[2], a[3]); pw0.z = cvtpk(a[4], a[5]); pw0.w = cvtpk(a[6], a[7]);
    pw1.x = cvtpk(a[8], a[9]); pw1.y = cvtpk(a[10], a[11]); pw1.z = cvtpk(a[12], a[13]); pw1.w = cvtpk(a[14], a[15]);
    const bf16x8 pf0 = __builtin_bit_cast(bf16x8, pw0), pf1 = __builtin_bit_cast(bf16x8, pw1);
    asm volatile("" ::: "memory");
#pragma unroll
    for (int dh = 0; dh < 2; ++dh)
#pragma unroll
        for (int s = 0; s < 2; ++s) {
            const v4i16_t lo = tr_read(vcur + troff + (16 * s) * 192 + dh * 64), h4 = tr_read(vcur + troff + (16 * s + 8) * 192 + dh * 64);
            const bf16x8 vf = (bf16x8){lo[0], lo[1], lo[2], lo[3], h4[0], h4[1], h4[2], h4[3]};
            if (dh == 0) o0 = __builtin_amdgcn_mfma_f32_32x32x16_bf16(vf, s == 0 ? pf0 : pf1, o0, 0, 0, 0);
            else o1 = __builtin_amdgcn_mfma_f32_32x32x16_bf16(vf, s == 0 ? pf0 : pf1, o1, 0, 0, 0);
        }
    asm volatile("" ::: "memory");
}
__device__ __forceinline__ void attn_phase(bf16* QKV, bf16* Oout, int ldo, LAS unsigned char* lds, int wave, int lane) {
    constexpr int LD = NQKV;
    const int r32 = lane & 31, hi = lane >> 5;
    LAS unsigned char* vb = lds + wave * 12288;
    const int vcu = (gridDim.x % 8 == 0) ? (int)((blockIdx.x & 7) * (gridDim.x >> 3) + (blockIdx.x >> 3)) : (int)blockIdx.x;
    const int gw = vcu * NWAVES + wave, ngw = gridDim.x * NWAVES;
    const int troff = (4 * hi + ((lane & 15) >> 2)) * 192 + (16 * ((lane >> 4) & 1) + 4 * (lane & 3)) * 2;
    const int strow = lane >> 3, stch = lane & 7;
#define ATT_UNIT(unit_) const int bh = (unit_) >> 6, qb = ((unit_) + 8 * (bh >> 5)) & 63, h = bh & 15, b = bh >> 4;     \
        const size_t rowbase = (size_t)b * SEQ; \
        const bf16* qp = QKV + (rowbase + qb * 32 + r32) * LD + h * 64; \
        const bf16* kbase = QKV + (rowbase + r32) * LD + 1024 + h * 64 + 8 * hi; \
        const bf16* vbase = QKV + (rowbase + strow) * LD + 2048 + h * 64 + stch * 8;
#define ATT_LOAD(Q_) do { const bf16* kp = kbase + (size_t)qb * 32 * LD; const bf16* vp = vbase + (size_t)qb * 32 * LD; \
        _Pragma("unroll") for (int s = 0; s < 4; ++s) Q_[s] = *(const bf16x8*)(qp + 16 * s + 8 * hi); \
        _Pragma("unroll") for (int s = 0; s < 4; ++s) { kf[s] = *(const bf16x8*)(kp + 16 * s); vr[s] = *(const u32x4*)(vp + (size_t)s * 8 * LD); } } while (0)
    const int nunits = BATCH * 16 * 64;
    bf16x8 qr[4], kf[4]; u32x4 vr[4];
    if (gw < nunits) { ATT_UNIT(gw) ATT_LOAD(qr); }
    for (int unit = gw; unit < nunits; unit += ngw) {
        ATT_UNIT(unit)
        f32x16 o0 = {}, o1 = {};
        float carry2 = 0.f;
        attn_tile<true>(o0, o1, carry2, qr, kf, vr, kbase + (size_t)(qb > 0 ? qb - 1 : 0) * 32 * LD, vbase + (size_t)(qb > 0 ? qb - 1 : 0) * 32 * LD, qb > 0, vb, troff, strow, stch, r32, hi);
        int buf = 1;
        for (int kt = qb - 1; kt >= 0; --kt) {
            if (__all(carry2 <= -150.f)) break;
            attn_tile<false>(o0, o1, carry2, qr, kf, vr, kbase + (size_t)(kt > 0 ? kt - 1 : 0) * 32 * LD, vbase + (size_t)(kt > 0 ? kt - 1 : 0) * 32 * LD, kt > 0, vb + buf * 6144, troff, strow, stch, r32, hi);
            buf ^= 1;
        }
        if (unit + ngw < nunits) { const int nu = unit + ngw; { ATT_UNIT(nu) ATT_LOAD(qr); } }
        bf16* op = Oout + (rowbase + qb * 32 + r32) * ldo + h * 64;
#pragma unroll
        for (int g = 0; g < 4; ++g) {
            u32x2 w0, w1;
            w0.x = cvtpk(o0[4 * g], o0[4 * g + 1]); w0.y = cvtpk(o0[4 * g + 2], o0[4 * g + 3]);
            w1.x = cvtpk(o1[4 * g], o1[4 * g + 1]); w1.y = cvtpk(o1[4 * g + 2], o1[4 * g + 3]);
            *(u32x2*)(op + 8 * g + 4 * hi) = w0; *(u32x2*)(op + 32 + 8 * g + 4 * hi) = w1;
        }
    }
#undef ATT_UNIT
#undef ATT_LOAD
}

#define XB_TMO      128
#define XB_XCNT(j)  (256  + 64 * (j))
#define XB_XSUB(j)  (1280 + 64 * (j))
#define XB_XGEN(j)  (2304 + 64 * (j))
#define XB_TOP      3328
#define XB_TOPGEN   3392
#define XCD_BAR_WORDS 3456
#define XB_SPIN_CAP (1u << 18)

__device__ __forceinline__ unsigned xb_ld(unsigned* p)              { return __hip_atomic_load(p, __ATOMIC_RELAXED, __HIP_MEMORY_SCOPE_AGENT); }
__device__ __forceinline__ unsigned xb_add(unsigned* p, unsigned v) { return __hip_atomic_fetch_add(p, v, __ATOMIC_RELAXED, __HIP_MEMORY_SCOPE_AGENT); }
__device__ __forceinline__ unsigned xb_xcc_id() { return (unsigned)__builtin_amdgcn_s_getreg((3 << 11) | 20) & 0xFu; }
#define XB_SPIN(cond, bar) do { unsigned _sp = 0; while (cond) { __builtin_amdgcn_s_sleep(1); \
    if ((++_sp & 255u) == 0u) { if (xb_ld(&(bar)[XB_TMO])) break; if (_sp > XB_SPIN_CAP) { atomicAdd(&(bar)[XB_TMO], 1u); break; } } } } while (0)

struct XcdBarrier {
    unsigned* bar; unsigned x;
    volatile LAS unsigned* st;
};

__device__ __forceinline__ XcdBarrier xcd_barrier_post(unsigned* bar, volatile LAS unsigned* st) {
    XcdBarrier b; b.bar = bar; b.x = xb_xcc_id(); b.st = st;
    if (threadIdx.x == 0) (void)xb_add(&bar[XB_XCNT(b.x)], 1u);
    return b;
}
__device__ __forceinline__ void xcd_barrier_complete(unsigned* bar, unsigned x, unsigned& nloc, unsigned& nx) {
    const unsigned G = gridDim.x * gridDim.y * gridDim.z;
    unsigned sum, cnt, mine, sp = 0u;
    for (;;) {
        sum = 0u; cnt = 0u; mine = 0u;
#pragma unroll
        for (unsigned j = 0; j < 16; ++j) { const unsigned c = xb_ld(&bar[XB_XCNT(j)]); sum += c; cnt += (c > 0u) ? 1u : 0u; mine = (j == x) ? c : mine; }
        if (sum == G) break;
        __builtin_amdgcn_s_sleep(1);
        if ((++sp & 255u) == 0u) { if (xb_ld(&bar[XB_TMO])) break; if (sp > XB_SPIN_CAP) { atomicAdd(&bar[XB_TMO], 1u); break; } }
    }
    nloc = mine > 0u ? mine : 1u; nx = cnt > 0u ? cnt : 1u;
}

__device__ __forceinline__ void xcd_barrier(const XcdBarrier& b) {
    asm volatile("s_waitcnt vmcnt(0)" ::: "memory");
    __syncthreads();
    if (threadIdx.x == 0) {
        unsigned* bar = b.bar;
        __builtin_amdgcn_s_waitcnt(0);
        unsigned nloc = b.st[0], nx = b.st[1];
        if (nloc == 0u) { xcd_barrier_complete(bar, b.x, nloc, nx); b.st[0] = nloc; b.st[1] = nx; }
        const unsigned old = xb_add(&bar[XB_XSUB(b.x)], 1u);
        const unsigned gen = old / nloc;
        if (old + 1u == (gen + 1u) * nloc) {
            __builtin_amdgcn_fence(__ATOMIC_RELEASE, "agent");
            asm volatile("s_waitcnt vmcnt(0)" ::: "memory");
            const unsigned og = xb_add(&bar[XB_TOP], 1u);
            const unsigned tg = og / nx;
            if (og + 1u == (tg + 1u) * nx) xb_add(&bar[XB_TOPGEN], 1u);
            else XB_SPIN(xb_ld(&bar[XB_TOPGEN]) == tg, bar);
            __builtin_amdgcn_fence(__ATOMIC_ACQUIRE, "agent");
            xb_add(&bar[XB_XGEN(b.x)], 1u);
            asm volatile("s_waitcnt vmcnt(0)" ::: "memory");
        } else {
            XB_SPIN(xb_ld(&bar[XB_XGEN(b.x)]) == gen, bar);
            __builtin_amdgcn_fence(__ATOMIC_ACQUIRE, "agent");
            asm volatile("s_waitcnt vmcnt(0)" ::: "memory");
        }
    }
    __syncthreads();
}

struct Params { const float* in[15]; float* out; unsigned char* ws; };

__global__ void __launch_bounds__(NWAVES * 64, 2) fwd_kernel(Params p) {
    extern __shared__ __attribute__((aligned(16))) unsigned char lds_raw[];
    cg::grid_group grid = cg::this_grid();
    LAS unsigned char* lds = (LAS unsigned char*)lds_raw;
    unsigned char* ws = p.ws;
    const float* x = p.in[0]; const float* n_mix_pre = p.in[1]; const float* n_mix_post = p.in[2]; const float* n_ffn_pre = p.in[3]; const float* n_ffn_post = p.in[4];
    const float* a_v_g = p.in[6]; const float* a_v_b = p.in[7]; const float* a_w_s = p.in[8]; const float* a_b_s = p.in[9];
    bf16* Win_t = (bf16*)(ws + WS_WIN); bf16* Wouta_t = (bf16*)(ws + WS_WOUTA); bf16* Wqkv_t = (bf16*)(ws + WS_WQKV); bf16* Wob_t = (bf16*)(ws + WS_WOB);
    bf16* W1_t = (bf16*)(ws + WS_W1); bf16* W2_t = (bf16*)(ws + WS_W2); bf16* Wc = (bf16*)(ws + WS_WC);
    bf16* XB = (bf16*)(ws + WS_HN); bf16* Z = (bf16*)(ws + WS_Z); float* STAT = (float*)(ws + WS_STAT);
    float* XCH = (float*)(ws + WS_XCH); float* XCH2 = (float*)(ws + WS_XCH2); float* XSTAT = (float*)(ws + WS_XSTAT); unsigned* CNT = (unsigned*)(ws + WS_CNT);
    float* out = p.out;
    unsigned* barw = (unsigned*)(ws + WS_BAR);
    volatile LAS unsigned* bst = (volatile LAS unsigned*)(lds + LDS_BST);
    if (threadIdx.x == 0) { bst[0] = 0u; bst[1] = 0u; }
    if (blockIdx.x == 0) for (int i = threadIdx.x; i < XCD_BAR_WORDS; i += NWAVES * 64) __hip_atomic_store(barw + i, 0u, __ATOMIC_RELAXED, __HIP_MEMORY_SCOPE_AGENT);
    __syncthreads();

    {
        const int tid = threadIdx.x, lane = tid & 63, wave = __builtin_amdgcn_readfirstlane(tid >> 6);
        const int gw = blockIdx.x * NWAVES + wave, ngw = gridDim.x * NWAVES;
        for (int i = blockIdx.x * 512 + tid; i < 16 * 256 * 64; i += gridDim.x * 512) __hip_atomic_store(CNT + i, 0u, __ATOMIC_RELAXED, __HIP_MEMORY_SCOPE_AGENT);
        LAS float* scr = (LAS float*)(lds + wave * 16384);
        for (int l = 0; l < 2; ++l) {
            transpose_matrix(p.in[5] + (size_t)l * 1024 * 4096, n_mix_pre + (2 * l) * 1024, 1024, 4096, Win_t + (size_t)l * 4096 * 1024, scr, gw, ngw, lane);
            transpose_matrix(p.in[10] + (size_t)l * 2048 * 1024, nullptr, 2048, 1024, Wouta_t + (size_t)l * 1024 * 2048, scr, gw, ngw, lane);
            transpose_matrix(p.in[11] + (size_t)l * 1024 * 3072, n_mix_pre + (2 * l + 1) * 1024, 1024, 3072, Wqkv_t + (size_t)l * 3072 * 1024, scr, gw, ngw, lane);
            transpose_matrix(p.in[12] + (size_t)l * 1024 * 1024, nullptr, 1024, 1024, Wob_t + (size_t)l * 1024 * 1024, scr, gw, ngw, lane);
        }
        for (int l = 0; l < 4; ++l) {
            transpose_matrix(p.in[13] + (size_t)l * 1024 * 4096, n_ffn_pre + l * 1024, 1024, 4096, W1_t + (size_t)l * 4096 * 1024, scr, gw, ngw, lane);
            transpose_matrix(p.in[14] + (size_t)l * 4096 * 1024, nullptr, 4096, 1024, W2_t + (size_t)l * 1024 * 4096, scr, gw, ngw, lane);
        }
        for (int i = blockIdx.x * 512 + tid; i < 2 * 8 * 128 * 128; i += gridDim.x * 512) { const int s = i & 127, t = (i >> 7) & 127; Wc[i] = (s <= t) ? (bf16)(cvtpk(a_w_s[i], 0.f) & 0xffffu) : (bf16)0; }
        x_to_bf16(x, XB, XSTAT, wave, lane);
    }
    grid.sync();
    const XcdBarrier xbar = xcd_barrier_post(barw, bst);

#pragma unroll 1
    for (int ph = 0; ph < 20; ++ph) {
        const int layer = ph / 5, step = ph % 5, j = layer >> 1; const bool even = (layer & 1) == 0;
        int tid = threadIdx.x; asm volatile("" : "+v"(tid));
        const int lane = tid & 63, wave = __builtin_amdgcn_readfirstlane(tid >> 6);
        if (step == 0 || step == 3) {
            pg8::Gemm g; EpiAct E; E.stat = STAT; E.rowstat = XSTAT; g.A = XB; g.lda = 1024; g.K = 1024; g.M = MTOK; E.O = Z;
            if (step == 0) { g.N = even ? 4096 : 3072; g.Bt = even ? Win_t + (size_t)j * 4096 * 1024 : Wqkv_t + (size_t)j * 3072 * 1024; E.ldc = g.N; E.act = even ? 1 : 3; }
            else { g.N = 4096; g.Bt = W1_t + (size_t)layer * 4096 * 1024; E.ldc = 4096; E.act = 2; }
            pg8::StaticOrder S; S.init(g.M, g.N, (int)gridDim.x, (int)blockIdx.x);
            pg8::gemm_phase<EpiAct, pg8::StaticOrder, true, true>(lds, g, S, E);
        } else if (step == 2 || step == 4) {
            { const float* gsrc = (step == 2 ? n_mix_post : n_ffn_post) + layer * 1024;
              for (int i = tid; i < 1024; i += NWAVES * 64) ((LAS float*)(lds + LDS_G))[i] = gsrc[i];
              __syncthreads(); }
            pg8::Gemm g; EpiRes E; g.A = Z; g.M = MTOK; g.N = 1024;
            if (step == 2) { g.lda = even ? 4096 : 3072; g.K = even ? 2048 : 1024; g.Bt = even ? Wouta_t + (size_t)j * 1024 * 2048 : Wob_t + (size_t)j * 1024 * 1024; }
            else { g.lda = 4096; g.K = 4096; g.Bt = W2_t + (size_t)layer * 1024 * 4096; }
            const int bank = layer * 2 + (step == 4 ? 1 : 0);
            E.XB = XB; E.outf = (ph == 19) ? out : nullptr; E.xch = XCH; E.xch2 = XCH2; E.cnt = CNT + (size_t)bank * 256 * 64; E.cnt2 = CNT + (size_t)(8 + bank) * 256 * 64; E.rs = XSTAT; E.lds = lds;
            pg8::StaticOrder S; S.init(g.M, g.N, (int)gridDim.x, (int)blockIdx.x);
            pg8::gemm_phase<EpiRes, pg8::StaticOrder, true, true>(lds, g, S, E);
        } else {
#if PROBE_MIX
            if (even) { mix_phase(Z, (bf16*)(ws + 900 * MiB), 2048, STAT, a_v_g + (size_t)j * 2048, a_v_b + (size_t)j * 2048, Wc + (size_t)j * 8 * 128 * 128, a_b_s + (size_t)j * 8 * 128, lds, tid, wave, lane); __syncthreads(); }
#endif
#if PROBE_ATTN
            if (!even) attn_phase(Z, (bf16*)(ws + 900 * MiB), 1024, lds, wave, lane);
#endif
            if (even) mix_phase(Z, Z, 4096, STAT, a_v_g + (size_t)j * 2048, a_v_b + (size_t)j * 2048, Wc + (size_t)j * 8 * 128 * 128, a_b_s + (size_t)j * 8 * 128, lds, tid, wave, lane);
            else attn_phase(Z, Z, NQKV, lds, wave, lane);
        }
        if (ph != 19) xcd_barrier(xbar);
    }
}

extern "C" void kernel_launch(void* const* d_in, const int* in_sizes, int n_in, void* d_out, int out_size, void* d_ws, size_t ws_size, hipStream_t stream) {
    static int grid = 0;
    if (grid == 0) {
        if (n_in != 15 || out_size != MTOK * D_MODEL || ws_size < WS_END) { fprintf(stderr, "kernel_launch: unexpected sizes (n_in %d out %d ws %zu)\n", n_in, out_size, ws_size); grid = -1; return; }
        int dev = 0, cus = 0, per_cu = 0;
        hipGetDevice(&dev); hipDeviceGetAttribute(&cus, hipDeviceAttributeMultiprocessorCount, dev);
        if (hipFuncSetAttribute((const void*)fwd_kernel, hipFuncAttributeMaxDynamicSharedMemorySize, LDS_BYTES) != hipSuccess) fprintf(stderr, "kernel_launch: hipFuncSetAttribute failed\n");
        if (hipOccupancyMaxActiveBlocksPerMultiprocessor(&per_cu, (const void*)fwd_kernel, NWAVES * 64, LDS_BYTES) != hipSuccess || per_cu < 1) { fprintf(stderr, "kernel_launch: occupancy query gave %d\n", per_cu); per_cu = 1; }
        (void)hipGetLastError();
        grid = cus * per_cu;
    }
    if (grid < 0) return;
    Params p{};
    for (int i = 0; i < 15; ++i) p.in[i] = (const float*)d_in[i];
    p.out = (float*)d_out; p.ws = (unsigned char*)d_ws;
    void* args[] = {&p};
    hipError_t e = hipLaunchCooperativeKernel((const void*)fwd_kernel, dim3(grid), dim3(NWAVES * 64), args, LDS_BYTES, stream);
    if (e != hipSuccess) fprintf(stderr, "kernel_launch: cooperative launch failed: %s (grid %d)\n", hipGetErrorString(e), grid);
}
```

```cpp
#include <hip/hip_runtime.h>
#include <hip/hip_cooperative_groups.h>
#include <cstdio>
#include <cstdint>
namespace cg = cooperative_groups;

namespace pg8 {
#define PG8_LAS __attribute__((address_space(3)))
typedef unsigned short bf16_t;
typedef short bf16x8 __attribute__((ext_vector_type(8)));
typedef float f32x4 __attribute__((ext_vector_type(4)));
typedef unsigned u32x4 __attribute__((ext_vector_type(4)));
constexpr int BM = 256, BK = 64, HALF = 128, HTB = HALF * BK * 2  , STAGE_BYTES = 8 * HTB, NXCD = 8, WGM = 8;

__host__ __device__ __forceinline__ int lds_byte(int r, int c) { const int st = (r >> 4) * 2 + (c >> 5), rr = r & 15, cc = c & 31, ob = rr * 64 + cc * 2; return st * 1024 + (ob ^ (((ob >> 9) & 1) << 5)); }
__host__ __device__ __forceinline__ void stage_rc(int b, int& R, int& C) { const int st = b / 1024, sb = b % 1024, swz = sb ^ (((sb >> 9) & 1) << 5); R = (st >> 1) * 16 + swz / 64; C = (st & 1) * 32 + (swz % 64) / 2; }
__host__ __device__ __forceinline__ int perm32(int rho) { const int n = rho >> 4, i = rho & 15; return 8 * (i >> 2) + 4 * n + (i & 3); }

struct Unit { int pm, pn; };
struct Gemm { const bf16_t* A; const bf16_t* Bt; int M, N, K, lda; };

struct StaticOrder {
    int nM, nN, nwg, G, c;
    __host__ __device__ void init(int M, int N, int G_, int c_) { nM = M / BM; nN = N / BM; nwg = nM * nN; G = G_; c = c_; }
    __host__ __device__ bool next(int i, Unit& u) const {
        const long L = (long)i * G + c; if (L >= nwg) return false;
        int wgid = (int)L; { const int q = nwg / NXCD, r = nwg % NXCD, xcd = wgid % NXCD, off = wgid / NXCD; wgid = (xcd < r ? xcd * (q + 1) : r * (q + 1) + (xcd - r) * q) + off; }
        const int nig = WGM * nN, gid = wgid / nig, fm = gid * WGM, gsz = (nM - fm) < WGM ? (nM - fm) : WGM;
        u.pm = fm + ((wgid % nig) % gsz); u.pn = (wgid % nig) / gsz; return true;
    }
    __device__ __forceinline__ void a_ready(const Unit&) const {}
    __device__ __forceinline__ void done(const Unit&) const {}
};

__device__ __forceinline__ unsigned cvt_pk_bf16(float lo, float hi) { unsigned r; asm volatile("v_cvt_pk_bf16_f32 %0, %1, %2" : "=v"(r) : "v"(lo), "v"(hi)); return r; }
typedef float f32x2 __attribute__((ext_vector_type(2)));
__device__ __forceinline__ f32x2 gelu_pk(f32x2 v) {
    const f32x2 av = __builtin_elementwise_abs(v), d = av * 0.2316418882f + 1.0f;
    f32x2 t; t.x = __builtin_amdgcn_rcpf(d.x); t.y = __builtin_amdgcn_rcpf(d.y);
    f32x2 q = t * 0.5307027145f + (-0.7265760135f); q = q * t + 0.7107068705f; q = q * t + (-0.142248368f); q = q * t + 0.127414796f; q = q * t;
    const f32x2 s = (v * v) * (-0.72134752044f);
    f32x2 e; e.x = __builtin_amdgcn_exp2f(s.x); e.y = __builtin_amdgcn_exp2f(s.y);
    const f32x2 m = v * (q * e), r = v - m;
    f32x2 o; o.x = v.x < 0.f ? m.x : r.x; o.y = v.y < 0.f ? m.y : r.y; return o;
}

template <int ACT  > struct EpiBf16 {
    static constexpr bool PERM = true, AFTER_DRAIN = false; static_assert(ACT == 0 || ACT == 1, "EpiBf16: ACT is 0 (none) or 1 (gelu_pk)");
    bf16_t* O; int ldc; const float* bias; int split_cols; size_t split_stride; float scale0;
    __device__ __forceinline__ void operator()(const f32x4 (&acc)[2][2][4][2], const Unit& u, int wr, int wc, int fr, int fq) const {
        const int row0 = u.pm * BM + wr * 64 + fr; int colt = u.pn * BM; bf16_t* base = O;
        float sc = 1.f; if (split_cols) { const int t = colt / split_cols; base += (size_t)t * split_stride; colt -= t * split_cols; if (t == 0) sc = scale0; }
        const int col0 = colt + wc * 32 + 8 * fq, bcol0 = u.pn * BM + wc * 32 + 8 * fq;
        f32x4 bv[2][2];
#pragma unroll
        for (int bj = 0; bj < 2; ++bj)
#pragma unroll
            for (int n = 0; n < 2; ++n) bv[bj][n] = bias ? *(const f32x4*)(bias + bcol0 + bj * HALF + 4 * n) : (f32x4){0.f, 0.f, 0.f, 0.f};
#pragma unroll
        for (int ai = 0; ai < 2; ++ai)
#pragma unroll
            for (int m = 0; m < 4; ++m) { bf16_t* rowp = base + (size_t)(row0 + ai * HALF + m * 16) * ldc + col0;
#pragma unroll
                for (int bj = 0; bj < 2; ++bj) { f32x4 v0 = acc[ai][bj][m][0] + bv[bj][0], v1 = acc[ai][bj][m][1] + bv[bj][1];
                    if (ACT == 1) { f32x2 a = gelu_pk((f32x2){v0[0], v0[1]}), b = gelu_pk((f32x2){v0[2], v0[3]}), c = gelu_pk((f32x2){v1[0], v1[1]}), d = gelu_pk((f32x2){v1[2], v1[3]});
                        v0 = (f32x4){a.x, a.y, b.x, b.y}; v1 = (f32x4){c.x, c.y, d.x, d.y}; }
                    v0 = v0 * sc; v1 = v1 * sc; u32x4 w; w.x = cvt_pk_bf16(v0[0], v0[1]); w.y = cvt_pk_bf16(v0[2], v0[3]); w.z = cvt_pk_bf16(v1[0], v1[1]); w.w = cvt_pk_bf16(v1[2], v1[3]);
                    *(u32x4*)(rowp + bj * HALF) = w; } }
    }
};
template <class Epi, class Sched, bool ALIGN_EPI = false, bool SP2 = false>
__device__ __forceinline__ void gemm_phase(PG8_LAS unsigned char* lds, const Gemm g, const Sched& S, const Epi& E) {
    int tid = threadIdx.x; asm volatile("" : "+v"(tid));
    const int wid = __builtin_amdgcn_readfirstlane(tid >> 6), lane = tid & 63, wr = wid >> 2, wc = wid & 3, fr = lane & 15, fq = lane >> 4;
    const int K = g.K, nt = K / BK;
    unsigned voffA[2], voffB[2];
#pragma unroll
    for (int i = 0; i < 2; ++i) { int R, C; stage_rc(tid * 16 + i * 8192, R, C); const int Rb = Epi::PERM ? ((R & ~31) + perm32(R & 31)) : R;
        voffA[i] = (unsigned)(R * g.lda + C) * 2u; voffB[i] = (unsigned)(Rb * K + C) * 2u; }
    const size_t kstep = (size_t)(BK * 2);
    const size_t hstepA = (size_t)HALF * g.lda * 2, hstepB = (size_t)HALF * K * 2;
    const size_t tstepA = 2 * hstepA, tstepB = 2 * hstepB;
    const unsigned ldsw = (unsigned)wid * 1024u;
    const int aoff = lds_byte(wr * 64 + fr, fq * 8), boff = lds_byte(wc * 32 + fr, fq * 8);
#define PG8_SA(b, h) (((b) * 2 + (h)) * HTB)
#define PG8_SB(b, h) ((4 + (b) * 2 + (h)) * HTB)
#define PG8_STAGE(bufoff, gbase, voff) do { _Pragma("unroll") for (int _i = 0; _i < 2; ++_i) \
        __builtin_amdgcn_global_load_lds((const unsigned*)((const char*)(gbase) + (voff)[_i]), (PG8_LAS unsigned*)(lds + (bufoff) + ldsw + _i * 8192), 16, 0, 0); } while (0)
#define PG8_LDA(dst, b, h) do { _Pragma("unroll") for (int m = 0; m < 4; ++m) _Pragma("unroll") for (int k = 0; k < 2; ++k) dst[m][k] = *(const PG8_LAS bf16x8*)(lds + PG8_SA(b, h) + aoff + m * 2048 + k * 1024); } while (0)
#define PG8_LDB(dst, b, h) do { _Pragma("unroll") for (int n = 0; n < 2; ++n) _Pragma("unroll") for (int k = 0; k < 2; ++k) dst[n][k] = *(const PG8_LAS bf16x8*)(lds + PG8_SB(b, h) + boff + n * 2048 + k * 1024); } while (0)
#define PG8_MMA(ai, bj, At, Bt) do { __builtin_amdgcn_s_setprio(1); _Pragma("unroll") for (int m = 0; m < 4; ++m) _Pragma("unroll") for (int n = 0; n < 2; ++n) _Pragma("unroll") for (int k = 0; k < 2; ++k) \
        acc[ai][bj][m][n] = __builtin_amdgcn_mfma_f32_16x16x32_bf16(Bt[n][k], At[m][k], acc[ai][bj][m][n], 0, 0, 0); __builtin_amdgcn_s_setprio(0); } while (0)
#define PG8_WAIT_V(n) asm volatile("s_waitcnt vmcnt(" #n ")" ::: "memory")
#define PG8_WAIT_L(n) asm volatile("s_waitcnt lgkmcnt(" #n ")" ::: "memory")
#define PG8_BAR __builtin_amdgcn_s_barrier()
#define PG8_SCHED __builtin_amdgcn_sched_barrier(0)
    Unit cur, nxt; int ui = 0;
    if (!S.next(0, cur)) return;
    f32x4 acc[2][2][4][2];
#pragma unroll
    for (int a = 0; a < 2; ++a)
#pragma unroll
        for (int b = 0; b < 2; ++b)
#pragma unroll
            for (int m = 0; m < 4; ++m)
#pragma unroll
                for (int n = 0; n < 2; ++n) acc[a][b][m][n] = (f32x4){0.f, 0.f, 0.f, 0.f};
    bf16x8 At[4][2], B0[2][2], B1[2][2];
    float epre[8];
    const char* cA = (const char*)g.A + (size_t)cur.pm * tstepA; const char* cB = (const char*)g.Bt + (size_t)cur.pn * tstepB;
    S.a_ready(cur);
    if constexpr (SP2) {
        PG8_STAGE(PG8_SB(0, 0), cB, voffB); PG8_STAGE(PG8_SB(0, 1), cB + hstepB, voffB); PG8_STAGE(PG8_SA(0, 0), cA, voffA); PG8_STAGE(PG8_SA(0, 1), cA + hstepA, voffA);
        if (wr == 1) PG8_BAR;
        PG8_WAIT_V(2); PG8_BAR;
        PG8_STAGE(PG8_SB(1, 0), cB + kstep, voffB); PG8_STAGE(PG8_SA(1, 0), cA + kstep, voffA); PG8_STAGE(PG8_SB(1, 1), cB + hstepB + kstep, voffB);
        PG8_WAIT_V(6); PG8_BAR;
    } else {
        PG8_STAGE(PG8_SB(0, 0), cB, voffB); PG8_STAGE(PG8_SA(0, 0), cA, voffA); PG8_STAGE(PG8_SB(0, 1), cB + hstepB, voffB); PG8_STAGE(PG8_SA(0, 1), cA + hstepA, voffA);
        if (wr == 1) PG8_BAR;
        PG8_WAIT_V(4); PG8_BAR;
        PG8_STAGE(PG8_SB(1, 0), cB + kstep, voffB); PG8_STAGE(PG8_SA(1, 0), cA + kstep, voffA); PG8_STAGE(PG8_SB(1, 1), cB + hstepB + kstep, voffB);
        PG8_WAIT_V(6); PG8_BAR;
    }
    for (;;) {
        const bool has_next = S.next(ui + 1, nxt);
        const char* nA = has_next ? (const char*)g.A + (size_t)nxt.pm * tstepA : cA; const char* nB = has_next ? (const char*)g.Bt + (size_t)nxt.pn * tstepB : cB;
        for (int t = 0; t < nt; t += 2) {
            const bool last = (t == nt - 2);
            const char* a1 = cA + (size_t)(t + 1) * kstep;
            const char* a2 = last ? nA : cA + (size_t)(t + 2) * kstep; const char* b2 = last ? nB : cB + (size_t)(t + 2) * kstep;
            const char* a3 = a2 + kstep; const char* b3 = b2 + kstep;
            if (last && has_next) S.a_ready(nxt);
            if (last) E.prefetch(epre, cur, wr, fr);
            if constexpr (SP2) {
            PG8_LDB(B0, 0, 0); PG8_LDB(B1, 0, 1); PG8_SCHED; PG8_LDA(At, 0, 0); PG8_STAGE(PG8_SA(1, 1), a1 + hstepA, voffA);
            PG8_WAIT_V(8); PG8_WAIT_L(0); PG8_BAR; PG8_MMA(0, 0, At, B0); PG8_MMA(0, 1, At, B1); PG8_BAR; PG8_SCHED;
            PG8_LDA(At, 0, 1); PG8_STAGE(PG8_SB(0, 0), b2, voffB); PG8_STAGE(PG8_SB(0, 1), b2 + hstepB, voffB); PG8_STAGE(PG8_SA(0, 0), a2, voffA);
            PG8_WAIT_V(8); PG8_WAIT_L(0); PG8_BAR; PG8_MMA(1, 0, At, B0); PG8_MMA(1, 1, At, B1); PG8_BAR; PG8_SCHED;
            PG8_LDB(B0, 1, 0); PG8_LDB(B1, 1, 1); PG8_SCHED; PG8_LDA(At, 1, 0); PG8_STAGE(PG8_SA(0, 1), a2 + hstepA, voffA);
            PG8_WAIT_V(8); PG8_WAIT_L(0); PG8_BAR; PG8_MMA(0, 0, At, B0); PG8_MMA(0, 1, At, B1); PG8_BAR; PG8_SCHED;
            PG8_LDA(At, 1, 1); PG8_STAGE(PG8_SB(1, 0), b3, voffB); PG8_STAGE(PG8_SB(1, 1), b3 + hstepB, voffB); PG8_STAGE(PG8_SA(1, 0), a3, voffA);
            PG8_WAIT_V(8); PG8_WAIT_L(0); PG8_BAR; PG8_MMA(1, 0, At, B0); PG8_MMA(1, 1, At, B1); PG8_BAR; PG8_SCHED;
            } else {
            PG8_LDB(B0, 0, 0); PG8_SCHED; PG8_LDA(At, 0, 0); PG8_STAGE(PG8_SA(1, 1), a1 + hstepA, voffA);
            PG8_WAIT_L(8); PG8_BAR; PG8_WAIT_L(0); PG8_MMA(0, 0, At, B0); PG8_BAR; PG8_SCHED;
            PG8_LDB(B1, 0, 1); PG8_STAGE(PG8_SB(0, 0), b2, voffB);
            PG8_BAR; PG8_WAIT_L(0); PG8_MMA(0, 1, At, B1); PG8_BAR;
            PG8_LDA(At, 0, 1); PG8_STAGE(PG8_SA(0, 0), a2, voffA);
            PG8_BAR; PG8_WAIT_L(0); PG8_MMA(1, 0, At, B0); PG8_BAR; PG8_SCHED;
            PG8_STAGE(PG8_SB(0, 1), b2 + hstepB, voffB);
            PG8_WAIT_V(6); PG8_BAR; PG8_MMA(1, 1, At, B1); PG8_BAR;
            PG8_LDB(B0, 1, 0); PG8_SCHED; PG8_LDA(At, 1, 0); PG8_STAGE(PG8_SA(0, 1), a2 + hstepA, voffA);
            PG8_WAIT_L(8); PG8_BAR; PG8_WAIT_L(0); PG8_MMA(0, 0, At, B0); PG8_BAR; PG8_SCHED;
            PG8_LDB(B1, 1, 1); PG8_STAGE(PG8_SB(1, 0), b3, voffB);
            PG8_BAR; PG8_WAIT_L(0); PG8_MMA(0, 1, At, B1); PG8_BAR;
            PG8_LDA(At, 1, 1); PG8_STAGE(PG8_SA(1, 0), a3, voffA);
            PG8_BAR; PG8_WAIT_L(0); PG8_MMA(1, 0, At, B0); PG8_BAR; PG8_SCHED;
            PG8_STAGE(PG8_SB(1, 1), b3 + hstepB, voffB);
            PG8_WAIT_V(6); PG8_BAR; PG8_MMA(1, 1, At, B1); PG8_BAR;
            }
        }
        if constexpr (ALIGN_EPI) { if (wr == 0) PG8_BAR; }
        if constexpr (!Epi::AFTER_DRAIN) { E(acc, cur, wr, wc, fr, fq, epre); S.done(cur); }
        if (!has_next) break;
#pragma unroll
        for (int a = 0; a < 2; ++a)
#pragma unroll
            for (int b = 0; b < 2; ++b)
#pragma unroll
                for (int m = 0; m < 4; ++m)
#pragma unroll
                    for (int n = 0; n < 2; ++n) acc[a][b][m][n] = (f32x4){0.f, 0.f, 0.f, 0.f};
        cur = nxt; cA = nA; cB = nB; ++ui;
        if constexpr (ALIGN_EPI) { if (wr == 1) PG8_BAR; }
    }
    PG8_WAIT_V(0);
    if constexpr (!ALIGN_EPI) { if (wr == 0) PG8_BAR; }
    PG8_BAR;
    if constexpr (Epi::AFTER_DRAIN) { E.fused(acc, cur, wr, wc, fr, fq, lds, wid, lane); S.done(cur); }
#undef PG8_SA
#undef PG8_SB
#undef PG8_STAGE
#undef PG8_LDA
#undef PG8_LDB
#undef PG8_MMA
#undef PG8_WAIT_V
#undef PG8_WAIT_L
#undef PG8_BAR
#undef PG8_SCHED
}
}

#define LAS __attribute__((address_space(3)))
typedef unsigned short bf16;
typedef short bf16x8 __attribute__((ext_vector_type(8)));
typedef float f32x4 __attribute__((ext_vector_type(4)));
typedef float f32x16 __attribute__((ext_vector_type(16)));
typedef unsigned u32x4 __attribute__((ext_vector_type(4)));
typedef unsigned u32x2 __attribute__((ext_vector_type(2)));
typedef short v4i16_t __attribute__((ext_vector_type(4)));
typedef float f32x2_t __attribute__((ext_vector_type(2)));
typedef __bf16 bf16x2_t __attribute__((ext_vector_type(2)));

constexpr int D_MODEL = 1024, BATCH = 32, SEQ = 2048, DEPTH = 4, MTOK = BATCH * SEQ, D_FF = 4096, A_WIDTH = 2048, NQKV = 3072;
constexpr float EPS = 1e-6f;
constexpr size_t MiB = 1u << 20;
constexpr size_t WS_WIN = 1 * MiB, WS_WOUTA = 17 * MiB, WS_WQKV = 25 * MiB, WS_WOB = 37 * MiB, WS_W1 = 41 * MiB, WS_W2 = 73 * MiB, WS_WC = 105 * MiB;
constexpr size_t WS_HN = 112 * MiB, WS_Z = 240 * MiB, WS_STAT = 752 * MiB, WS_XCH = 768 * MiB, WS_XSTAT = 769 * MiB, WS_CNT = 770 * MiB, WS_XCH2 = 771 * MiB, WS_END = 772 * MiB;
constexpr int LDS_BYTES = 147456, LDS_BST = 131072 + 1024;
constexpr size_t WS_BAR = 65536;
constexpr int NWAVES = 8;
#ifndef PROBE_MIX
#define PROBE_MIX 0
#endif
#ifndef PROBE_ATTN
#define PROBE_ATTN 0
#endif


__device__ __forceinline__ unsigned cvtpk(float lo, float hi) { f32x2_t v = {lo, hi}; bf16x2_t b = __builtin_convertvector(v, bf16x2_t); return __builtin_bit_cast(unsigned, b); }
__device__ __forceinline__ float bflo(unsigned w) { return __uint_as_float(w << 16); }
__device__ __forceinline__ float bfhi(unsigned w) { return __uint_as_float(w & 0xffff0000u); }
__device__ __forceinline__ float wave_sum(float v) {
#pragma unroll
    for (int o = 1; o < 64; o <<= 1) v += __shfl_xor(v, o);
    return v;
}
__device__ __forceinline__ int crow(int r, int hi) { return (r & 3) + 8 * (r >> 2) + 4 * hi; }
__device__ __forceinline__ v4i16_t tr_read(LAS unsigned char* p) { return __builtin_amdgcn_ds_read_tr16_b64_v4i16((LAS v4i16_t*)p); }

struct EpiAct {
    static constexpr bool PERM = true, AFTER_DRAIN = false;
    bf16* O; int ldc; int act; const float* rowstat; float* stat;
    __device__ __forceinline__ void prefetch(float (&pre)[8], const pg8::Unit& u, int wr, int fr) const {
        const int row0 = u.pm * pg8::BM + wr * 64 + fr;
#pragma unroll
        for (int ai = 0; ai < 2; ++ai)
#pragma unroll
            for (int m = 0; m < 4; ++m) pre[ai * 4 + m] = rowstat ? rowstat[row0 + ai * pg8::HALF + m * 16] : 1.f;
    }
    template <int MODE>
    __device__ __forceinline__ void run(pg8::f32x4 (&acc)[2][2][4][2], const pg8::Unit& u, int wr, int wc, int fr, int fq, const float (&pre)[8], float sc) const {
        using namespace pg8;
        const int row0 = u.pm * BM + wr * 64 + fr; const int col0 = u.pn * BM + wc * 32 + 8 * fq;
#pragma unroll
        for (int ai = 0; ai < 2; ++ai)
#pragma unroll
            for (int m = 0; m < 4; ++m) { bf16* rowp = O + (size_t)(row0 + ai * HALF + m * 16) * ldc + col0;
                float rs = 0.f, rq = 0.f; const float ps = pre[ai * 4 + m] * sc;
#pragma unroll
                for (int bj = 0; bj < 2; ++bj) { pg8::f32x4 v0 = acc[ai][bj][m][0] * ps, v1 = acc[ai][bj][m][1] * ps;
                    if (MODE == 1) { f32x2 a = gelu_pk((f32x2){v0[0], v0[1]}), b = gelu_pk((f32x2){v0[2], v0[3]}), c = gelu_pk((f32x2){v1[0], v1[1]}), d = gelu_pk((f32x2){v1[2], v1[3]});
                        v0 = (pg8::f32x4){a.x, a.y, b.x, b.y}; v1 = (pg8::f32x4){c.x, c.y, d.x, d.y};
                        rs += ((v0[0] + v0[1]) + (v0[2] + v0[3])) + ((v1[0] + v1[1]) + (v1[2] + v1[3]));
                        rq += ((v0[0] * v0[0] + v0[1] * v0[1]) + (v0[2] * v0[2] + v0[3] * v0[3])) + ((v1[0] * v1[0] + v1[1] * v1[1]) + (v1[2] * v1[2] + v1[3] * v1[3])); }
                    else if (MODE == 2) {
#pragma unroll
                        for (int e = 0; e < 4; ++e) { const float a = fmaxf(v0[e], 0.f), b = fmaxf(v1[e], 0.f); v0[e] = a * a; v1[e] = b * b; } }
                    pg8::u32x4 w; w.x = cvtpk(v0[0], v0[1]); w.y = cvtpk(v0[2], v0[3]); w.z = cvtpk(v1[0], v1[1]); w.w = cvtpk(v1[2], v1[3]);
                    *(pg8::u32x4*)(rowp + bj * HALF) = w; }
                if (MODE == 1) { rs += __shfl_xor(rs, 16); rs += __shfl_xor(rs, 32); rq += __shfl_xor(rq, 16); rq += __shfl_xor(rq, 32);
                    if (fq == 0) *(f32x2*)(stat + ((size_t)(row0 + ai * HALF + m * 16) * 32 + (u.pn - 8) * 4 + wc) * 2) = (f32x2){rs, rq}; } }
    }
    __device__ __forceinline__ void operator()(pg8::f32x4 (&acc)[2][2][4][2], const pg8::Unit& u, int wr, int wc, int fr, int fq, const float (&pre)[8]) const {
        asm volatile("" : "+v"(fr), "+v"(fq));
        const float sc = (act == 3 && u.pn * pg8::BM < 1024) ? 0.125f : 1.f;
        if (act == 2) run<2>(acc, u, wr, wc, fr, fq, pre, 1.f);
        else if (act == 1 && u.pn >= 8) run<1>(acc, u, wr, wc, fr, fq, pre, 1.f);
        else run<0>(acc, u, wr, wc, fr, fq, pre, sc);
    }
};

constexpr int LDS_P = 131072 + 2048, LDS_S = LDS_P + 4096, LDS_G = LDS_S + 1024;
struct EpiRes {
    static constexpr bool PERM = true, AFTER_DRAIN = false;
    bf16* XB; float* outf; float* xch; float* xch2; unsigned* cnt; unsigned* cnt2; float* rs; LAS unsigned char* lds;
    __device__ __forceinline__ void prefetch(float (&)[8], const pg8::Unit&, int, int) const {}
    __device__ __forceinline__ void wait32(unsigned* c) const {
        unsigned sp = 0u;
        while ((unsigned)__builtin_amdgcn_readfirstlane(__hip_atomic_load(c, __ATOMIC_RELAXED, __HIP_MEMORY_SCOPE_AGENT)) < 32u) { __builtin_amdgcn_s_sleep(1); if (++sp > (1u << 22)) break; }
        __builtin_amdgcn_fence(__ATOMIC_ACQUIRE, "agent");
    }
    __device__ __forceinline__ void operator()(pg8::f32x4 (&acc)[2][2][4][2], const pg8::Unit& u, int wr, int wc, int fr, int fq, const float (&)[8]) const {
        using namespace pg8;
        asm volatile("" : "+v"(fr), "+v"(fq));
        const int lane = fq * 16 + fr, wid = wr * 4 + wc;
        LAS float* P = (LAS float*)(lds + LDS_P); LAS float* S = (LAS float*)(lds + LDS_S); LAS float* Gs = (LAS float*)(lds + LDS_G);
        const int col0 = u.pn * BM + wc * 32 + 8 * fq;
#pragma unroll
        for (int ai = 0; ai < 2; ++ai)
#pragma unroll
            for (int m = 0; m < 4; ++m) { float q = 0.f;
#pragma unroll
                for (int bj = 0; bj < 2; ++bj)
#pragma unroll
                    for (int n = 0; n < 2; ++n) { const pg8::f32x4 v = acc[ai][bj][m][n]; q += (v[0] * v[0] + v[1] * v[1]) + (v[2] * v[2] + v[3] * v[3]); }
                q += __shfl_xor(q, 16); q += __shfl_xor(q, 32);
                if (fq == 0) P[(ai * HALF + wr * 64 + m * 16 + fr) * 4 + wc] = q; }
        asm volatile("s_waitcnt lgkmcnt(0)" ::: "memory"); __builtin_amdgcn_s_barrier(); asm volatile("" ::: "memory");
        const int row = wid * 32 + (lane & 31);
        if (lane < 32) { const pg8::f32x4 pp = *(LAS pg8::f32x4*)(P + row * 4);
            __hip_atomic_store(xch + ((size_t)(u.pm * BM + row) * 4 + u.pn), (pp[0] + pp[1]) + (pp[2] + pp[3]), __ATOMIC_RELAXED, __HIP_MEMORY_SCOPE_AGENT); }
        asm volatile("" ::: "memory");
        pg8::u32x4 xpre0[4][2], xpre1[4][2];
#pragma unroll
        for (int m = 0; m < 4; ++m)
#pragma unroll
            for (int bj = 0; bj < 2; ++bj) xpre0[m][bj] = *(const pg8::u32x4*)(XB + (size_t)(u.pm * BM + wr * 64 + m * 16 + fr) * 1024 + col0 + bj * HALF);
        asm volatile("" ::: "memory");
        asm volatile("s_waitcnt vmcnt(8)" ::: "memory");
        if (lane == 0) __hip_atomic_fetch_add(cnt + 64 * u.pm, 1u, __ATOMIC_RELAXED, __HIP_MEMORY_SCOPE_AGENT);
        if (wid == 0) wait32(cnt + 64 * u.pm);
        asm volatile("s_waitcnt vmcnt(0) lgkmcnt(0)" ::: "memory"); __builtin_amdgcn_s_barrier(); asm volatile("" ::: "memory");
        if (lane < 32) { const float* sl = xch + (size_t)(u.pm * BM + row) * 4; float t = 0.f;
#pragma unroll
            for (int k = 0; k < 4; ++k) t += __hip_atomic_load(sl + k, __ATOMIC_RELAXED, __HIP_MEMORY_SCOPE_AGENT);
            S[row] = 1.0f / sqrtf(t * (1.f / 1024.f) + 1e-6f); }
        asm volatile("s_waitcnt lgkmcnt(0)" ::: "memory"); __builtin_amdgcn_s_barrier(); asm volatile("" ::: "memory");
        pg8::f32x4 gp[2][2];
#pragma unroll
        for (int bj = 0; bj < 2; ++bj) { gp[bj][0] = *(LAS pg8::f32x4*)(Gs + col0 + bj * HALF); gp[bj][1] = *(LAS pg8::f32x4*)(Gs + col0 + bj * HALF + 4); }
#pragma unroll
        for (int ai = 0; ai < 2; ++ai) {
#pragma unroll
            for (int m = 0; m < 4; ++m) { const int r = ai * HALF + wr * 64 + m * 16 + fr; const float rsm = S[r]; const size_t off = (size_t)(u.pm * BM + r) * 1024 + col0; float q2 = 0.f;
#pragma unroll
                for (int bj = 0; bj < 2; ++bj) { const pg8::u32x4 xw = ai == 0 ? xpre0[m][bj] : xpre1[m][bj];
                    pg8::f32x4 x0 = {__uint_as_float(xw.x << 16), __uint_as_float(xw.x & 0xffff0000u), __uint_as_float(xw.y << 16), __uint_as_float(xw.y & 0xffff0000u)};
                    pg8::f32x4 x1 = {__uint_as_float(xw.z << 16), __uint_as_float(xw.z & 0xffff0000u), __uint_as_float(xw.w << 16), __uint_as_float(xw.w & 0xffff0000u)};
                    x0 = x0 + acc[ai][bj][m][0] * rsm * gp[bj][0]; x1 = x1 + acc[ai][bj][m][1] * rsm * gp[bj][1];
                    q2 += ((x0[0] * x0[0] + x0[1] * x0[1]) + (x0[2] * x0[2] + x0[3] * x0[3])) + ((x1[0] * x1[0] + x1[1] * x1[1]) + (x1[2] * x1[2] + x1[3] * x1[3]));
                    acc[ai][bj][m][0] = x0; acc[ai][bj][m][1] = x1; }
                if (ai == 0) {
#pragma unroll
                    for (int bj = 0; bj < 2; ++bj) xpre1[m][bj] = *(const pg8::u32x4*)(XB + (size_t)(u.pm * BM + HALF + wr * 64 + m * 16 + fr) * 1024 + col0 + bj * HALF);
                    asm volatile("" ::: "memory"); }
                q2 += __shfl_xor(q2, 16); q2 += __shfl_xor(q2, 32);
                if (fq == 0) P[r * 4 + wc] = q2; }
            asm volatile("" ::: "memory"); }
        asm volatile("s_waitcnt lgkmcnt(0)" ::: "memory"); __builtin_amdgcn_s_barrier(); asm volatile("" ::: "memory");
        if (lane < 32) { const pg8::f32x4 pp = *(LAS pg8::f32x4*)(P + row * 4);
            __hip_atomic_store(xch2 + ((size_t)(u.pm * BM + row) * 4 + u.pn), (pp[0] + pp[1]) + (pp[2] + pp[3]), __ATOMIC_RELAXED, __HIP_MEMORY_SCOPE_AGENT); }
        asm volatile("s_waitcnt vmcnt(0)" ::: "memory");
        if (lane == 0) __hip_atomic_fetch_add(cnt2 + 64 * u.pm, 1u, __ATOMIC_RELAXED, __HIP_MEMORY_SCOPE_AGENT);
#pragma unroll
        for (int ai = 0; ai < 2; ++ai)
#pragma unroll
            for (int m = 0; m < 4; ++m) { const size_t off = (size_t)(u.pm * BM + ai * HALF + wr * 64 + m * 16 + fr) * 1024 + col0;
#pragma unroll
                for (int bj = 0; bj < 2; ++bj) { const pg8::f32x4 x0 = acc[ai][bj][m][0], x1 = acc[ai][bj][m][1];
                    if (outf) { *(pg8::f32x4*)(outf + off + bj * HALF) = x0; *(pg8::f32x4*)(outf + off + bj * HALF + 4) = x1; }
                    else { pg8::u32x4 w; w.x = cvtpk(x0[0], x0[1]); w.y = cvtpk(x0[2], x0[3]); w.z = cvtpk(x1[0], x1[1]); w.w = cvtpk(x1[2], x1[3]); *(pg8::u32x4*)(XB + off + bj * HALF) = w; } } }
        if (u.pn == (u.pm & 3)) {
            if (wid == 0) wait32(cnt2 + 64 * u.pm);
            asm volatile("s_waitcnt vmcnt(0) lgkmcnt(0)" ::: "memory"); __builtin_amdgcn_s_barrier(); asm volatile("" ::: "memory");
            if (lane < 32) { const float* sl = xch2 + (size_t)(u.pm * BM + row) * 4; float t = 0.f;
#pragma unroll
                for (int k = 0; k < 4; ++k) t += __hip_atomic_load(sl + k, __ATOMIC_RELAXED, __HIP_MEMORY_SCOPE_AGENT);
                rs[u.pm * BM + row] = 1.0f / sqrtf(t * (1.f / 1024.f) + 1e-6f); }
        }
    }
};

__device__ __forceinline__ void transpose_item(const float* W, const float* gk, int K, int N, bf16* WT, LAS float* scr, int item, int lane) {
    const int nblk = N / 32, kb = item / nblk, nb = item % nblk, k0 = 64 * kb, n0 = 32 * nb;
#pragma unroll
    for (int i = 0; i < 32; ++i) { const int kk = 2 * i + (lane >> 5); scr[kk * 33 + (lane & 31)] = W[(size_t)(k0 + kk) * N + n0 + (lane & 31)]; }
    const int c = lane & 7;
    f32x4 ga = {1.f, 1.f, 1.f, 1.f}, gb = ga;
    if (gk) { ga = *(const f32x4*)(gk + k0 + 8 * c); gb = *(const f32x4*)(gk + k0 + 8 * c + 4); }
    asm volatile("s_waitcnt lgkmcnt(0)" ::: "memory");
#pragma unroll
    for (int j = 0; j < 4; ++j) { const int n = (lane >> 3) + 8 * j; const LAS float* s = scr + (8 * c) * 33 + n;
        u32x4 o; o.x = cvtpk(s[0 * 33] * ga.x, s[1 * 33] * ga.y); o.y = cvtpk(s[2 * 33] * ga.z, s[3 * 33] * ga.w); o.z = cvtpk(s[4 * 33] * gb.x, s[5 * 33] * gb.y); o.w = cvtpk(s[6 * 33] * gb.z, s[7 * 33] * gb.w);
        *(u32x4*)(WT + (size_t)(n0 + n) * K + k0 + 8 * c) = o; }
    asm volatile("s_waitcnt lgkmcnt(0)" ::: "memory");
}
__device__ __forceinline__ void transpose_matrix(const float* W, const float* gk, int K, int N, bf16* WT, LAS float* scr, int gw, int ngw, int lane) {
    const int items = (K / 64) * (N / 32);
    for (int it = gw; it < items; it += ngw) transpose_item(W, gk, K, N, WT, scr, it, lane);
}

__device__ __forceinline__ void tr_load(float (&r)[32], const float* W, int N, int item, int lane) {
    const int nblk = N / 32, kb = item / nblk, nb = item % nblk, k0 = 64 * kb, n0 = 32 * nb;
#pragma unroll
    for (int i = 0; i < 32; ++i) { const int kk = 2 * i + (lane >> 5); r[i] = W[(size_t)(k0 + kk) * N + n0 + (lane & 31)]; }
}
__device__ __forceinline__ void tr_finish(const float (&r)[32], const float* gk, int K, int N, bf16* WT, LAS float* scr, int item, int lane) {
    const int nblk = N / 32, kb = item / nblk, nb = item % nblk, k0 = 64 * kb, n0 = 32 * nb;
#pragma unroll
    for (int i = 0; i < 32; ++i) { const int kk = 2 * i + (lane >> 5); scr[kk * 33 + (lane & 31)] = r[i]; }
    const int c = lane & 7;
    f32x4 ga = {1.f, 1.f, 1.f, 1.f}, gb = ga;
    if (gk) { ga = *(const f32x4*)(gk + k0 + 8 * c); gb = *(const f32x4*)(gk + k0 + 8 * c + 4); }
    asm volatile("s_waitcnt lgkmcnt(0)" ::: "memory");
#pragma unroll
    for (int j = 0; j < 4; ++j) { const int n = (lane >> 3) + 8 * j; const LAS float* s = scr + (8 * c) * 33 + n;
        u32x4 o; o.x = cvtpk(s[0 * 33] * ga.x, s[1 * 33] * ga.y); o.y = cvtpk(s[2 * 33] * ga.z, s[3 * 33] * ga.w); o.z = cvtpk(s[4 * 33] * gb.x, s[5 * 33] * gb.y); o.w = cvtpk(s[6 * 33] * gb.z, s[7 * 33] * gb.w);
        *(u32x4*)(WT + (size_t)(n0 + n) * K + k0 + 8 * c) = o; }
    asm volatile("s_waitcnt lgkmcnt(0)" ::: "memory");
}

__device__ __forceinline__ void x_to_bf16(const float* xin, bf16* xb, float* xstat, int wave, int lane) {
    const int gw = blockIdx.x * NWAVES + wave, ngw = gridDim.x * NWAVES;
    for (int m0 = gw * 4; m0 < MTOK; m0 += ngw * 4) {
        f32x4 v[4][4];
#pragma unroll
        for (int r = 0; r < 4; ++r) { const f32x4* xr = (const f32x4*)(xin + (size_t)(m0 + r) * D_MODEL) + lane;
#pragma unroll
            for (int j = 0; j < 4; ++j) v[r][j] = xr[64 * j]; }
#pragma unroll
        for (int r = 0; r < 4; ++r) { float ss = 0.f;
#pragma unroll
            for (int j = 0; j < 4; ++j) ss += (v[r][j].x * v[r][j].x + v[r][j].y * v[r][j].y) + (v[r][j].z * v[r][j].z + v[r][j].w * v[r][j].w);
            ss = wave_sum(ss);
            u32x2* ho = (u32x2*)(xb + (size_t)(m0 + r) * D_MODEL) + lane;
#pragma unroll
            for (int j = 0; j < 4; ++j) { u32x2 w; w.x = cvtpk(v[r][j].x, v[r][j].y); w.y = cvtpk(v[r][j].z, v[r][j].w); ho[64 * j] = w; }
            if (lane == 0) xstat[m0 + r] = 1.0f / sqrtf(ss * (1.f / D_MODEL) + EPS); }
    }
}

__device__ __forceinline__ void row_pass(bf16* xb, const bf16* mo, const float* gpost, float* outf, float* xstat, int wave, int lane) {
    const int gw = blockIdx.x * NWAVES + wave, ngw = gridDim.x * NWAVES;
    f32x4 gp[4];
#pragma unroll
    for (int j = 0; j < 4; ++j) gp[j] = *((const f32x4*)gpost + lane + 64 * j);
    for (int m0 = gw * 4; m0 < MTOK; m0 += ngw * 4) {
        u32x2 xw[4][4], mw[4][4];
#pragma unroll
        for (int r = 0; r < 4; ++r) { const u32x2* xr = (const u32x2*)(xb + (size_t)(m0 + r) * D_MODEL) + lane; const u32x2* mr = (const u32x2*)(mo + (size_t)(m0 + r) * D_MODEL) + lane;
#pragma unroll
            for (int j = 0; j < 4; ++j) { xw[r][j] = xr[64 * j]; mw[r][j] = mr[64 * j]; } }
#pragma unroll
        for (int r = 0; r < 4; ++r) {
            const int m = m0 + r;
            f32x4 mv[4], v[4]; float ss = 0.f;
#pragma unroll
            for (int j = 0; j < 4; ++j) { mv[j] = (f32x4){bflo(mw[r][j].x), bfhi(mw[r][j].x), bflo(mw[r][j].y), bfhi(mw[r][j].y)}; v[j] = (f32x4){bflo(xw[r][j].x), bfhi(xw[r][j].x), bflo(xw[r][j].y), bfhi(xw[r][j].y)};
                ss += (mv[j].x * mv[j].x + mv[j].y * mv[j].y) + (mv[j].z * mv[j].z + mv[j].w * mv[j].w); }
            const float rstd = 1.0f / sqrtf(wave_sum(ss) * (1.f / D_MODEL) + EPS);
            float s2 = 0.f;
#pragma unroll
            for (int j = 0; j < 4; ++j) { v[j] = v[j] + mv[j] * rstd * gp[j]; s2 += (v[j].x * v[j].x + v[j].y * v[j].y) + (v[j].z * v[j].z + v[j].w * v[j].w); }
            s2 = wave_sum(s2);
            if (outf) { f32x4* xo = (f32x4*)(outf + (size_t)m * D_MODEL) + lane;
#pragma unroll
                for (int j = 0; j < 4; ++j) xo[64 * j] = v[j]; }
            else { u32x2* ho = (u32x2*)(xb + (size_t)m * D_MODEL) + lane;
#pragma unroll
                for (int j = 0; j < 4; ++j) { u32x2 w; w.x = cvtpk(v[j].x, v[j].y); w.y = cvtpk(v[j].z, v[j].w); ho[64 * j] = w; }
                if (lane == 0) xstat[m] = 1.0f / sqrtf(s2 * (1.f / D_MODEL) + EPS); }
        }
    }
}

__device__ __forceinline__ void mix_phase(bf16* Z, bf16* Gout, int ldg, const float* stat, const float* vg, const float* vbias, const bf16* Wc, const float* bs, LAS unsigned char* lds, int tid, int wave, int lane) {
    constexpr int LD = 4096, PITCH = 576, WPITCH = 272, OFF_W = 128 * PITCH, OFF_ST = OFF_W + 128 * WPITCH;
    LAS float* st = (LAS float*)(lds + OFF_ST);
    const int nper = gridDim.x >> 3, g = blockIdx.x & 7, ci = blockIdx.x >> 3;
    if (nper == 0 || ci >= nper) return;
    const int r32 = lane & 31, hi = lane >> 5;
    const int troff = (8 * hi + ((lane & 15) >> 2)) * PITCH + (32 * wave + 16 * ((lane >> 4) & 1) + 4 * (lane & 3)) * 2;
#pragma unroll
    for (int it = 0; it < 4; ++it) { const int idx = it * 512 + tid, row = idx >> 4, ch = idx & 15;
        *(LAS u32x4*)(lds + OFF_W + row * WPITCH + ch * 16) = *(const u32x4*)(Wc + ((size_t)g * 128 + row) * 128 + ch * 8); }
    const int vrow = tid >> 5, vch = tid & 31;
    const f32x4 g0 = *(const f32x4*)(vg + g * 256 + vch * 8), g1 = *(const f32x4*)(vg + g * 256 + vch * 8 + 4);
    const f32x4 b0 = *(const f32x4*)(vbias + g * 256 + vch * 8), b1 = *(const f32x4*)(vbias + g * 256 + vch * 8 + 4);
    const int srow = tid >> 2, sq = tid & 3;
    float bsr[4];
#pragma unroll
    for (int tb = 0; tb < 4; ++tb) bsr[tb] = bs[g * 128 + tb * 32 + r32];
    u32x4 rawv[8]; f32x4 stp[4];
    { const size_t row0 = (size_t)ci * 128;
#pragma unroll
      for (int it = 0; it < 8; ++it) rawv[it] = *(const u32x4*)(Z + (row0 + it * 16 + vrow) * LD + 2048 + g * 256 + vch * 8);
#pragma unroll
      for (int k = 0; k < 4; ++k) stp[k] = *(const f32x4*)(stat + ((row0 + srow) * 32 + sq * 8 + k * 2) * 2); }
    for (int chunk = ci; chunk < MTOK / 128; chunk += nper) {
        const size_t row0 = (size_t)chunk * 128;
        bf16* up = Z + (row0 + r32) * LD + g * 256 + 32 * wave + 4 * hi;
        bf16* gp = Gout + (row0 + r32) * ldg + g * 256 + 32 * wave + 4 * hi;
        u32x2 uw[4][4];
#pragma unroll
        for (int tb = 0; tb < 4; ++tb)
#pragma unroll
            for (int g4 = 0; g4 < 4; ++g4) uw[tb][g4] = *(const u32x2*)(up + (size_t)tb * 32 * LD + 8 * g4);
        { float s = (stp[0].x + stp[0].z) + (stp[1].x + stp[1].z) + (stp[2].x + stp[2].z) + (stp[3].x + stp[3].z);
          float q = (stp[0].y + stp[0].w) + (stp[1].y + stp[1].w) + (stp[2].y + stp[2].w) + (stp[3].y + stp[3].w);
          s += __shfl_xor(s, 1); s += __shfl_xor(s, 2); q += __shfl_xor(q, 1); q += __shfl_xor(q, 2);
          const float mean = s * (1.f / 2048.f), var = fmaxf(q * (1.f / 2048.f) - mean * mean, 0.f);
          if (sq == 0) { st[2 * srow] = mean; st[2 * srow + 1] = 1.0f / sqrtf(var + EPS); } }
        __syncthreads();
#pragma unroll
        for (int it = 0; it < 8; ++it) {
            const int row = it * 16 + vrow; const u32x4 w = rawv[it];
            const float mean = st[2 * row], rstd = st[2 * row + 1];
            u32x4 o;
            o.x = cvtpk((bflo(w.x) - mean) * rstd * g0.x + b0.x, (bfhi(w.x) - mean) * rstd * g0.y + b0.y);
            o.y = cvtpk((bflo(w.y) - mean) * rstd * g0.z + b0.z, (bfhi(w.y) - mean) * rstd * g0.w + b0.w);
            o.z = cvtpk((bflo(w.z) - mean) * rstd * g1.x + b1.x, (bfhi(w.z) - mean) * rstd * g1.y + b1.y);
            o.w = cvtpk((bflo(w.w) - mean) * rstd * g1.z + b1.z, (bfhi(w.w) - mean) * rstd * g1.w + b1.w);
            *(LAS u32x4*)(lds + row * PITCH + vch * 16) = o;
        }
        __syncthreads();
        if (chunk + nper < MTOK / 128) { const size_t nrow0 = (size_t)(chunk + nper) * 128;
#pragma unroll
            for (int it = 0; it < 8; ++it) rawv[it] = *(const u32x4*)(Z + (nrow0 + it * 16 + vrow) * LD + 2048 + g * 256 + vch * 8);
#pragma unroll
            for (int k = 0; k < 4; ++k) stp[k] = *(const f32x4*)(stat + ((nrow0 + srow) * 32 + sq * 8 + k * 2) * 2); }
        bf16x8 af[8];
#pragma unroll
        for (int ks = 0; ks < 8; ++ks) { const v4i16_t lo = tr_read(lds + troff + (16 * ks) * PITCH), h4 = tr_read(lds + troff + (16 * ks + 4) * PITCH);
            af[ks] = (bf16x8){lo[0], lo[1], lo[2], lo[3], h4[0], h4[1], h4[2], h4[3]}; }
#pragma unroll
        for (int tb = 0; tb < 4; ++tb) {
            f32x16 acc = {};
            LAS unsigned char* wp = lds + OFF_W + (tb * 32 + r32) * WPITCH + 16 * hi;
#pragma unroll
            for (int ks = 0; ks < 2 * (tb + 1); ++ks) { const bf16x8 bfrag = *(LAS bf16x8*)(wp + 32 * ks); acc = __builtin_amdgcn_mfma_f32_32x32x16_bf16(af[ks], bfrag, acc, 0, 0, 0); }
            const float bsv = bsr[tb];
#pragma unroll
            for (int g4 = 0; g4 < 4; ++g4) { const u32x2 u2 = uw[tb][g4]; u32x2 ow;
                const pg8::f32x2 ua = pg8::gelu_pk((pg8::f32x2){bflo(u2.x), bfhi(u2.x)}), ub = pg8::gelu_pk((pg8::f32x2){bflo(u2.y), bfhi(u2.y)});
                ow.x = cvtpk(ua.x * (acc[4 * g4] + bsv), ua.y * (acc[4 * g4 + 1] + bsv));
                ow.y = cvtpk(ub.x * (acc[4 * g4 + 2] + bsv), ub.y * (acc[4 * g4 + 3] + bsv));
                *(u32x2*)(gp + (size_t)tb * 32 * ldg + 8 * g4) = ow; }
        }
        __syncthreads();
    }
}

template <bool DIAG>
__device__ __forceinline__ void attn_tile(f32x16& o0, f32x16& o1, float& carry2, const bf16x8 (&qr)[4], bf16x8 (&kf)[4], u32x4 (&vr)[4], const bf16* kpn, const bf16* vpn, bool has_next,
                                          LAS unsigned char* vcur, int troff, int strow, int stch, int r32, int hi) {
    constexpr int LD = NQKV; constexpr float LOG2E = 1.4426950408889634f;
#pragma unroll
    for (int it = 0; it < 4; ++it) *(LAS u32x4*)(vcur + (it * 8 + strow) * 192 + stch * 16) = vr[it];
    f32x16 p = {};
#pragma unroll
    for (int s = 0; s < 4; ++s) p = __builtin_amdgcn_mfma_f32_32x32x16_bf16(kf[s], qr[s], p, 0, 0, 0);
    (void)has_next;
#pragma unroll
    for (int s = 0; s < 4; ++s) { kf[s] = *(const bf16x8*)(kpn + 16 * s); vr[s] = *(const u32x4*)(vpn + (size_t)s * 8 * LD); }
    float kp[16], be[16];
#pragma unroll
    for (int r = 0; r < 16; ++r) { const float z = __builtin_amdgcn_fmed3f(p[r], -80.f, 3.0e38f);
        const float t = __builtin_amdgcn_exp2f(z * -LOG2E); be[r] = __builtin_amdgcn_rcpf(1.f + t); kp[r] = t * be[r];
        if (DIAG) { const bool msk = crow(r, hi) >= r32; kp[r] = msk ? 1.f : kp[r]; be[r] = msk ? 0.f : be[r]; } }
    float se[16], G[4], oth[4], T[4];
#pragma unroll
    for (int g = 0; g < 4; ++g) { se[4 * g + 3] = 1.f; se[4 * g + 2] = kp[4 * g + 3]; se[4 * g + 1] = se[4 * g + 2] * kp[4 * g + 2]; se[4 * g] = se[4 * g + 1] * kp[4 * g + 1]; G[g] = se[4 * g] * kp[4 * g]; }
#pragma unroll
    for (int g = 0; g < 4; ++g) {
        const auto rr = __builtin_amdgcn_permlane32_swap(__float_as_uint(G[g]), __float_as_uint(G[g]), false, false);
        oth[g] = __uint_as_float(rr[1]); T[g] = __uint_as_float(rr[0]) * __uint_as_float(rr[1]); }
    const float C = __builtin_amdgcn_exp2f(carry2);
    float base[4]; const float a2 = T[3], a1 = T[3] * T[2], a0 = a1 * T[1];
    base[3] = C; base[2] = C * a2; base[1] = C * a1; base[0] = C * a0;
    if (hi == 0) {
#pragma unroll
        for (int g = 0; g < 4; ++g) base[g] *= oth[g]; }
    carry2 += __builtin_amdgcn_logf(a0 * T[0]);
    float a[16];
#pragma unroll
    for (int r = 0; r < 16; ++r) a[r] = be[r] * (se[r] * base[r >> 2]);
    u32x4 pw0, pw1;
    pw0.x = cvtpk(a[0], a[1]); pw0.y = cvtpk(a[2], a[3]); pw0.z = cvtpk(a[4], a[5]); pw0.w = cvtpk(a[6], a[7]);
    pw1.x = cvtpk(a[8], a[9]); pw1.y = cvtpk(a[10], a[11]); pw1.z = cvtpk(a[12], a[13]); pw1.w = cvtpk(a[14], a[15]);
    const bf16x8 pf0 = __builtin_bit_cast(bf16x8, pw0), pf1 = __builtin_bit_cast(bf16x8, pw1);
    asm volatile("" ::: "memory");
#pragma unroll
    for (int dh = 0; dh < 2; ++dh)
#pragma unroll
        for (int s = 0; s < 2; ++s) {
            const v4i16_t lo = tr_read(vcur + troff + (16 * s) * 192 + dh * 64), h4 = tr_read(vcur + troff + (16 * s + 8) * 192 + dh * 64);
            const bf16x8 vf = (bf16x8){lo[0], lo[1], lo[2], lo[3], h4[0], h4[1], h4[2], h4[3]};
            if (dh == 0) o0 = __builtin_amdgcn_mfma_f32_32x32x16_bf16(vf, s == 0 ? pf0 : pf1, o0, 0, 0, 0);
            else o1 = __builtin_amdgcn_mfma_f32_32x32x16_bf16(vf, s == 0 ? pf0 : pf1, o1, 0, 0, 0);
        }
    asm volatile("" ::: "memory");
}
__device__ __forceinline__ void attn_phase(bf16* QKV, bf16* Oout, int ldo, LAS unsigned char* lds, int wave, int lane) {
    constexpr int LD = NQKV;
    const int r32 = lane & 31, hi = lane >> 5;
    LAS unsigned char* vb = lds + wave * 12288;
    const int vcu = (gridDim.x % 8 == 0) ? (int)((blockIdx.x & 7) * (gridDim.x >> 3) + (blockIdx.x >> 3)) : (int)blockIdx.x;
    const int gw = vcu * NWAVES + wave, ngw = gridDim.x * NWAVES;
    const int troff = (4 * hi + ((lane & 15) >> 2)) * 192 + (16 * ((lane >> 4) & 1) + 4 * (lane & 3)) * 2;
    const int strow = lane >> 3, stch = lane & 7;
#define ATT_UNIT(unit_) const int bh = (unit_) >> 6, qb = ((unit_) + 8 * (bh >> 5)) & 63, h = bh & 15, b = bh >> 4;     \
        const size_t rowbase = (size_t)b * SEQ; \
        const bf16* qp = QKV + (rowbase + qb * 32 + r32) * LD + h * 64; \
        const bf16* kbase = QKV + (rowbase + r32) * LD + 1024 + h * 64 + 8 * hi; \
        const bf16* vbase = QKV + (rowbase + strow) * LD + 2048 + h * 64 + stch * 8;
#define ATT_LOAD(Q_) do { const bf16* kp = kbase + (size_t)qb * 32 * LD; const bf16* vp = vbase + (size_t)qb * 32 * LD; \
        _Pragma("unroll") for (int s = 0; s < 4; ++s) Q_[s] = *(const bf16x8*)(qp + 16 * s + 8 * hi); \
        _Pragma("unroll") for (int s = 0; s < 4; ++s) { kf[s] = *(const bf16x8*)(kp + 16 * s); vr[s] = *(const u32x4*)(vp + (size_t)s * 8 * LD); } } while (0)
    const int nunits = BATCH * 16 * 64;
    bf16x8 qr[4], kf[4]; u32x4 vr[4];
    if (gw < nunits) { ATT_UNIT(gw) ATT_LOAD(qr); }
    for (int unit = gw; unit < nunits; unit += ngw) {
        ATT_UNIT(unit)
        f32x16 o0 = {}, o1 = {};
        float carry2 = 0.f;
        attn_tile<true>(o0, o1, carry2, qr, kf, vr, kbase + (size_t)(qb > 0 ? qb - 1 : 0) * 32 * LD, vbase + (size_t)(qb > 0 ? qb - 1 : 0) * 32 * LD, qb > 0, vb, troff, strow, stch, r32, hi);
        int buf = 1;
        for (int kt = qb - 1; kt >= 0; --kt) {
            if (__all(carry2 <= -150.f)) break;
            attn_tile<false>(o0, o1, carry2, qr, kf, vr, kbase + (size_t)(kt > 0 ? kt - 1 : 0) * 32 * LD, vbase + (size_t)(kt > 0 ? kt - 1 : 0) * 32 * LD, kt > 0, vb + buf * 6144, troff, strow, stch, r32, hi);
            buf ^= 1;
        }
        if (unit + ngw < nunits) { const int nu = unit + ngw; { ATT_UNIT(nu) ATT_LOAD(qr); } }
        bf16* op = Oout + (rowbase + qb * 32 + r32) * ldo + h * 64;
#pragma unroll
        for (int g = 0; g < 4; ++g) {
            u32x2 w0, w1;
            w0.x = cvtpk(o0[4 * g], o0[4 * g + 1]); w0.y = cvtpk(o0[4 * g + 2], o0[4 * g + 3]);
            w1.x = cvtpk(o1[4 * g], o1[4 * g + 1]); w1.y = cvtpk(o1[4 * g + 2], o1[4 * g + 3]);
            *(u32x2*)(op + 8 * g + 4 * hi) = w0; *(u32x2*)(op + 32 + 8 * g + 4 * hi) = w1;
        }
    }
#undef ATT_UNIT
#undef ATT_LOAD
}

#define XB_TMO      128
#define XB_XCNT(j)  (256  + 64 * (j))
#define XB_XSUB(j)  (1280 + 64 * (j))
#define XB_XGEN(j)  (2304 + 64 * (j))
#define XB_TOP      3328
#define XB_TOPGEN   3392
#define XCD_BAR_WORDS 3456
#define XB_SPIN_CAP (1u << 18)

__device__ __forceinline__ unsigned xb_ld(unsigned* p)              { return __hip_atomic_load(p, __ATOMIC_RELAXED, __HIP_MEMORY_SCOPE_AGENT); }
__device__ __forceinline__ unsigned xb_add(unsigned* p, unsigned v) { return __hip_atomic_fetch_add(p, v, __ATOMIC_RELAXED, __HIP_MEMORY_SCOPE_AGENT); }
__device__ __forceinline__ unsigned xb_xcc_id() { return (unsigned)__builtin_amdgcn_s_getreg((3 << 11) | 20) & 0xFu; }
#define XB_SPIN(cond, bar) do { unsigned _sp = 0; while (cond) { __builtin_amdgcn_s_sleep(1); \
    if ((++_sp & 255u) == 0u) { if (xb_ld(&(bar)[XB_TMO])) break; if (_sp > XB_SPIN_CAP) { atomicAdd(&(bar)[XB_TMO], 1u); break; } } } } while (0)

struct XcdBarrier {
    unsigned* bar; unsigned x;
    volatile LAS unsigned* st;
};

__device__ __forceinline__ XcdBarrier xcd_barrier_post(unsigned* bar, volatile LAS unsigned* st) {
    XcdBarrier b; b.bar = bar; b.x = xb_xcc_id(); b.st = st;
    if (threadIdx.x == 0) (void)xb_add(&bar[XB_XCNT(b.x)], 1u);
    return b;
}
__device__ __forceinline__ void xcd_barrier_complete(unsigned* bar, unsigned x, unsigned& nloc, unsigned& nx) {
    const unsigned G = gridDim.x * gridDim.y * gridDim.z;
    unsigned sum, cnt, mine, sp = 0u;
    for (;;) {
        sum = 0u; cnt = 0u; mine = 0u;
#pragma unroll
        for (unsigned j = 0; j < 16; ++j) { const unsigned c = xb_ld(&bar[XB_XCNT(j)]); sum += c; cnt += (c > 0u) ? 1u : 0u; mine = (j == x) ? c : mine; }
        if (sum == G) break;
        __builtin_amdgcn_s_sleep(1);
        if ((++sp & 255u) == 0u) { if (xb_ld(&bar[XB_TMO])) break; if (sp > XB_SPIN_CAP) { atomicAdd(&bar[XB_TMO], 1u); break; } }
    }
    nloc = mine > 0u ? mine : 1u; nx = cnt > 0u ? cnt : 1u;
}

__device__ __forceinline__ void xcd_barrier(const XcdBarrier& b) {
    asm volatile("s_waitcnt vmcnt(0)" ::: "memory");
    __syncthreads();
    if (threadIdx.x == 0) {
        unsigned* bar = b.bar;
        __builtin_amdgcn_s_waitcnt(0);
        unsigned nloc = b.st[0], nx = b.st[1];
        if (nloc == 0u) { xcd_barrier_complete(bar, b.x, nloc, nx); b.st[0] = nloc; b.st[1] = nx; }
        const unsigned old = xb_add(&bar[XB_XSUB(b.x)], 1u);
        const unsigned gen = old / nloc;
        if (old + 1u == (gen + 1u) * nloc) {
            __builtin_amdgcn_fence(__ATOMIC_RELEASE, "agent");
            asm volatile("s_waitcnt vmcnt(0)" ::: "memory");
            const unsigned og = xb_add(&bar[XB_TOP], 1u);
            const unsigned tg = og / nx;
            if (og + 1u == (tg + 1u) * nx) xb_add(&bar[XB_TOPGEN], 1u);
            else XB_SPIN(xb_ld(&bar[XB_TOPGEN]) == tg, bar);
            __builtin_amdgcn_fence(__ATOMIC_ACQUIRE, "agent");
            xb_add(&bar[XB_XGEN(b.x)], 1u);
            asm volatile("s_waitcnt vmcnt(0)" ::: "memory");
        } else {
            XB_SPIN(xb_ld(&bar[XB_XGEN(b.x)]) == gen, bar);
            __builtin_amdgcn_fence(__ATOMIC_ACQUIRE, "agent");
            asm volatile("s_waitcnt vmcnt(0)" ::: "memory");
        }
    }
    __syncthreads();
}

struct Params { const float* in[15]; float* out; unsigned char* ws; };

__global__ void __launch_bounds__(NWAVES * 64, 2) fwd_kernel(Params p) {
    extern __shared__ __attribute__((aligned(16))) unsigned char lds_raw[];
    cg::grid_group grid = cg::this_grid();
    LAS unsigned char* lds = (LAS unsigned char*)lds_raw;
    unsigned char* ws = p.ws;
    const float* x = p.in[0]; const float* n_mix_pre = p.in[1]; const float* n_mix_post = p.in[2]; const float* n_ffn_pre = p.in[3]; const float* n_ffn_post = p.in[4];
    const float* a_v_g = p.in[6]; const float* a_v_b = p.in[7]; const float* a_w_s = p.in[8]; const float* a_b_s = p.in[9];
    bf16* Win_t = (bf16*)(ws + WS_WIN); bf16* Wouta_t = (bf16*)(ws + WS_WOUTA); bf16* Wqkv_t = (bf16*)(ws + WS_WQKV); bf16* Wob_t = (bf16*)(ws + WS_WOB);
    bf16* W1_t = (bf16*)(ws + WS_W1); bf16* W2_t = (bf16*)(ws + WS_W2); bf16* Wc = (bf16*)(ws + WS_WC);
    bf16* XB = (bf16*)(ws + WS_HN); bf16* Z = (bf16*)(ws + WS_Z); float* STAT = (float*)(ws + WS_STAT);
    float* XCH = (float*)(ws + WS_XCH); float* XCH2 = (float*)(ws + WS_XCH2); float* XSTAT = (float*)(ws + WS_XSTAT); unsigned* CNT = (unsigned*)(ws + WS_CNT);
    float* out = p.out;
    unsigned* barw = (unsigned*)(ws + WS_BAR);
    volatile LAS unsigned* bst = (volatile LAS unsigned*)(lds + LDS_BST);
    if (threadIdx.x == 0) { bst[0] = 0u; bst[1] = 0u; }
    if (blockIdx.x == 0) for (int i = threadIdx.x; i < XCD_BAR_WORDS; i += NWAVES * 64) __hip_atomic_store(barw + i, 0u, __ATOMIC_RELAXED, __HIP_MEMORY_SCOPE_AGENT);
    __syncthreads();

    {
        const int tid = threadIdx.x, lane = tid & 63, wave = __builtin_amdgcn_readfirstlane(tid >> 6);
        const int gw = blockIdx.x * NWAVES + wave, ngw = gridDim.x * NWAVES;
        for (int i = blockIdx.x * 512 + tid; i < 16 * 256 * 64; i += gridDim.x * 512) __hip_atomic_store(CNT + i, 0u, __ATOMIC_RELAXED, __HIP_MEMORY_SCOPE_AGENT);
        LAS float* scr = (LAS float*)(lds + wave * 16384);
        if (ngw >= 2048) {
            float ra[32], rb[32];
#define TRM_W(m)  ((m) < 8 ? (((m) & 3) == 0 ? p.in[5] + (size_t)((m) >> 2) * 1024 * 4096 : ((m) & 3) == 1 ? p.in[10] + (size_t)((m) >> 2) * 2048 * 1024 : ((m) & 3) == 2 ? p.in[11] + (size_t)((m) >> 2) * 1024 * 3072 : p.in[12] + (size_t)((m) >> 2) * 1024 * 1024) \
                           : (m) < 12 ? p.in[13] + (size_t)((m) - 8) * 1024 * 4096 : p.in[14] + (size_t)((m) - 12) * 4096 * 1024)
#define TRM_K(m)  ((m) < 8 ? (((m) & 3) == 1 ? 2048 : 1024) : (m) < 12 ? 1024 : 4096)
#define TRM_N(m)  ((m) < 8 ? (((m) & 3) == 0 ? 4096 : ((m) & 3) == 1 ? 1024 : ((m) & 3) == 2 ? 3072 : 1024) : (m) < 12 ? 4096 : 1024)
#define TRM_G(m)  ((m) < 8 ? (((m) & 3) == 0 ? n_mix_pre + (2 * ((m) >> 2)) * 1024 : ((m) & 3) == 2 ? n_mix_pre + (2 * ((m) >> 2) + 1) * 1024 : (const float*)nullptr) : (m) < 12 ? n_ffn_pre + ((m) - 8) * 1024 : (const float*)nullptr)
#define TRM_T(m)  ((m) < 8 ? (((m) & 3) == 0 ? Win_t + (size_t)((m) >> 2) * 4096 * 1024 : ((m) & 3) == 1 ? Wouta_t + (size_t)((m) >> 2) * 1024 * 2048 : ((m) & 3) == 2 ? Wqkv_t + (size_t)((m) >> 2) * 3072 * 1024 : Wob_t + (size_t)((m) >> 2) * 1024 * 1024) \
                           : (m) < 12 ? W1_t + (size_t)((m) - 8) * 4096 * 1024 : W2_t + (size_t)((m) - 12) * 1024 * 4096)
#define TRM_HAS(m) (gw < (TRM_K(m) / 64) * (TRM_N(m) / 32))
            if (TRM_HAS(0)) tr_load(ra, TRM_W(0), TRM_N(0), gw, lane);
#pragma unroll
            for (int m = 0; m < 16; m += 2) {
                if (TRM_HAS(m + 1)) tr_load(rb, TRM_W(m + 1), TRM_N(m + 1), gw, lane);
                if (TRM_HAS(m)) tr_finish(ra, TRM_G(m), TRM_K(m), TRM_N(m), TRM_T(m), scr, gw, lane);
                if (m + 2 < 16) { if (TRM_HAS(m + 2)) tr_load(ra, TRM_W(m + 2), TRM_N(m + 2), gw, lane); }
                if (TRM_HAS(m + 1)) tr_finish(rb, TRM_G(m + 1), TRM_K(m + 1), TRM_N(m + 1), TRM_T(m + 1), scr, gw, lane);
            }
#undef TRM_W
#undef TRM_K
#undef TRM_N
#undef TRM_G
#undef TRM_T
#undef TRM_HAS
        } else {
        for (int l = 0; l < 2; ++l) {
            transpose_matrix(p.in[5] + (size_t)l * 1024 * 4096, n_mix_pre + (2 * l) * 1024, 1024, 4096, Win_t + (size_t)l * 4096 * 1024, scr, gw, ngw, lane);
            transpose_matrix(p.in[10] + (size_t)l * 2048 * 1024, nullptr, 2048, 1024, Wouta_t + (size_t)l * 1024 * 2048, scr, gw, ngw, lane);
            transpose_matrix(p.in[11] + (size_t)l * 1024 * 3072, n_mix_pre + (2 * l + 1) * 1024, 1024, 3072, Wqkv_t + (size_t)l * 3072 * 1024, scr, gw, ngw, lane);
            transpose_matrix(p.in[12] + (size_t)l * 1024 * 1024, nullptr, 1024, 1024, Wob_t + (size_t)l * 1024 * 1024, scr, gw, ngw, lane);
        }
        for (int l = 0; l < 4; ++l) {
            transpose_matrix(p.in[13] + (size_t)l * 1024 * 4096, n_ffn_pre + l * 1024, 1024, 4096, W1_t + (size_t)l * 4096 * 1024, scr, gw, ngw, lane);
            transpose_matrix(p.in[14] + (size_t)l * 4096 * 1024, nullptr, 4096, 1024, W2_t + (size_t)l * 1024 * 4096, scr, gw, ngw, lane);
        }
        }
        for (int i = blockIdx.x * 512 + tid; i < 2 * 8 * 128 * 128; i += gridDim.x * 512) { const int s = i & 127, t = (i >> 7) & 127; Wc[i] = (s <= t) ? (bf16)(cvtpk(a_w_s[i], 0.f) & 0xffffu) : (bf16)0; }
        x_to_bf16(x, XB, XSTAT, wave, lane);
    }
    grid.sync();
    const XcdBarrier xbar = xcd_barrier_post(barw, bst);

#pragma unroll 1
    for (int ph = 0; ph < 20; ++ph) {
        const int layer = ph / 5, step = ph % 5, j = layer >> 1; const bool even = (layer & 1) == 0;
        int tid = threadIdx.x; asm volatile("" : "+v"(tid));
        const int lane = tid & 63, wave = __builtin_amdgcn_readfirstlane(tid >> 6);
        if (step == 0 || step == 3) {
            pg8::Gemm g; EpiAct E; E.stat = STAT; E.rowstat = XSTAT; g.A = XB; g.lda = 1024; g.K = 1024; g.M = MTOK; E.O = Z;
            if (step == 0) { g.N = even ? 4096 : 3072; g.Bt = even ? Win_t + (size_t)j * 4096 * 1024 : Wqkv_t + (size_t)j * 3072 * 1024; E.ldc = g.N; E.act = even ? 1 : 3; }
            else { g.N = 4096; g.Bt = W1_t + (size_t)layer * 4096 * 1024; E.ldc = 4096; E.act = 2; }
            pg8::StaticOrder S; S.init(g.M, g.N, (int)gridDim.x, (int)blockIdx.x);
            pg8::gemm_phase<EpiAct, pg8::StaticOrder, true, true>(lds, g, S, E);
        } else if (step == 2 || step == 4) {
            { const float* gsrc = (step == 2 ? n_mix_post : n_ffn_post) + layer * 1024;
              for (int i = tid; i < 1024; i += NWAVES * 64) ((LAS float*)(lds + LDS_G))[i] = gsrc[i];
              __syncthreads(); }
            pg8::Gemm g; EpiRes E; g.A = Z; g.M = MTOK; g.N = 1024;
            if (step == 2) { g.lda = even ? 4096 : 3072; g.K = even ? 2048 : 1024; g.Bt = even ? Wouta_t + (size_t)j * 1024 * 2048 : Wob_t + (size_t)j * 1024 * 1024; }
            else { g.lda = 4096; g.K = 4096; g.Bt = W2_t + (size_t)layer * 1024 * 4096; }
            const int bank = layer * 2 + (step == 4 ? 1 : 0);
            E.XB = XB; E.outf = (ph == 19) ? out : nullptr; E.xch = XCH; E.xch2 = XCH2; E.cnt = CNT + (size_t)bank * 256 * 64; E.cnt2 = CNT + (size_t)(8 + bank) * 256 * 64; E.rs = XSTAT; E.lds = lds;
            pg8::StaticOrder S; S.init(g.M, g.N, (int)gridDim.x, (int)blockIdx.x);
            pg8::gemm_phase<EpiRes, pg8::StaticOrder, true, true>(lds, g, S, E);
        } else {
#if PROBE_MIX
            if (even) { mix_phase(Z, (bf16*)(ws + 900 * MiB), 2048, STAT, a_v_g + (size_t)j * 2048, a_v_b + (size_t)j * 2048, Wc + (size_t)j * 8 * 128 * 128, a_b_s + (size_t)j * 8 * 128, lds, tid, wave, lane); __syncthreads(); }
#endif
#if PROBE_ATTN
            if (!even) attn_phase(Z, (bf16*)(ws + 900 * MiB), 1024, lds, wave, lane);
#endif
            if (even) mix_phase(Z, Z, 4096, STAT, a_v_g + (size_t)j * 2048, a_v_b + (size_t)j * 2048, Wc + (size_t)j * 8 * 128 * 128, a_b_s + (size_t)j * 8 * 128, lds, tid, wave, lane);
            else attn_phase(Z, Z, NQKV, lds, wave, lane);
        }
        if (ph != 19) xcd_barrier(xbar);
    }
}

extern "C" void kernel_launch(void* const* d_in, const int* in_sizes, int n_in, void* d_out, int out_size, void* d_ws, size_t ws_size, hipStream_t stream) {
    static int grid = 0;
    if (grid == 0) {
        if (n_in != 15 || out_size != MTOK * D_MODEL || ws_size < WS_END) { fprintf(stderr, "kernel_launch: unexpected sizes (n_in %d out %d ws %zu)\n", n_in, out_size, ws_size); grid = -1; return; }
        int dev = 0, cus = 0, per_cu = 0;
        hipGetDevice(&dev); hipDeviceGetAttribute(&cus, hipDeviceAttributeMultiprocessorCount, dev);
        if (hipFuncSetAttribute((const void*)fwd_kernel, hipFuncAttributeMaxDynamicSharedMemorySize, LDS_BYTES) != hipSuccess) fprintf(stderr, "kernel_launch: hipFuncSetAttribute failed\n");
        if (hipOccupancyMaxActiveBlocksPerMultiprocessor(&per_cu, (const void*)fwd_kernel, NWAVES * 64, LDS_BYTES) != hipSuccess || per_cu < 1) { fprintf(stderr, "kernel_launch: occupancy query gave %d\n", per_cu); per_cu = 1; }
        (void)hipGetLastError();
        grid = cus * per_cu;
    }
    if (grid < 0) return;
    Params p{};
    for (int i = 0; i < 15; ++i) p.in[i] = (const float*)d_in[i];
    p.out = (float*)d_out; p.ws = (unsigned char*)d_ws;
    void* args[] = {&p};
    hipError_t e = hipLaunchCooperativeKernel((const void*)fwd_kernel, dim3(grid), dim3(NWAVES * 64), args, LDS_BYTES, stream);
    if (e != hipSuccess) fprintf(stderr, "kernel_launch: cooperative launch failed: %s (grid %d)\n", hipGetErrorString(e), grid);
}
```

```cpp
#include <hip/hip_runtime.h>
#include <hip/hip_cooperative_groups.h>
#include <cstdio>
#include <cstdint>
namespace cg = cooperative_groups;

namespace pg8 {
#define PG8_LAS __attribute__((address_space(3)))
typedef unsigned short bf16_t;
typedef short bf16x8 __attribute__((ext_vector_type(8)));
typedef float f32x4 __attribute__((ext_vector_type(4)));
typedef unsigned u32x4 __attribute__((ext_vector_type(4)));
constexpr int BM = 256, BK = 64, HALF = 128, HTB = HALF * BK * 2  , STAGE_BYTES = 8 * HTB, NXCD = 8, WGM = 8;

__host__ __device__ __forceinline__ int lds_byte(int r, int c) { const int st = (r >> 4) * 2 + (c >> 5), rr = r & 15, cc = c & 31, ob = rr * 64 + cc * 2; return st * 1024 + (ob ^ (((ob >> 9) & 1) << 5)); }
__host__ __device__ __forceinline__ void stage_rc(int b, int& R, int& C) { const int st = b / 1024, sb = b % 1024, swz = sb ^ (((sb >> 9) & 1) << 5); R = (st >> 1) * 16 + swz / 64; C = (st & 1) * 32 + (swz % 64) / 2; }
__host__ __device__ __forceinline__ int perm32(int rho) { const int n = rho >> 4, i = rho & 15; return 8 * (i >> 2) + 4 * n + (i & 3); }

struct Unit { int pm, pn; };
struct Gemm { const bf16_t* A; const bf16_t* Bt; int M, N, K, lda; };

struct StaticOrder {
    int nM, nN, nwg, G, c;
    __host__ __device__ void init(int M, int N, int G_, int c_) { nM = M / BM; nN = N / BM; nwg = nM * nN; G = G_; c = c_; }
    __host__ __device__ bool next(int i, Unit& u) const {
        const long L = (long)i * G + c; if (L >= nwg) return false;
        int wgid = (int)L; { const int q = nwg / NXCD, r = nwg % NXCD, xcd = wgid % NXCD, off = wgid / NXCD; wgid = (xcd < r ? xcd * (q + 1) : r * (q + 1) + (xcd - r) * q) + off; }
        const int nig = WGM * nN, gid = wgid / nig, fm = gid * WGM, gsz = (nM - fm) < WGM ? (nM - fm) : WGM;
        u.pm = fm + ((wgid % nig) % gsz); u.pn = (wgid % nig) / gsz; return true;
    }
    __device__ __forceinline__ void a_ready(const Unit&) const {}
    __device__ __forceinline__ void done(const Unit&) const {}
};

__device__ __forceinline__ unsigned cvt_pk_bf16(float lo, float hi) { unsigned r; asm volatile("v_cvt_pk_bf16_f32 %0, %1, %2" : "=v"(r) : "v"(lo), "v"(hi)); return r; }
typedef float f32x2 __attribute__((ext_vector_type(2)));
__device__ __forceinline__ f32x2 gelu_pk(f32x2 v) {
    const f32x2 av = __builtin_elementwise_abs(v), d = av * 0.2316418882f + 1.0f;
    f32x2 t; t.x = __builtin_amdgcn_rcpf(d.x); t.y = __builtin_amdgcn_rcpf(d.y);
    f32x2 q = t * 0.5307027145f + (-0.7265760135f); q = q * t + 0.7107068705f; q = q * t + (-0.142248368f); q = q * t + 0.127414796f; q = q * t;
    const f32x2 s = (v * v) * (-0.72134752044f);
    f32x2 e; e.x = __builtin_amdgcn_exp2f(s.x); e.y = __builtin_amdgcn_exp2f(s.y);
    const f32x2 m = v * (q * e), r = v - m;
    f32x2 o; o.x = v.x < 0.f ? m.x : r.x; o.y = v.y < 0.f ? m.y : r.y; return o;
}

template <int ACT  > struct EpiBf16 {
    static constexpr bool PERM = true, AFTER_DRAIN = false; static_assert(ACT == 0 || ACT == 1, "EpiBf16: ACT is 0 (none) or 1 (gelu_pk)");
    bf16_t* O; int ldc; const float* bias; int split_cols; size_t split_stride; float scale0;
    __device__ __forceinline__ void operator()(const f32x4 (&acc)[2][2][4][2], const Unit& u, int wr, int wc, int fr, int fq) const {
        const int row0 = u.pm * BM + wr * 64 + fr; int colt = u.pn * BM; bf16_t* base = O;
        float sc = 1.f; if (split_cols) { const int t = colt / split_cols; base += (size_t)t * split_stride; colt -= t * split_cols; if (t == 0) sc = scale0; }
        const int col0 = colt + wc * 32 + 8 * fq, bcol0 = u.pn * BM + wc * 32 + 8 * fq;
        f32x4 bv[2][2];
#pragma unroll
        for (int bj = 0; bj < 2; ++bj)
#pragma unroll
            for (int n = 0; n < 2; ++n) bv[bj][n] = bias ? *(const f32x4*)(bias + bcol0 + bj * HALF + 4 * n) : (f32x4){0.f, 0.f, 0.f, 0.f};
#pragma unroll
        for (int ai = 0; ai < 2; ++ai)
#pragma unroll
            for (int m = 0; m < 4; ++m) { bf16_t* rowp = base + (size_t)(row0 + ai * HALF + m * 16) * ldc + col0;
#pragma unroll
                for (int bj = 0; bj < 2; ++bj) { f32x4 v0 = acc[ai][bj][m][0] + bv[bj][0], v1 = acc[ai][bj][m][1] + bv[bj][1];
                    if (ACT == 1) { f32x2 a = gelu_pk((f32x2){v0[0], v0[1]}), b = gelu_pk((f32x2){v0[2], v0[3]}), c = gelu_pk((f32x2){v1[0], v1[1]}), d = gelu_pk((f32x2){v1[2], v1[3]});
                        v0 = (f32x4){a.x, a.y, b.x, b.y}; v1 = (f32x4){c.x, c.y, d.x, d.y}; }
                    v0 = v0 * sc; v1 = v1 * sc; u32x4 w; w.x = cvt_pk_bf16(v0[0], v0[1]); w.y = cvt_pk_bf16(v0[2], v0[3]); w.z = cvt_pk_bf16(v1[0], v1[1]); w.w = cvt_pk_bf16(v1[2], v1[3]);
                    *(u32x4*)(rowp + bj * HALF) = w; } }
    }
};
template <class Epi, class Sched, bool ALIGN_EPI = false, bool SP2 = false>
__device__ __forceinline__ void gemm_phase(PG8_LAS unsigned char* lds, const Gemm g, const Sched& S, const Epi& E) {
    int tid = threadIdx.x; asm volatile("" : "+v"(tid));
    const int wid = __builtin_amdgcn_readfirstlane(tid >> 6), lane = tid & 63, wr = wid >> 2, wc = wid & 3, fr = lane & 15, fq = lane >> 4;
    const int K = g.K, nt = K / BK;
    unsigned voffA[2], voffB[2];
#pragma unroll
    for (int i = 0; i < 2; ++i) { int R, C; stage_rc(tid * 16 + i * 8192, R, C); const int Rb = Epi::PERM ? ((R & ~31) + perm32(R & 31)) : R;
        voffA[i] = (unsigned)(R * g.lda + C) * 2u; voffB[i] = (unsigned)(Rb * K + C) * 2u; }
    const size_t kstep = (size_t)(BK * 2);
    const size_t hstepA = (size_t)HALF * g.lda * 2, hstepB = (size_t)HALF * K * 2;
    const size_t tstepA = 2 * hstepA, tstepB = 2 * hstepB;
    const unsigned ldsw = (unsigned)wid * 1024u;
    const int aoff = lds_byte(wr * 64 + fr, fq * 8), boff = lds_byte(wc * 32 + fr, fq * 8);
#define PG8_SA(b, h) (((b) * 2 + (h)) * HTB)
#define PG8_SB(b, h) ((4 + (b) * 2 + (h)) * HTB)
#define PG8_STAGE(bufoff, gbase, voff) do { _Pragma("unroll") for (int _i = 0; _i < 2; ++_i) \
        __builtin_amdgcn_global_load_lds((const unsigned*)((const char*)(gbase) + (voff)[_i]), (PG8_LAS unsigned*)(lds + (bufoff) + ldsw + _i * 8192), 16, 0, 0); } while (0)
#define PG8_LDA(dst, b, h) do { _Pragma("unroll") for (int m = 0; m < 4; ++m) _Pragma("unroll") for (int k = 0; k < 2; ++k) dst[m][k] = *(const PG8_LAS bf16x8*)(lds + PG8_SA(b, h) + aoff + m * 2048 + k * 1024); } while (0)
#define PG8_LDB(dst, b, h) do { _Pragma("unroll") for (int n = 0; n < 2; ++n) _Pragma("unroll") for (int k = 0; k < 2; ++k) dst[n][k] = *(const PG8_LAS bf16x8*)(lds + PG8_SB(b, h) + boff + n * 2048 + k * 1024); } while (0)
#define PG8_MMA(ai, bj, At, Bt) do { __builtin_amdgcn_s_setprio(1); _Pragma("unroll") for (int m = 0; m < 4; ++m) _Pragma("unroll") for (int n = 0; n < 2; ++n) _Pragma("unroll") for (int k = 0; k < 2; ++k) \
        acc[ai][bj][m][n] = __builtin_amdgcn_mfma_f32_16x16x32_bf16(Bt[n][k], At[m][k], acc[ai][bj][m][n], 0, 0, 0); __builtin_amdgcn_s_setprio(0); } while (0)
#define PG8_WAIT_V(n) asm volatile("s_waitcnt vmcnt(" #n ")" ::: "memory")
#define PG8_WAIT_L(n) asm volatile("s_waitcnt lgkmcnt(" #n ")" ::: "memory")
#define PG8_BAR __builtin_amdgcn_s_barrier()
#define PG8_SCHED __builtin_amdgcn_sched_barrier(0)
    Unit cur, nxt; int ui = 0;
    if (!S.next(0, cur)) return;
    f32x4 acc[2][2][4][2];
#pragma unroll
    for (int a = 0; a < 2; ++a)
#pragma unroll
        for (int b = 0; b < 2; ++b)
#pragma unroll
            for (int m = 0; m < 4; ++m)
#pragma unroll
                for (int n = 0; n < 2; ++n) acc[a][b][m][n] = (f32x4){0.f, 0.f, 0.f, 0.f};
    bf16x8 At[4][2], B0[2][2], B1[2][2];
    float epre[8];
    const char* cA = (const char*)g.A + (size_t)cur.pm * tstepA; const char* cB = (const char*)g.Bt + (size_t)cur.pn * tstepB;
    S.a_ready(cur);
    if constexpr (SP2) {
        PG8_STAGE(PG8_SB(0, 0), cB, voffB); PG8_STAGE(PG8_SB(0, 1), cB + hstepB, voffB); PG8_STAGE(PG8_SA(0, 0), cA, voffA); PG8_STAGE(PG8_SA(0, 1), cA + hstepA, voffA);
        if (wr == 1) PG8_BAR;
        PG8_WAIT_V(2); PG8_BAR;
        PG8_STAGE(PG8_SB(1, 0), cB + kstep, voffB); PG8_STAGE(PG8_SA(1, 0), cA + kstep, voffA); PG8_STAGE(PG8_SB(1, 1), cB + hstepB + kstep, voffB);
        PG8_WAIT_V(6); PG8_BAR;
    } else {
        PG8_STAGE(PG8_SB(0, 0), cB, voffB); PG8_STAGE(PG8_SA(0, 0), cA, voffA); PG8_STAGE(PG8_SB(0, 1), cB + hstepB, voffB); PG8_STAGE(PG8_SA(0, 1), cA + hstepA, voffA);
        if (wr == 1) PG8_BAR;
        PG8_WAIT_V(4); PG8_BAR;
        PG8_STAGE(PG8_SB(1, 0), cB + kstep, voffB); PG8_STAGE(PG8_SA(1, 0), cA + kstep, voffA); PG8_STAGE(PG8_SB(1, 1), cB + hstepB + kstep, voffB);
        PG8_WAIT_V(6); PG8_BAR;
    }
    for (;;) {
        const bool has_next = S.next(ui + 1, nxt);
        const char* nA = has_next ? (const char*)g.A + (size_t)nxt.pm * tstepA : cA; const char* nB = has_next ? (const char*)g.Bt + (size_t)nxt.pn * tstepB : cB;
        for (int t = 0; t < nt; t += 2) {
            const bool last = (t == nt - 2);
            const char* a1 = cA + (size_t)(t + 1) * kstep;
            const char* a2 = last ? nA : cA + (size_t)(t + 2) * kstep; const char* b2 = last ? nB : cB + (size_t)(t + 2) * kstep;
            const char* a3 = a2 + kstep; const char* b3 = b2 + kstep;
            if (last && has_next) S.a_ready(nxt);
            if (last) E.prefetch(epre, cur, wr, fr);
            if constexpr (SP2) {
            PG8_LDB(B0, 0, 0); PG8_LDB(B1, 0, 1); PG8_SCHED; PG8_LDA(At, 0, 0); PG8_STAGE(PG8_SA(1, 1), a1 + hstepA, voffA);
            PG8_WAIT_V(8); PG8_WAIT_L(0); PG8_BAR; PG8_MMA(0, 0, At, B0); PG8_MMA(0, 1, At, B1); PG8_BAR; PG8_SCHED;
            PG8_LDA(At, 0, 1); PG8_STAGE(PG8_SB(0, 0), b2, voffB); PG8_STAGE(PG8_SB(0, 1), b2 + hstepB, voffB); PG8_STAGE(PG8_SA(0, 0), a2, voffA);
            PG8_WAIT_V(8); PG8_WAIT_L(0); PG8_BAR; PG8_MMA(1, 0, At, B0); PG8_MMA(1, 1, At, B1); PG8_BAR; PG8_SCHED;
            PG8_LDB(B0, 1, 0); PG8_LDB(B1, 1, 1); PG8_SCHED; PG8_LDA(At, 1, 0); PG8_STAGE(PG8_SA(0, 1), a2 + hstepA, voffA);
            PG8_WAIT_V(8); PG8_WAIT_L(0); PG8_BAR; PG8_MMA(0, 0, At, B0); PG8_MMA(0, 1, At, B1); PG8_BAR; PG8_SCHED;
            PG8_LDA(At, 1, 1); PG8_STAGE(PG8_SB(1, 0), b3, voffB); PG8_STAGE(PG8_SB(1, 1), b3 + hstepB, voffB); PG8_STAGE(PG8_SA(1, 0), a3, voffA);
            PG8_WAIT_V(8); PG8_WAIT_L(0); PG8_BAR; PG8_MMA(1, 0, At, B0); PG8_MMA(1, 1, At, B1); PG8_BAR; PG8_SCHED;
            } else {
            PG8_LDB(B0, 0, 0); PG8_SCHED; PG8_LDA(At, 0, 0); PG8_STAGE(PG8_SA(1, 1), a1 + hstepA, voffA);
            PG8_WAIT_L(8); PG8_BAR; PG8_WAIT_L(0); PG8_MMA(0, 0, At, B0); PG8_BAR; PG8_SCHED;
            PG8_LDB(B1, 0, 1); PG8_STAGE(PG8_SB(0, 0), b2, voffB);
            PG8_BAR; PG8_WAIT_L(0); PG8_MMA(0, 1, At, B1); PG8_BAR;
            PG8_LDA(At, 0, 1); PG8_STAGE(PG8_SA(0, 0), a2, voffA);
            PG8_BAR; PG8_WAIT_L(0); PG8_MMA(1, 0, At, B0); PG8_BAR; PG8_SCHED;
            PG8_STAGE(PG8_SB(0, 1), b2 + hstepB, voffB);
            PG8_WAIT_V(6); PG8_BAR; PG8_MMA(1, 1, At, B1); PG8_BAR;
            PG8_LDB(B0, 1, 0); PG8_SCHED; PG8_LDA(At, 1, 0); PG8_STAGE(PG8_SA(0, 1), a2 + hstepA, voffA);
            PG8_WAIT_L(8); PG8_BAR; PG8_WAIT_L(0); PG8_MMA(0, 0, At, B0); PG8_BAR; PG8_SCHED;
            PG8_LDB(B1, 1, 1); PG8_STAGE(PG8_SB(1, 0), b3, voffB);
            PG8_BAR; PG8_WAIT_L(0); PG8_MMA(0, 1, At, B1); PG8_BAR;
            PG8_LDA(At, 1, 1); PG8_STAGE(PG8_SA(1, 0), a3, voffA);
            PG8_BAR; PG8_WAIT_L(0); PG8_MMA(1, 0, At, B0); PG8_BAR; PG8_SCHED;
            PG8_STAGE(PG8_SB(1, 1), b3 + hstepB, voffB);
            PG8_WAIT_V(6); PG8_BAR; PG8_MMA(1, 1, At, B1); PG8_BAR;
            }
        }
        if constexpr (ALIGN_EPI) { if (wr == 0) PG8_BAR; }
        if constexpr (!Epi::AFTER_DRAIN) { E(acc, cur, wr, wc, fr, fq, epre); S.done(cur); }
        if (!has_next) break;
#pragma unroll
        for (int a = 0; a < 2; ++a)
#pragma unroll
            for (int b = 0; b < 2; ++b)
#pragma unroll
                for (int m = 0; m < 4; ++m)
#pragma unroll
                    for (int n = 0; n < 2; ++n) acc[a][b][m][n] = (f32x4){0.f, 0.f, 0.f, 0.f};
        cur = nxt; cA = nA; cB = nB; ++ui;
        if constexpr (ALIGN_EPI) { if (wr == 1) PG8_BAR; }
    }
    PG8_WAIT_V(0);
    if constexpr (!ALIGN_EPI) { if (wr == 0) PG8_BAR; }
    PG8_BAR;
    if constexpr (Epi::AFTER_DRAIN) { E.fused(acc, cur, wr, wc, fr, fq, lds, wid, lane); S.done(cur); }
#undef PG8_SA
#undef PG8_SB
#undef PG8_STAGE
#undef PG8_LDA
#undef PG8_LDB
#undef PG8_MMA
#undef PG8_WAIT_V
#undef PG8_WAIT_L
#undef PG8_BAR
#undef PG8_SCHED
}
}

#define LAS __attribute__((address_space(3)))
typedef unsigned short bf16;
typedef short bf16x8 __attribute__((ext_vector_type(8)));
typedef float f32x4 __attribute__((ext_vector_type(4)));
typedef float f32x16 __attribute__((ext_vector_type(16)));
typedef unsigned u32x4 __attribute__((ext_vector_type(4)));
typedef unsigned u32x2 __attribute__((ext_vector_type(2)));
typedef short v4i16_t __attribute__((ext_vector_type(4)));
typedef float f32x2_t __attribute__((ext_vector_type(2)));
typedef __bf16 bf16x2_t __attribute__((ext_vector_type(2)));

constexpr int D_MODEL = 1024, BATCH = 32, SEQ = 2048, DEPTH = 4, MTOK = BATCH * SEQ, D_FF = 4096, A_WIDTH = 2048, NQKV = 3072;
constexpr float EPS = 1e-6f;
constexpr size_t MiB = 1u << 20;
constexpr size_t WS_WIN = 1 * MiB, WS_WOUTA = 17 * MiB, WS_WQKV = 25 * MiB, WS_WOB = 37 * MiB, WS_W1 = 41 * MiB, WS_W2 = 73 * MiB, WS_WC = 105 * MiB;
constexpr size_t WS_HN = 112 * MiB, WS_Z = 240 * MiB, WS_STAT = 752 * MiB, WS_XCH = 768 * MiB, WS_XSTAT = 769 * MiB, WS_CNT = 770 * MiB, WS_XCH2 = 771 * MiB, WS_END = 772 * MiB;
constexpr int LDS_BYTES = 147456, LDS_BST = 131072 + 1024;
constexpr size_t WS_BAR = 65536;
constexpr int NWAVES = 8;
#ifndef PROBE_MIX
#define PROBE_MIX 0
#endif
#ifndef PROBE_ATTN
#define PROBE_ATTN 0
#endif


__device__ __forceinline__ unsigned cvtpk(float lo, float hi) { f32x2_t v = {lo, hi}; bf16x2_t b = __builtin_convertvector(v, bf16x2_t); return __builtin_bit_cast(unsigned, b); }
__device__ __forceinline__ float bflo(unsigned w) { return __uint_as_float(w << 16); }
__device__ __forceinline__ float bfhi(unsigned w) { return __uint_as_float(w & 0xffff0000u); }
__device__ __forceinline__ float wave_sum(float v) {
#pragma unroll
    for (int o = 1; o < 64; o <<= 1) v += __shfl_xor(v, o);
    return v;
}
__device__ __forceinline__ int crow(int r, int hi) { return (r & 3) + 8 * (r >> 2) + 4 * hi; }
__device__ __forceinline__ v4i16_t tr_read(LAS unsigned char* p) { return __builtin_amdgcn_ds_read_tr16_b64_v4i16((LAS v4i16_t*)p); }

struct EpiAct {
    static constexpr bool PERM = true, AFTER_DRAIN = false;
    bf16* O; int ldc; int act; const float* rowstat; float* stat;
    __device__ __forceinline__ void prefetch(float (&pre)[8], const pg8::Unit& u, int wr, int fr) const {
        const int row0 = u.pm * pg8::BM + wr * 64 + fr;
#pragma unroll
        for (int ai = 0; ai < 2; ++ai)
#pragma unroll
            for (int m = 0; m < 4; ++m) pre[ai * 4 + m] = rowstat ? rowstat[row0 + ai * pg8::HALF + m * 16] : 1.f;
    }
    template <int MODE>
    __device__ __forceinline__ void run(pg8::f32x4 (&acc)[2][2][4][2], const pg8::Unit& u, int wr, int wc, int fr, int fq, const float (&pre)[8], float sc) const {
        using namespace pg8;
        const int row0 = u.pm * BM + wr * 64 + fr; const int col0 = u.pn * BM + wc * 32 + 8 * fq;
#pragma unroll
        for (int ai = 0; ai < 2; ++ai)
#pragma unroll
            for (int m = 0; m < 4; ++m) { bf16* rowp = O + (size_t)(row0 + ai * HALF + m * 16) * ldc + col0;
                float rs = 0.f, rq = 0.f; const float ps = pre[ai * 4 + m] * sc;
#pragma unroll
                for (int bj = 0; bj < 2; ++bj) { pg8::f32x4 v0 = acc[ai][bj][m][0] * ps, v1 = acc[ai][bj][m][1] * ps;
                    if (MODE == 1) { f32x2 a = gelu_pk((f32x2){v0[0], v0[1]}), b = gelu_pk((f32x2){v0[2], v0[3]}), c = gelu_pk((f32x2){v1[0], v1[1]}), d = gelu_pk((f32x2){v1[2], v1[3]});
                        v0 = (pg8::f32x4){a.x, a.y, b.x, b.y}; v1 = (pg8::f32x4){c.x, c.y, d.x, d.y};
                        rs += ((v0[0] + v0[1]) + (v0[2] + v0[3])) + ((v1[0] + v1[1]) + (v1[2] + v1[3]));
                        rq += ((v0[0] * v0[0] + v0[1] * v0[1]) + (v0[2] * v0[2] + v0[3] * v0[3])) + ((v1[0] * v1[0] + v1[1] * v1[1]) + (v1[2] * v1[2] + v1[3] * v1[3])); }
                    else if (MODE == 2) {
#pragma unroll
                        for (int e = 0; e < 4; ++e) { const float a = fmaxf(v0[e], 0.f), b = fmaxf(v1[e], 0.f); v0[e] = a * a; v1[e] = b * b; } }
                    pg8::u32x4 w; w.x = cvtpk(v0[0], v0[1]); w.y = cvtpk(v0[2], v0[3]); w.z = cvtpk(v1[0], v1[1]); w.w = cvtpk(v1[2], v1[3]);
                    *(pg8::u32x4*)(rowp + bj * HALF) = w; }
                if (MODE == 1) { rs += __shfl_xor(rs, 16); rs += __shfl_xor(rs, 32); rq += __shfl_xor(rq, 16); rq += __shfl_xor(rq, 32);
                    if (fq == 0) *(f32x2*)(stat + ((size_t)(row0 + ai * HALF + m * 16) * 32 + (u.pn - 8) * 4 + wc) * 2) = (f32x2){rs, rq}; } }
    }
    __device__ __forceinline__ void operator()(pg8::f32x4 (&acc)[2][2][4][2], const pg8::Unit& u, int wr, int wc, int fr, int fq, const float (&pre)[8]) const {
        asm volatile("" : "+v"(fr), "+v"(fq));
        const float sc = (act == 3 && u.pn * pg8::BM < 1024) ? 0.125f : 1.f;
        if (act == 2) run<2>(acc, u, wr, wc, fr, fq, pre, 1.f);
        else if (act == 1 && u.pn >= 8) run<1>(acc, u, wr, wc, fr, fq, pre, 1.f);
        else run<0>(acc, u, wr, wc, fr, fq, pre, sc);
    }
};

constexpr int LDS_P = 131072 + 2048, LDS_S = LDS_P + 4096, LDS_G = LDS_S + 1024;
struct EpiRes {
    static constexpr bool PERM = true, AFTER_DRAIN = false;
    bf16* XB; float* outf; float* xch; float* xch2; unsigned* cnt; unsigned* cnt2; float* rs; LAS unsigned char* lds;
    __device__ __forceinline__ void prefetch(float (&)[8], const pg8::Unit&, int, int) const {}
    __device__ __forceinline__ void wait32(unsigned* c) const {
        unsigned sp = 0u;
        while ((unsigned)__builtin_amdgcn_readfirstlane(__hip_atomic_load(c, __ATOMIC_RELAXED, __HIP_MEMORY_SCOPE_AGENT)) < 32u) { __builtin_amdgcn_s_sleep(1); if (++sp > (1u << 22)) break; }
        __builtin_amdgcn_fence(__ATOMIC_ACQUIRE, "agent");
    }
    __device__ __forceinline__ void operator()(pg8::f32x4 (&acc)[2][2][4][2], const pg8::Unit& u, int wr, int wc, int fr, int fq, const float (&)[8]) const {
        using namespace pg8;
        asm volatile("" : "+v"(fr), "+v"(fq));
        const int lane = fq * 16 + fr, wid = wr * 4 + wc;
        LAS float* P = (LAS float*)(lds + LDS_P); LAS float* S = (LAS float*)(lds + LDS_S); LAS float* Gs = (LAS float*)(lds + LDS_G);
        const int col0 = u.pn * BM + wc * 32 + 8 * fq;
#pragma unroll
        for (int ai = 0; ai < 2; ++ai)
#pragma unroll
            for (int m = 0; m < 4; ++m) { float q = 0.f;
#pragma unroll
                for (int bj = 0; bj < 2; ++bj)
#pragma unroll
                    for (int n = 0; n < 2; ++n) { const pg8::f32x4 v = acc[ai][bj][m][n]; q += (v[0] * v[0] + v[1] * v[1]) + (v[2] * v[2] + v[3] * v[3]); }
                q += __shfl_xor(q, 16); q += __shfl_xor(q, 32);
                if (fq == 0) P[(ai * HALF + wr * 64 + m * 16 + fr) * 4 + wc] = q; }
        asm volatile("s_waitcnt lgkmcnt(0)" ::: "memory"); __builtin_amdgcn_s_barrier(); asm volatile("" ::: "memory");
        const int row = wid * 32 + (lane & 31);
        if (lane < 32) { const pg8::f32x4 pp = *(LAS pg8::f32x4*)(P + row * 4);
            __hip_atomic_store(xch + ((size_t)(u.pm * BM + row) * 4 + u.pn), (pp[0] + pp[1]) + (pp[2] + pp[3]), __ATOMIC_RELAXED, __HIP_MEMORY_SCOPE_AGENT); }
        asm volatile("" ::: "memory");
        pg8::u32x4 xpre0[4][2], xpre1[4][2];
#pragma unroll
        for (int m = 0; m < 4; ++m)
#pragma unroll
            for (int bj = 0; bj < 2; ++bj) xpre0[m][bj] = *(const pg8::u32x4*)(XB + (size_t)(u.pm * BM + wr * 64 + m * 16 + fr) * 1024 + col0 + bj * HALF);
        asm volatile("" ::: "memory");
        asm volatile("s_waitcnt vmcnt(8)" ::: "memory");
        if (lane == 0) __hip_atomic_fetch_add(cnt + 64 * u.pm, 1u, __ATOMIC_RELAXED, __HIP_MEMORY_SCOPE_AGENT);
        if (wid == 0) wait32(cnt + 64 * u.pm);
        asm volatile("s_waitcnt vmcnt(0) lgkmcnt(0)" ::: "memory"); __builtin_amdgcn_s_barrier(); asm volatile("" ::: "memory");
        if (lane < 32) { const float* sl = xch + (size_t)(u.pm * BM + row) * 4; float t = 0.f;
#pragma unroll
            for (int k = 0; k < 4; ++k) t += __hip_atomic_load(sl + k, __ATOMIC_RELAXED, __HIP_MEMORY_SCOPE_AGENT);
            S[row] = 1.0f / sqrtf(t * (1.f / 1024.f) + 1e-6f); }
        asm volatile("s_waitcnt lgkmcnt(0)" ::: "memory"); __builtin_amdgcn_s_barrier(); asm volatile("" ::: "memory");
        pg8::f32x4 gp[2][2];
#pragma unroll
        for (int bj = 0; bj < 2; ++bj) { gp[bj][0] = *(LAS pg8::f32x4*)(Gs + col0 + bj * HALF); gp[bj][1] = *(LAS pg8::f32x4*)(Gs + col0 + bj * HALF + 4); }
#pragma unroll
        for (int ai = 0; ai < 2; ++ai) {
#pragma unroll
            for (int m = 0; m < 4; ++m) { const int r = ai * HALF + wr * 64 + m * 16 + fr; const float rsm = S[r]; const size_t off = (size_t)(u.pm * BM + r) * 1024 + col0; float q2 = 0.f;
#pragma unroll
                for (int bj = 0; bj < 2; ++bj) { const pg8::u32x4 xw = ai == 0 ? xpre0[m][bj] : xpre1[m][bj];
                    pg8::f32x4 x0 = {__uint_as_float(xw.x << 16), __uint_as_float(xw.x & 0xffff0000u), __uint_as_float(xw.y << 16), __uint_as_float(xw.y & 0xffff0000u)};
                    pg8::f32x4 x1 = {__uint_as_float(xw.z << 16), __uint_as_float(xw.z & 0xffff0000u), __uint_as_float(xw.w << 16), __uint_as_float(xw.w & 0xffff0000u)};
                    x0 = x0 + acc[ai][bj][m][0] * rsm * gp[bj][0]; x1 = x1 + acc[ai][bj][m][1] * rsm * gp[bj][1];
                    q2 += ((x0[0] * x0[0] + x0[1] * x0[1]) + (x0[2] * x0[2] + x0[3] * x0[3])) + ((x1[0] * x1[0] + x1[1] * x1[1]) + (x1[2] * x1[2] + x1[3] * x1[3]));
                    acc[ai][bj][m][0] = x0; acc[ai][bj][m][1] = x1; }
                if (ai == 0) {
#pragma unroll
                    for (int bj = 0; bj < 2; ++bj) xpre1[m][bj] = *(const pg8::u32x4*)(XB + (size_t)(u.pm * BM + HALF + wr * 64 + m * 16 + fr) * 1024 + col0 + bj * HALF);
                    asm volatile("" ::: "memory"); }
                q2 += __shfl_xor(q2, 16); q2 += __shfl_xor(q2, 32);
                if (fq == 0) P[r * 4 + wc] = q2; }
            asm volatile("" ::: "memory"); }
        asm volatile("s_waitcnt lgkmcnt(0)" ::: "memory"); __builtin_amdgcn_s_barrier(); asm volatile("" ::: "memory");
        if (lane < 32) { const pg8::f32x4 pp = *(LAS pg8::f32x4*)(P + row * 4);
            __hip_atomic_store(xch2 + ((size_t)(u.pm * BM + row) * 4 + u.pn), (pp[0] + pp[1]) + (pp[2] + pp[3]), __ATOMIC_RELAXED, __HIP_MEMORY_SCOPE_AGENT); }
        asm volatile("s_waitcnt vmcnt(0)" ::: "memory");
        if (lane == 0) __hip_atomic_fetch_add(cnt2 + 64 * u.pm, 1u, __ATOMIC_RELAXED, __HIP_MEMORY_SCOPE_AGENT);
#pragma unroll
        for (int ai = 0; ai < 2; ++ai)
#pragma unroll
            for (int m = 0; m < 4; ++m) { const size_t off = (size_t)(u.pm * BM + ai * HALF + wr * 64 + m * 16 + fr) * 1024 + col0;
#pragma unroll
                for (int bj = 0; bj < 2; ++bj) { const pg8::f32x4 x0 = acc[ai][bj][m][0], x1 = acc[ai][bj][m][1];
                    if (outf) { *(pg8::f32x4*)(outf + off + bj * HALF) = x0; *(pg8::f32x4*)(outf + off + bj * HALF + 4) = x1; }
                    else { pg8::u32x4 w; w.x = cvtpk(x0[0], x0[1]); w.y = cvtpk(x0[2], x0[3]); w.z = cvtpk(x1[0], x1[1]); w.w = cvtpk(x1[2], x1[3]); *(pg8::u32x4*)(XB + off + bj * HALF) = w; } } }
        if (u.pn == (u.pm & 3)) {
            if (wid == 0) wait32(cnt2 + 64 * u.pm);
            asm volatile("s_waitcnt vmcnt(0) lgkmcnt(0)" ::: "memory"); __builtin_amdgcn_s_barrier(); asm volatile("" ::: "memory");
            if (lane < 32) { const float* sl = xch2 + (size_t)(u.pm * BM + row) * 4; float t = 0.f;
#pragma unroll
                for (int k = 0; k < 4; ++k) t += __hip_atomic_load(sl + k, __ATOMIC_RELAXED, __HIP_MEMORY_SCOPE_AGENT);
                rs[u.pm * BM + row] = 1.0f / sqrtf(t * (1.f / 1024.f) + 1e-6f); }
        }
    }
};

__device__ __forceinline__ void transpose_item(const float* W, const float* gk, int K, int N, bf16* WT, LAS float* scr, int item, int lane) {
    const int nblk = N / 32, kb = item / nblk, nb = item % nblk, k0 = 64 * kb, n0 = 32 * nb;
#pragma unroll
    for (int i = 0; i < 32; ++i) { const int kk = 2 * i + (lane >> 5); scr[kk * 33 + (lane & 31)] = W[(size_t)(k0 + kk) * N + n0 + (lane & 31)]; }
    const int c = lane & 7;
    f32x4 ga = {1.f, 1.f, 1.f, 1.f}, gb = ga;
    if (gk) { ga = *(const f32x4*)(gk + k0 + 8 * c); gb = *(const f32x4*)(gk + k0 + 8 * c + 4); }
    asm volatile("s_waitcnt lgkmcnt(0)" ::: "memory");
#pragma unroll
    for (int j = 0; j < 4; ++j) { const int n = (lane >> 3) + 8 * j; const LAS float* s = scr + (8 * c) * 33 + n;
        u32x4 o; o.x = cvtpk(s[0 * 33] * ga.x, s[1 * 33] * ga.y); o.y = cvtpk(s[2 * 33] * ga.z, s[3 * 33] * ga.w); o.z = cvtpk(s[4 * 33] * gb.x, s[5 * 33] * gb.y); o.w = cvtpk(s[6 * 33] * gb.z, s[7 * 33] * gb.w);
        *(u32x4*)(WT + (size_t)(n0 + n) * K + k0 + 8 * c) = o; }
    asm volatile("s_waitcnt lgkmcnt(0)" ::: "memory");
}
__device__ __forceinline__ void transpose_matrix(const float* W, const float* gk, int K, int N, bf16* WT, LAS float* scr, int gw, int ngw, int lane) {
    const int items = (K / 64) * (N / 32);
    for (int it = gw; it < items; it += ngw) transpose_item(W, gk, K, N, WT, scr, it, lane);
}

__device__ __forceinline__ void tr_load(float (&r)[32], const float* W, int N, int item, int lane) {
    const int nblk = N / 32, kb = item / nblk, nb = item % nblk, k0 = 64 * kb, n0 = 32 * nb;
#pragma unroll
    for (int i = 0; i < 32; ++i) { const int kk = 2 * i + (lane >> 5); r[i] = W[(size_t)(k0 + kk) * N + n0 + (lane & 31)]; }
}
__device__ __forceinline__ void tr_finish(const float (&r)[32], const float* gk, int K, int N, bf16* WT, LAS float* scr, int item, int lane) {
    const int nblk = N / 32, kb = item / nblk, nb = item % nblk, k0 = 64 * kb, n0 = 32 * nb;
#pragma unroll
    for (int i = 0; i < 32; ++i) { const int kk = 2 * i + (lane >> 5); scr[kk * 33 + (lane & 31)] = r[i]; }
    const int c = lane & 7;
    f32x4 ga = {1.f, 1.f, 1.f, 1.f}, gb = ga;
    if (gk) { ga = *(const f32x4*)(gk + k0 + 8 * c); gb = *(const f32x4*)(gk + k0 + 8 * c + 4); }
    asm volatile("s_waitcnt lgkmcnt(0)" ::: "memory");
#pragma unroll
    for (int j = 0; j < 4; ++j) { const int n = (lane >> 3) + 8 * j; const LAS float* s = scr + (8 * c) * 33 + n;
        u32x4 o; o.x = cvtpk(s[0 * 33] * ga.x, s[1 * 33] * ga.y); o.y = cvtpk(s[2 * 33] * ga.z, s[3 * 33] * ga.w); o.z = cvtpk(s[4 * 33] * gb.x, s[5 * 33] * gb.y); o.w = cvtpk(s[6 * 33] * gb.z, s[7 * 33] * gb.w);
        *(u32x4*)(WT + (size_t)(n0 + n) * K + k0 + 8 * c) = o; }
    asm volatile("s_waitcnt lgkmcnt(0)" ::: "memory");
}

__device__ __forceinline__ void x_to_bf16(const float* xin, bf16* xb, float* xstat, int wave, int lane) {
    const int gw = blockIdx.x * NWAVES + wave, ngw = gridDim.x * NWAVES;
    for (int m0 = gw * 4; m0 < MTOK; m0 += ngw * 4) {
        f32x4 v[4][4];
#pragma unroll
        for (int r = 0; r < 4; ++r) { const f32x4* xr = (const f32x4*)(xin + (size_t)(m0 + r) * D_MODEL) + lane;
#pragma unroll
            for (int j = 0; j < 4; ++j) v[r][j] = xr[64 * j]; }
#pragma unroll
        for (int r = 0; r < 4; ++r) { float ss = 0.f;
#pragma unroll
            for (int j = 0; j < 4; ++j) ss += (v[r][j].x * v[r][j].x + v[r][j].y * v[r][j].y) + (v[r][j].z * v[r][j].z + v[r][j].w * v[r][j].w);
            ss = wave_sum(ss);
            u32x2* ho = (u32x2*)(xb + (size_t)(m0 + r) * D_MODEL) + lane;
#pragma unroll
            for (int j = 0; j < 4; ++j) { u32x2 w; w.x = cvtpk(v[r][j].x, v[r][j].y); w.y = cvtpk(v[r][j].z, v[r][j].w); ho[64 * j] = w; }
            if (lane == 0) xstat[m0 + r] = 1.0f / sqrtf(ss * (1.f / D_MODEL) + EPS); }
    }
}

__device__ __forceinline__ void row_pass(bf16* xb, const bf16* mo, const float* gpost, float* outf, float* xstat, int wave, int lane) {
    const int gw = blockIdx.x * NWAVES + wave, ngw = gridDim.x * NWAVES;
    f32x4 gp[4];
#pragma unroll
    for (int j = 0; j < 4; ++j) gp[j] = *((const f32x4*)gpost + lane + 64 * j);
    for (int m0 = gw * 4; m0 < MTOK; m0 += ngw * 4) {
        u32x2 xw[4][4], mw[4][4];
#pragma unroll
        for (int r = 0; r < 4; ++r) { const u32x2* xr = (const u32x2*)(xb + (size_t)(m0 + r) * D_MODEL) + lane; const u32x2* mr = (const u32x2*)(mo + (size_t)(m0 + r) * D_MODEL) + lane;
#pragma unroll
            for (int j = 0; j < 4; ++j) { xw[r][j] = xr[64 * j]; mw[r][j] = mr[64 * j]; } }
#pragma unroll
        for (int r = 0; r < 4; ++r) {
            const int m = m0 + r;
            f32x4 mv[4], v[4]; float ss = 0.f;
#pragma unroll
            for (int j = 0; j < 4; ++j) { mv[j] = (f32x4){bflo(mw[r][j].x), bfhi(mw[r][j].x), bflo(mw[r][j].y), bfhi(mw[r][j].y)}; v[j] = (f32x4){bflo(xw[r][j].x), bfhi(xw[r][j].x), bflo(xw[r][j].y), bfhi(xw[r][j].y)};
                ss += (mv[j].x * mv[j].x + mv[j].y * mv[j].y) + (mv[j].z * mv[j].z + mv[j].w * mv[j].w); }
            const float rstd = 1.0f / sqrtf(wave_sum(ss) * (1.f / D_MODEL) + EPS);
            float s2 = 0.f;
#pragma unroll
            for (int j = 0; j < 4; ++j) { v[j] = v[j] + mv[j] * rstd * gp[j]; s2 += (v[j].x * v[j].x + v[j].y * v[j].y) + (v[j].z * v[j].z + v[j].w * v[j].w); }
            s2 = wave_sum(s2);
            if (outf) { f32x4* xo = (f32x4*)(outf + (size_t)m * D_MODEL) + lane;
#pragma unroll
                for (int j = 0; j < 4; ++j) xo[64 * j] = v[j]; }
            else { u32x2* ho = (u32x2*)(xb + (size_t)m * D_MODEL) + lane;
#pragma unroll
                for (int j = 0; j < 4; ++j) { u32x2 w; w.x = cvtpk(v[j].x, v[j].y); w.y = cvtpk(v[j].z, v[j].w); ho[64 * j] = w; }
                if (lane == 0) xstat[m] = 1.0f / sqrtf(s2 * (1.f / D_MODEL) + EPS); }
        }
    }
}

__device__ __forceinline__ void mix_phase(bf16* Z, bf16* Gout, int ldg, const float* stat, const float* vg, const float* vbias, const bf16* Wc, const float* bs, LAS unsigned char* lds, int tid, int wave, int lane) {
    constexpr int LD = 4096, PITCH = 576, WPITCH = 272, OFF_W = 128 * PITCH, OFF_ST = OFF_W + 128 * WPITCH;
    LAS float* st = (LAS float*)(lds + OFF_ST);
    const int nper = gridDim.x >> 3, g = blockIdx.x & 7, ci = blockIdx.x >> 3;
    if (nper == 0 || ci >= nper) return;
    const int r32 = lane & 31, hi = lane >> 5;
    const int troff = (8 * hi + ((lane & 15) >> 2)) * PITCH + (32 * wave + 16 * ((lane >> 4) & 1) + 4 * (lane & 3)) * 2;
#pragma unroll
    for (int it = 0; it < 4; ++it) { const int idx = it * 512 + tid, row = idx >> 4, ch = idx & 15;
        *(LAS u32x4*)(lds + OFF_W + row * WPITCH + ch * 16) = *(const u32x4*)(Wc + ((size_t)g * 128 + row) * 128 + ch * 8); }
    const int vrow = tid >> 5, vch = tid & 31;
    const f32x4 g0 = *(const f32x4*)(vg + g * 256 + vch * 8), g1 = *(const f32x4*)(vg + g * 256 + vch * 8 + 4);
    const f32x4 b0 = *(const f32x4*)(vbias + g * 256 + vch * 8), b1 = *(const f32x4*)(vbias + g * 256 + vch * 8 + 4);
    const int srow = tid >> 2, sq = tid & 3;
    float bsr[4];
#pragma unroll
    for (int tb = 0; tb < 4; ++tb) bsr[tb] = bs[g * 128 + tb * 32 + r32];
    u32x4 rawv[8]; f32x4 stp[4];
    { const size_t row0 = (size_t)ci * 128;
#pragma unroll
      for (int it = 0; it < 8; ++it) rawv[it] = *(const u32x4*)(Z + (row0 + it * 16 + vrow) * LD + 2048 + g * 256 + vch * 8);
#pragma unroll
      for (int k = 0; k < 4; ++k) stp[k] = *(const f32x4*)(stat + ((row0 + srow) * 32 + sq * 8 + k * 2) * 2); }
    for (int chunk = ci; chunk < MTOK / 128; chunk += nper) {
        const size_t row0 = (size_t)chunk * 128;
        bf16* up = Z + (row0 + r32) * LD + g * 256 + 32 * wave + 4 * hi;
        bf16* gp = Gout + (row0 + r32) * ldg + g * 256 + 32 * wave + 4 * hi;
        u32x2 uw[4][4];
#pragma unroll
        for (int tb = 0; tb < 4; ++tb)
#pragma unroll
            for (int g4 = 0; g4 < 4; ++g4) uw[tb][g4] = *(const u32x2*)(up + (size_t)tb * 32 * LD + 8 * g4);
        { float s = (stp[0].x + stp[0].z) + (stp[1].x + stp[1].z) + (stp[2].x + stp[2].z) + (stp[3].x + stp[3].z);
          float q = (stp[0].y + stp[0].w) + (stp[1].y + stp[1].w) + (stp[2].y + stp[2].w) + (stp[3].y + stp[3].w);
          s += __shfl_xor(s, 1); s += __shfl_xor(s, 2); q += __shfl_xor(q, 1); q += __shfl_xor(q, 2);
          const float mean = s * (1.f / 2048.f), var = fmaxf(q * (1.f / 2048.f) - mean * mean, 0.f);
          if (sq == 0) { st[2 * srow] = mean; st[2 * srow + 1] = 1.0f / sqrtf(var + EPS); } }
        __syncthreads();
#pragma unroll
        for (int it = 0; it < 8; ++it) {
            const int row = it * 16 + vrow; const u32x4 w = rawv[it];
            const float mean = st[2 * row], rstd = st[2 * row + 1];
            u32x4 o;
            o.x = cvtpk((bflo(w.x) - mean) * rstd * g0.x + b0.x, (bfhi(w.x) - mean) * rstd * g0.y + b0.y);
            o.y = cvtpk((bflo(w.y) - mean) * rstd * g0.z + b0.z, (bfhi(w.y) - mean) * rstd * g0.w + b0.w);
            o.z = cvtpk((bflo(w.z) - mean) * rstd * g1.x + b1.x, (bfhi(w.z) - mean) * rstd * g1.y + b1.y);
            o.w = cvtpk((bflo(w.w) - mean) * rstd * g1.z + b1.z, (bfhi(w.w) - mean) * rstd * g1.w + b1.w);
            *(LAS u32x4*)(lds + row * PITCH + vch * 16) = o;
        }
        __syncthreads();
        if (chunk + nper < MTOK / 128) { const size_t nrow0 = (size_t)(chunk + nper) * 128;
#pragma unroll
            for (int it = 0; it < 8; ++it) rawv[it] = *(const u32x4*)(Z + (nrow0 + it * 16 + vrow) * LD + 2048 + g * 256 + vch * 8);
#pragma unroll
            for (int k = 0; k < 4; ++k) stp[k] = *(const f32x4*)(stat + ((nrow0 + srow) * 32 + sq * 8 + k * 2) * 2); }
        bf16x8 af[8];
#pragma unroll
        for (int ks = 0; ks < 8; ++ks) { const v4i16_t lo = tr_read(lds + troff + (16 * ks) * PITCH), h4 = tr_read(lds + troff + (16 * ks + 4) * PITCH);
            af[ks] = (bf16x8){lo[0], lo[1], lo[2], lo[3], h4[0], h4[1], h4[2], h4[3]}; }
#pragma unroll
        for (int tb = 0; tb < 4; ++tb) {
            f32x16 acc = {};
            LAS unsigned char* wp = lds + OFF_W + (tb * 32 + r32) * WPITCH + 16 * hi;
#pragma unroll
            for (int ks = 0; ks < 2 * (tb + 1); ++ks) { const bf16x8 bfrag = *(LAS bf16x8*)(wp + 32 * ks); acc = __builtin_amdgcn_mfma_f32_32x32x16_bf16(af[ks], bfrag, acc, 0, 0, 0); }
            const float bsv = bsr[tb];
#pragma unroll
            for (int g4 = 0; g4 < 4; ++g4) { const u32x2 u2 = uw[tb][g4]; u32x2 ow;
                const pg8::f32x2 ua = pg8::gelu_pk((pg8::f32x2){bflo(u2.x), bfhi(u2.x)}), ub = pg8::gelu_pk((pg8::f32x2){bflo(u2.y), bfhi(u2.y)});
                ow.x = cvtpk(ua.x * (acc[4 * g4] + bsv), ua.y * (acc[4 * g4 + 1] + bsv));
                ow.y = cvtpk(ub.x * (acc[4 * g4 + 2] + bsv), ub.y * (acc[4 * g4 + 3] + bsv));
                *(u32x2*)(gp + (size_t)tb * 32 * ldg + 8 * g4) = ow; }
        }
        __syncthreads();
    }
}

template <bool DIAG>
__device__ __forceinline__ void attn_tile(f32x16& o0, f32x16& o1, float& carry2, const bf16x8 (&qr)[4], bf16x8 (&kf)[4], u32x4 (&vr)[4], const bf16* kpn, const bf16* vpn, bool has_next,
                                          LAS unsigned char* vcur, int troff, int strow, int stch, int r32, int hi) {
    constexpr int LD = NQKV; constexpr float LOG2E = 1.4426950408889634f;
#pragma unroll
    for (int it = 0; it < 4; ++it) *(LAS u32x4*)(vcur + (it * 8 + strow) * 192 + stch * 16) = vr[it];
    f32x16 p = {};
#pragma unroll
    for (int s = 0; s < 4; ++s) p = __builtin_amdgcn_mfma_f32_32x32x16_bf16(kf[s], qr[s], p, 0, 0, 0);
    (void)has_next;
#pragma unroll
    for (int s = 0; s < 4; ++s) { kf[s] = *(const bf16x8*)(kpn + 16 * s); vr[s] = *(const u32x4*)(vpn + (size_t)s * 8 * LD); }
    float kp[16], be[16];
#pragma unroll
    for (int r = 0; r < 16; ++r) { const float z = __builtin_amdgcn_fmed3f(p[r], -80.f, 3.0e38f);
        const float t = __builtin_amdgcn_exp2f(z * -LOG2E); be[r] = __builtin_amdgcn_rcpf(1.f + t); kp[r] = t * be[r];
        if (DIAG) { const bool msk = crow(r, hi) >= r32; kp[r] = msk ? 1.f : kp[r]; be[r] = msk ? 0.f : be[r]; } }
    float se[16], G[4], oth[4], T[4];
#pragma unroll
    for (int g = 0; g < 4; ++g) { se[4 * g + 3] = 1.f; se[4 * g + 2] = kp[4 * g + 3]; se[4 * g + 1] = se[4 * g + 2] * kp[4 * g + 2]; se[4 * g] = se[4 * g + 1] * kp[4 * g + 1]; G[g] = se[4 * g] * kp[4 * g]; }
#pragma unroll
    for (int g = 0; g < 4; ++g) {
        const auto rr = __builtin_amdgcn_permlane32_swap(__float_as_uint(G[g]), __float_as_uint(G[g]), false, false);
        oth[g] = __uint_as_float(rr[1]); T[g] = __uint_as_float(rr[0]) * __uint_as_float(rr[1]); }
    const float C = __builtin_amdgcn_exp2f(carry2);
    float base[4]; const float a2 = T[3], a1 = T[3] * T[2], a0 = a1 * T[1];
    base[3] = C; base[2] = C * a2; base[1] = C * a1; base[0] = C * a0;
    if (hi == 0) {
#pragma unroll
        for (int g = 0; g < 4; ++g) base[g] *= oth[g]; }
    carry2 += __builtin_amdgcn_logf(a0 * T[0]);
    float a[16];
#pragma unroll
    for (int r = 0; r < 16; ++r) a[r] = be[r] * (se[r] * base[r >> 2]);
    u32x4 pw0, pw1;
    pw0.x = cvtpk(a[0], a[1]); pw0.y = cvtpk(a[2], a[3]); pw0.z = cvtpk(a[4], a[5]); pw0.w = cvtpk(a[6], a[7]);
    pw1.x = cvtpk(a[8], a[9]); pw1.y = cvtpk(a[10], a[11]); pw1.z = cvtpk(a[12], a[13]); pw1.w = cvtpk(a[14], a[15]);
    const bf16x8 pf0 = __builtin_bit_cast(bf16x8, pw0), pf1 = __builtin_bit_cast(bf16x8, pw1);
    asm volatile("" ::: "memory");
#pragma unroll
    for (int dh = 0; dh < 2; ++dh)
#pragma unroll
        for (int s = 0; s < 2; ++s) {
            const v4i16_t lo = tr_read(vcur + troff + (16 * s) * 192 + dh * 64), h4 = tr_read(vcur + troff + (16 * s + 8) * 192 + dh * 64);
            const bf16x8 vf = (bf16x8){lo[0], lo[1], lo[2], lo[3], h4[0], h4[1], h4[2], h4[3]};
            if (dh == 0) o0 = __builtin_amdgcn_mfma_f32_32x32x16_bf16(vf, s == 0 ? pf0 : pf1, o0, 0, 0, 0);
            else o1 = __builtin_amdgcn_mfma_f32_32x32x16_bf16(vf, s == 0 ? pf0 : pf1, o1, 0, 0, 0);
        }
    asm volatile("" ::: "memory");
}
__device__ __forceinline__ void attn_phase(bf16* QKV, bf16* Oout, int ldo, LAS unsigned char* lds, int wave, int lane) {
    constexpr int LD = NQKV;
    const int r32 = lane & 31, hi = lane >> 5;
    LAS unsigned char* vb = lds + wave * 12288;
    const int vcu = (gridDim.x % 8 == 0) ? (int)((blockIdx.x & 7) * (gridDim.x >> 3) + (blockIdx.x >> 3)) : (int)blockIdx.x;
    const int gw = vcu * NWAVES + wave, ngw = gridDim.x * NWAVES;
    const int troff = (4 * hi + ((lane & 15) >> 2)) * 192 + (16 * ((lane >> 4) & 1) + 4 * (lane & 3)) * 2;
    const int strow = lane >> 3, stch = lane & 7;
#define ATT_UNIT(unit_) const int bh = (unit_) >> 6, qb = ((unit_) + 8 * (bh >> 5)) & 63, h = bh & 15, b = bh >> 4;     \
        const size_t rowbase = (size_t)b * SEQ; \
        const bf16* qp = QKV + (rowbase + qb * 32 + r32) * LD + h * 64; \
        const bf16* kbase = QKV + (rowbase + r32) * LD + 1024 + h * 64 + 8 * hi; \
        const bf16* vbase = QKV + (rowbase + strow) * LD + 2048 + h * 64 + stch * 8;
#define ATT_LOAD(Q_) do { const bf16* kp = kbase + (size_t)qb * 32 * LD; const bf16* vp = vbase + (size_t)qb * 32 * LD; \
        _Pragma("unroll") for (int s = 0; s < 4; ++s) Q_[s] = *(const bf16x8*)(qp + 16 * s + 8 * hi); \
        _Pragma("unroll") for (int s = 0; s < 4; ++s) { kf[s] = *(const bf16x8*)(kp + 16 * s); vr[s] = *(const u32x4*)(vp + (size_t)s * 8 * LD); } } while (0)
    const int nunits = BATCH * 16 * 64;
    bf16x8 qr[4], kf[4]; u32x4 vr[4];
    if (gw < nunits) { ATT_UNIT(gw) ATT_LOAD(qr); }
    for (int unit = gw; unit < nunits; unit += ngw) {
        ATT_UNIT(unit)
        f32x16 o0 = {}, o1 = {};
        float carry2 = 0.f;
        attn_tile<true>(o0, o1, carry2, qr, kf, vr, kbase + (size_t)(qb > 0 ? qb - 1 : 0) * 32 * LD, vbase + (size_t)(qb > 0 ? qb - 1 : 0) * 32 * LD, qb > 0, vb, troff, strow, stch, r32, hi);
        int buf = 1;
        for (int kt = qb - 1; kt >= 0; --kt) {
            if (__all(carry2 <= -150.f)) break;
            attn_tile<false>(o0, o1, carry2, qr, kf, vr, kbase + (size_t)(kt > 0 ? kt - 1 : 0) * 32 * LD, vbase + (size_t)(kt > 0 ? kt - 1 : 0) * 32 * LD, kt > 0, vb + buf * 6144, troff, strow, stch, r32, hi);
            buf ^= 1;
        }
        if (unit + ngw < nunits) { const int nu = unit + ngw; { ATT_UNIT(nu) ATT_LOAD(qr); } }
        bf16* op = Oout + (rowbase + qb * 32 + r32) * ldo + h * 64;
#pragma unroll
        for (int g = 0; g < 4; ++g) {
            u32x2 w0, w1;
            w0.x = cvtpk(o0[4 * g], o0[4 * g + 1]); w0.y = cvtpk(o0[4 * g + 2], o0[4 * g + 3]);
            w1.x = cvtpk(o1[4 * g], o1[4 * g + 1]); w1.y = cvtpk(o1[4 * g + 2], o1[4 * g + 3]);
            *(u32x2*)(op + 8 * g + 4 * hi) = w0; *(u32x2*)(op + 32 + 8 * g + 4 * hi) = w1;
        }
    }
#undef ATT_UNIT
#undef ATT_LOAD
}

#define XB_TMO      128
#define XB_XCNT(j)  (256  + 64 * (j))
#define XB_XSUB(j)  (1280 + 64 * (j))
#define XB_XGEN(j)  (2304 + 64 * (j))
#define XB_TOP      3328
#define XB_TOPGEN   3392
#define XCD_BAR_WORDS 3456
#define XB_SPIN_CAP (1u << 18)

__device__ __forceinline__ unsigned xb_ld(unsigned* p)              { return __hip_atomic_load(p, __ATOMIC_RELAXED, __HIP_MEMORY_SCOPE_AGENT); }
__device__ __forceinline__ unsigned xb_add(unsigned* p, unsigned v) { return __hip_atomic_fetch_add(p, v, __ATOMIC_RELAXED, __HIP_MEMORY_SCOPE_AGENT); }
__device__ __forceinline__ unsigned xb_xcc_id() { return (unsigned)__builtin_amdgcn_s_getreg((3 << 11) | 20) & 0xFu; }
#define XB_SPIN(cond, bar) do { unsigned _sp = 0; while (cond) { __builtin_amdgcn_s_sleep(1); \
    if ((++_sp & 255u) == 0u) { if (xb_ld(&(bar)[XB_TMO])) break; if (_sp > XB_SPIN_CAP) { atomicAdd(&(bar)[XB_TMO], 1u); break; } } } } while (0)

struct XcdBarrier {
    unsigned* bar; unsigned x;
    volatile LAS unsigned* st;
};

__device__ __forceinline__ XcdBarrier xcd_barrier_post(unsigned* bar, volatile LAS unsigned* st) {
    XcdBarrier b; b.bar = bar; b.x = xb_xcc_id(); b.st = st;
    if (threadIdx.x == 0) (void)xb_add(&bar[XB_XCNT(b.x)], 1u);
    return b;
}
__device__ __forceinline__ void xcd_barrier_complete(unsigned* bar, unsigned x, unsigned& nloc, unsigned& nx) {
    const unsigned G = gridDim.x * gridDim.y * gridDim.z;
    unsigned sum, cnt, mine, sp = 0u;
    for (;;) {
        sum = 0u; cnt = 0u; mine = 0u;
#pragma unroll
        for (unsigned j = 0; j < 16; ++j) { const unsigned c = xb_ld(&bar[XB_XCNT(j)]); sum += c; cnt += (c > 0u) ? 1u : 0u; mine = (j == x) ? c : mine; }
        if (sum == G) break;
        __builtin_amdgcn_s_sleep(1);
        if ((++sp & 255u) == 0u) { if (xb_ld(&bar[XB_TMO])) break; if (sp > XB_SPIN_CAP) { atomicAdd(&bar[XB_TMO], 1u); break; } }
    }
    nloc = mine > 0u ? mine : 1u; nx = cnt > 0u ? cnt : 1u;
}

__device__ __forceinline__ void xcd_barrier(const XcdBarrier& b) {
    asm volatile("s_waitcnt vmcnt(0)" ::: "memory");
    __syncthreads();
    if (threadIdx.x == 0) {
        unsigned* bar = b.bar;
        __builtin_amdgcn_s_waitcnt(0);
        unsigned nloc = b.st[0], nx = b.st[1];
        if (nloc == 0u) { xcd_barrier_complete(bar, b.x, nloc, nx); b.st[0] = nloc; b.st[1] = nx; }
        const unsigned old = xb_add(&bar[XB_XSUB(b.x)], 1u);
        const unsigned gen = old / nloc;
        if (old + 1u == (gen + 1u) * nloc) {
            __builtin_amdgcn_fence(__ATOMIC_RELEASE, "agent");
            asm volatile("s_waitcnt vmcnt(0)" ::: "memory");
            const unsigned og = xb_add(&bar[XB_TOP], 1u);
            const unsigned tg = og / nx;
            if (og + 1u == (tg + 1u) * nx) xb_add(&bar[XB_TOPGEN], 1u);
            else XB_SPIN(xb_ld(&bar[XB_TOPGEN]) == tg, bar);
            __builtin_amdgcn_fence(__ATOMIC_ACQUIRE, "agent");
            xb_add(&bar[XB_XGEN(b.x)], 1u);
            asm volatile("s_waitcnt vmcnt(0)" ::: "memory");
        } else {
            XB_SPIN(xb_ld(&bar[XB_XGEN(b.x)]) == gen, bar);
            __builtin_amdgcn_fence(__ATOMIC_ACQUIRE, "agent");
            asm volatile("s_waitcnt vmcnt(0)" ::: "memory");
        }
    }
    __syncthreads();
}

struct Params { const float* in[15]; float* out; unsigned char* ws; };

__global__ void __launch_bounds__(NWAVES * 64, 2) fwd_kernel(Params p) {
    extern __shared__ __attribute__((aligned(16))) unsigned char lds_raw[];
    cg::grid_group grid = cg::this_grid();
    LAS unsigned char* lds = (LAS unsigned char*)lds_raw;
    unsigned char* ws = p.ws;
    const float* x = p.in[0]; const float* n_mix_pre = p.in[1]; const float* n_mix_post = p.in[2]; const float* n_ffn_pre = p.in[3]; const float* n_ffn_post = p.in[4];
    const float* a_v_g = p.in[6]; const float* a_v_b = p.in[7]; const float* a_w_s = p.in[8]; const float* a_b_s = p.in[9];
    bf16* Win_t = (bf16*)(ws + WS_WIN); bf16* Wouta_t = (bf16*)(ws + WS_WOUTA); bf16* Wqkv_t = (bf16*)(ws + WS_WQKV); bf16* Wob_t = (bf16*)(ws + WS_WOB);
    bf16* W1_t = (bf16*)(ws + WS_W1); bf16* W2_t = (bf16*)(ws + WS_W2); bf16* Wc = (bf16*)(ws + WS_WC);
    bf16* XB = (bf16*)(ws + WS_HN); bf16* Z = (bf16*)(ws + WS_Z); float* STAT = (float*)(ws + WS_STAT);
    float* XCH = (float*)(ws + WS_XCH); float* XCH2 = (float*)(ws + WS_XCH2); float* XSTAT = (float*)(ws + WS_XSTAT); unsigned* CNT = (unsigned*)(ws + WS_CNT);
    float* out = p.out;
    unsigned* barw = (unsigned*)(ws + WS_BAR);
    volatile LAS unsigned* bst = (volatile LAS unsigned*)(lds + LDS_BST);
    if (threadIdx.x == 0) { bst[0] = 0u; bst[1] = 0u; }
    if (blockIdx.x == 0) for (int i = threadIdx.x; i < XCD_BAR_WORDS; i += NWAVES * 64) __hip_atomic_store(barw + i, 0u, __ATOMIC_RELAXED, __HIP_MEMORY_SCOPE_AGENT);
    __syncthreads();

    {
        const int tid = threadIdx.x, lane = tid & 63, wave = __builtin_amdgcn_readfirstlane(tid >> 6);
        const int gw = blockIdx.x * NWAVES + wave, ngw = gridDim.x * NWAVES;
        for (int i = blockIdx.x * 512 + tid; i < 16 * 256 * 64; i += gridDim.x * 512) __hip_atomic_store(CNT + i, 0u, __ATOMIC_RELAXED, __HIP_MEMORY_SCOPE_AGENT);
        LAS float* scr = (LAS float*)(lds + wave * 16384);
        if (ngw >= 2048) {
            float ra[32], rb[32];
#define TRM_W(m)  ((m) < 8 ? (((m) & 3) == 0 ? p.in[5] + (size_t)((m) >> 2) * 1024 * 4096 : ((m) & 3) == 1 ? p.in[10] + (size_t)((m) >> 2) * 2048 * 1024 : ((m) & 3) == 2 ? p.in[11] + (size_t)((m) >> 2) * 1024 * 3072 : p.in[12] + (size_t)((m) >> 2) * 1024 * 1024) \
                           : (m) < 12 ? p.in[13] + (size_t)((m) - 8) * 1024 * 4096 : p.in[14] + (size_t)((m) - 12) * 4096 * 1024)
#define TRM_K(m)  ((m) < 8 ? (((m) & 3) == 1 ? 2048 : 1024) : (m) < 12 ? 1024 : 4096)
#define TRM_N(m)  ((m) < 8 ? (((m) & 3) == 0 ? 4096 : ((m) & 3) == 1 ? 1024 : ((m) & 3) == 2 ? 3072 : 1024) : (m) < 12 ? 4096 : 1024)
#define TRM_G(m)  ((m) < 8 ? (((m) & 3) == 0 ? n_mix_pre + (2 * ((m) >> 2)) * 1024 : ((m) & 3) == 2 ? n_mix_pre + (2 * ((m) >> 2) + 1) * 1024 : (const float*)nullptr) : (m) < 12 ? n_ffn_pre + ((m) - 8) * 1024 : (const float*)nullptr)
#define TRM_T(m)  ((m) < 8 ? (((m) & 3) == 0 ? Win_t + (size_t)((m) >> 2) * 4096 * 1024 : ((m) & 3) == 1 ? Wouta_t + (size_t)((m) >> 2) * 1024 * 2048 : ((m) & 3) == 2 ? Wqkv_t + (size_t)((m) >> 2) * 3072 * 1024 : Wob_t + (size_t)((m) >> 2) * 1024 * 1024) \
                           : (m) < 12 ? W1_t + (size_t)((m) - 8) * 4096 * 1024 : W2_t + (size_t)((m) - 12) * 1024 * 4096)
#define TRM_HAS(m) (gw < (TRM_K(m) / 64) * (TRM_N(m) / 32))
            if (TRM_HAS(0)) tr_load(ra, TRM_W(0), TRM_N(0), gw, lane);
#pragma unroll
            for (int m = 0; m < 16; m += 2) {
                if (TRM_HAS(m + 1)) tr_load(rb, TRM_W(m + 1), TRM_N(m + 1), gw, lane);
                if (TRM_HAS(m)) tr_finish(ra, TRM_G(m), TRM_K(m), TRM_N(m), TRM_T(m), scr, gw, lane);
                if (m + 2 < 16) { if (TRM_HAS(m + 2)) tr_load(ra, TRM_W(m + 2), TRM_N(m + 2), gw, lane); }
                if (TRM_HAS(m + 1)) tr_finish(rb, TRM_G(m + 1), TRM_K(m + 1), TRM_N(m + 1), TRM_T(m + 1), scr, gw, lane);
            }
#undef TRM_W
#undef TRM_K
#undef TRM_N
#undef TRM_G
#undef TRM_T
#undef TRM_HAS
        } else {
        for (int l = 0; l < 2; ++l) {
            transpose_matrix(p.in[5] + (size_t)l * 1024 * 4096, n_mix_pre + (2 * l) * 1024, 1024, 4096, Win_t + (size_t)l * 4096 * 1024, scr, gw, ngw, lane);
            transpose_matrix(p.in[10] + (size_t)l * 2048 * 1024, nullptr, 2048, 1024, Wouta_t + (size_t)l * 1024 * 2048, scr, gw, ngw, lane);
            transpose_matrix(p.in[11] + (size_t)l * 1024 * 3072, n_mix_pre + (2 * l + 1) * 1024, 1024, 3072, Wqkv_t + (size_t)l * 3072 * 1024, scr, gw, ngw, lane);
            transpose_matrix(p.in[12] + (size_t)l * 1024 * 1024, nullptr, 1024, 1024, Wob_t + (size_t)l * 1024 * 1024, scr, gw, ngw, lane);
        }
        for (int l = 0; l < 4; ++l) {
            transpose_matrix(p.in[13] + (size_t)l * 1024 * 4096, n_ffn_pre + l * 1024, 1024, 4096, W1_t + (size_t)l * 4096 * 1024, scr, gw, ngw, lane);
            transpose_matrix(p.in[14] + (size_t)l * 4096 * 1024, nullptr, 4096, 1024, W2_t + (size_t)l * 1024 * 4096, scr, gw, ngw, lane);
        }
        }
        for (int i = blockIdx.x * 512 + tid; i < 2 * 8 * 128 * 128; i += gridDim.x * 512) { const int s = i & 127, t = (i >> 7) & 127; Wc[i] = (s <= t) ? (bf16)(cvtpk(a_w_s[i], 0.f) & 0xffffu) : (bf16)0; }
        x_to_bf16(x, XB, XSTAT, wave, lane);
    }
    grid.sync();
    const XcdBarrier xbar = xcd_barrier_post(barw, bst);

#pragma unroll 1
    for (int ph = 0; ph < 20; ++ph) {
        const int layer = ph / 5, step = ph % 5, j = layer >> 1; const bool even = (layer & 1) == 0;
        int tid = threadIdx.x; asm volatile("" : "+v"(tid));
        const int lane = tid & 63, wave = __builtin_amdgcn_readfirstlane(tid >> 6);
        if (step == 0 || step == 3) {
            pg8::Gemm g; EpiAct E; E.stat = STAT; E.rowstat = XSTAT; g.A = XB; g.lda = 1024; g.K = 1024; g.M = MTOK; E.O = Z;
            if (step == 0) { g.N = even ? 4096 : 3072; g.Bt = even ? Win_t + (size_t)j * 4096 * 1024 : Wqkv_t + (size_t)j * 3072 * 1024; E.ldc = g.N; E.act = even ? 1 : 3; }
            else { g.N = 4096; g.Bt = W1_t + (size_t)layer * 4096 * 1024; E.ldc = 4096; E.act = 2; }
            pg8::StaticOrder S; S.init(g.M, g.N, (int)gridDim.x, (int)blockIdx.x);
            pg8::gemm_phase<EpiAct, pg8::StaticOrder, true, true>(lds, g, S, E);
        } else if (step == 2 || step == 4) {
            pg8::Gemm g; EpiRes E; g.A = Z; g.M = MTOK; g.N = 1024;
            if (step == 2) { g.lda = even ? 4096 : 3072; g.K = even ? 2048 : 1024; g.Bt = even ? Wouta_t + (size_t)j * 1024 * 2048 : Wob_t + (size_t)j * 1024 * 1024; }
            else { g.lda = 4096; g.K = 4096; g.Bt = W2_t + (size_t)layer * 1024 * 4096; }
            const int bank = layer * 2 + (step == 4 ? 1 : 0);
            E.XB = XB; E.outf = (ph == 19) ? out : nullptr; E.xch = XCH; E.xch2 = XCH2; E.cnt = CNT + (size_t)bank * 256 * 64; E.cnt2 = CNT + (size_t)(8 + bank) * 256 * 64; E.rs = XSTAT; E.lds = lds;
            pg8::StaticOrder S; S.init(g.M, g.N, (int)gridDim.x, (int)blockIdx.x);
            pg8::gemm_phase<EpiRes, pg8::StaticOrder, true, true>(lds, g, S, E);
        } else {
#if PROBE_MIX
            if (even) { mix_phase(Z, (bf16*)(ws + 900 * MiB), 2048, STAT, a_v_g + (size_t)j * 2048, a_v_b + (size_t)j * 2048, Wc + (size_t)j * 8 * 128 * 128, a_b_s + (size_t)j * 8 * 128, lds, tid, wave, lane); __syncthreads(); }
#endif
#if PROBE_ATTN
            if (!even) attn_phase(Z, (bf16*)(ws + 900 * MiB), 1024, lds, wave, lane);
#endif
            if (even) mix_phase(Z, Z, 4096, STAT, a_v_g + (size_t)j * 2048, a_v_b + (size_t)j * 2048, Wc + (size_t)j * 8 * 128 * 128, a_b_s + (size_t)j * 8 * 128, lds, tid, wave, lane);
            else attn_phase(Z, Z, NQKV, lds, wave, lane);
        }
        if (step == 1 || step == 3) {
            const float* gsrc = (step == 1 ? n_mix_post : n_ffn_post) + layer * 1024;
            for (int i = tid; i < 1024; i += NWAVES * 64) ((LAS float*)(lds + LDS_G))[i] = gsrc[i];
        }
        if (ph != 19) xcd_barrier(xbar);
    }
}

extern "C" void kernel_launch(void* const* d_in, const int* in_sizes, int n_in, void* d_out, int out_size, void* d_ws, size_t ws_size, hipStream_t stream) {
    static int grid = 0;
    if (grid == 0) {
        if (n_in != 15 || out_size != MTOK * D_MODEL || ws_size < WS_END) { fprintf(stderr, "kernel_launch: unexpected sizes (n_in %d out %d ws %zu)\n", n_in, out_size, ws_size); grid = -1; return; }
        int dev = 0, cus = 0, per_cu = 0;
        hipGetDevice(&dev); hipDeviceGetAttribute(&cus, hipDeviceAttributeMultiprocessorCount, dev);
        if (hipFuncSetAttribute((const void*)fwd_kernel, hipFuncAttributeMaxDynamicSharedMemorySize, LDS_BYTES) != hipSuccess) fprintf(stderr, "kernel_launch: hipFuncSetAttribute failed\n");
        if (hipOccupancyMaxActiveBlocksPerMultiprocessor(&per_cu, (const void*)fwd_kernel, NWAVES * 64, LDS_BYTES) != hipSuccess || per_cu < 1) { fprintf(stderr, "kernel_launch: occupancy query gave %d\n", per_cu); per_cu = 1; }
        (void)hipGetLastError();
        grid = cus * per_cu;
    }
    if (grid < 0) return;
    Params p{};
    for (int i = 0; i < 15; ++i) p.in[i] = (const float*)d_in[i];
    p.out = (float*)d_out; p.ws = (unsigned char*)d_ws;
    void* args[] = {&p};
    hipError_t e = hipLaunchCooperativeKernel((const void*)fwd_kernel, dim3(grid), dim3(NWAVES * 64), args, LDS_BYTES, stream);
    if (e != hipSuccess) fprintf(stderr, "kernel_launch: cooperative launch failed: %s (grid %d)\n", hipGetErrorString(e), grid);
}
```

```cpp
#include <hip/hip_runtime.h>
#include <hip/hip_cooperative_groups.h>
#include <cstdio>
#include <cstdint>
namespace cg = cooperative_groups;

namespace pg8 {
#define PG8_LAS __attribute__((address_space(3)))
typedef unsigned short bf16_t;
typedef short bf16x8 __attribute__((ext_vector_type(8)));
typedef float f32x4 __attribute__((ext_vector_type(4)));
typedef unsigned u32x4 __attribute__((ext_vector_type(4)));
constexpr int BM = 256, BK = 64, HALF = 128, HTB = HALF * BK * 2  , STAGE_BYTES = 8 * HTB, NXCD = 8, WGM = 8;

__host__ __device__ __forceinline__ int lds_byte(int r, int c) { const int st = (r >> 4) * 2 + (c >> 5), rr = r & 15, cc = c & 31, ob = rr * 64 + cc * 2; return st * 1024 + (ob ^ (((ob >> 9) & 1) << 5)); }
__host__ __device__ __forceinline__ void stage_rc(int b, int& R, int& C) { const int st = b / 1024, sb = b % 1024, swz = sb ^ (((sb >> 9) & 1) << 5); R = (st >> 1) * 16 + swz / 64; C = (st & 1) * 32 + (swz % 64) / 2; }
__host__ __device__ __forceinline__ int perm32(int rho) { const int n = rho >> 4, i = rho & 15; return 8 * (i >> 2) + 4 * n + (i & 3); }

struct Unit { int pm, pn; };
struct Gemm { const bf16_t* A; const bf16_t* Bt; int M, N, K, lda; };

struct StaticOrder {
    int nM, nN, nwg, G, c;
    __host__ __device__ void init(int M, int N, int G_, int c_) { nM = M / BM; nN = N / BM; nwg = nM * nN; G = G_; c = c_; }
    __host__ __device__ bool next(int i, Unit& u) const {
        const long L = (long)i * G + c; if (L >= nwg) return false;
        int wgid = (int)L; { const int q = nwg / NXCD, r = nwg % NXCD, xcd = wgid % NXCD, off = wgid / NXCD; wgid = (xcd < r ? xcd * (q + 1) : r * (q + 1) + (xcd - r) * q) + off; }
        const int nig = WGM * nN, gid = wgid / nig, fm = gid * WGM, gsz = (nM - fm) < WGM ? (nM - fm) : WGM;
        u.pm = fm + ((wgid % nig) % gsz); u.pn = (wgid % nig) / gsz; return true;
    }
    __device__ __forceinline__ void a_ready(const Unit&) const {}
    __device__ __forceinline__ void done(const Unit&) const {}
};

__device__ __forceinline__ unsigned cvt_pk_bf16(float lo, float hi) { unsigned r; asm volatile("v_cvt_pk_bf16_f32 %0, %1, %2" : "=v"(r) : "v"(lo), "v"(hi)); return r; }
typedef float f32x2 __attribute__((ext_vector_type(2)));
__device__ __forceinline__ f32x2 gelu_pk(f32x2 v) {
    const f32x2 av = __builtin_elementwise_abs(v), d = av * 0.2316418882f + 1.0f;
    f32x2 t; t.x = __builtin_amdgcn_rcpf(d.x); t.y = __builtin_amdgcn_rcpf(d.y);
    f32x2 q = t * 0.5307027145f + (-0.7265760135f); q = q * t + 0.7107068705f; q = q * t + (-0.142248368f); q = q * t + 0.127414796f; q = q * t;
    const f32x2 s = (v * v) * (-0.72134752044f);
    f32x2 e; e.x = __builtin_amdgcn_exp2f(s.x); e.y = __builtin_amdgcn_exp2f(s.y);
    const f32x2 m = v * (q * e), r = v - m;
    f32x2 o; o.x = v.x < 0.f ? m.x : r.x; o.y = v.y < 0.f ? m.y : r.y; return o;
}

template <int ACT  > struct EpiBf16 {
    static constexpr bool PERM = true, AFTER_DRAIN = false; static_assert(ACT == 0 || ACT == 1, "EpiBf16: ACT is 0 (none) or 1 (gelu_pk)");
    bf16_t* O; int ldc; const float* bias; int split_cols; size_t split_stride; float scale0;
    __device__ __forceinline__ void operator()(const f32x4 (&acc)[2][2][4][2], const Unit& u, int wr, int wc, int fr, int fq) const {
        const int row0 = u.pm * BM + wr * 64 + fr; int colt = u.pn * BM; bf16_t* base = O;
        float sc = 1.f; if (split_cols) { const int t = colt / split_cols; base += (size_t)t * split_stride; colt -= t * split_cols; if (t == 0) sc = scale0; }
        const int col0 = colt + wc * 32 + 8 * fq, bcol0 = u.pn * BM + wc * 32 + 8 * fq;
        f32x4 bv[2][2];
#pragma unroll
        for (int bj = 0; bj < 2; ++bj)
#pragma unroll
            for (int n = 0; n < 2; ++n) bv[bj][n] = bias ? *(const f32x4*)(bias + bcol0 + bj * HALF + 4 * n) : (f32x4){0.f, 0.f, 0.f, 0.f};
#pragma unroll
        for (int ai = 0; ai < 2; ++ai)
#pragma unroll
            for (int m = 0; m < 4; ++m) { bf16_t* rowp = base + (size_t)(row0 + ai * HALF + m * 16) * ldc + col0;
#pragma unroll
                for (int bj = 0; bj < 2; ++bj) { f32x4 v0 = acc[ai][bj][m][0] + bv[bj][0], v1 = acc[ai][bj][m][1] + bv[bj][1];
                    if (ACT == 1) { f32x2 a = gelu_pk((f32x2){v0[0], v0[1]}), b = gelu_pk((f32x2){v0[2], v0[3]}), c = gelu_pk((f32x2){v1[0], v1[1]}), d = gelu_pk((f32x2){v1[2], v1[3]});
                        v0 = (f32x4){a.x, a.y, b.x, b.y}; v1 = (f32x4){c.x, c.y, d.x, d.y}; }
                    v0 = v0 * sc; v1 = v1 * sc; u32x4 w; w.x = cvt_pk_bf16(v0[0], v0[1]); w.y = cvt_pk_bf16(v0[2], v0[3]); w.z = cvt_pk_bf16(v1[0], v1[1]); w.w = cvt_pk_bf16(v1[2], v1[3]);
                    *(u32x4*)(rowp + bj * HALF) = w; } }
    }
};
template <class Epi, class Sched, bool ALIGN_EPI = false, bool SP2 = false>
__device__ __forceinline__ void gemm_phase(PG8_LAS unsigned char* lds, const Gemm g, const Sched& S, const Epi& E) {
    int tid = threadIdx.x; asm volatile("" : "+v"(tid));
    const int wid = __builtin_amdgcn_readfirstlane(tid >> 6), lane = tid & 63, wr = wid >> 2, wc = wid & 3, fr = lane & 15, fq = lane >> 4;
    const int K = g.K, nt = K / BK;
    unsigned voffA[2], voffB[2];
#pragma unroll
    for (int i = 0; i < 2; ++i) { int R, C; stage_rc(tid * 16 + i * 8192, R, C); const int Rb = Epi::PERM ? ((R & ~31) + perm32(R & 31)) : R;
        voffA[i] = (unsigned)(R * g.lda + C) * 2u; voffB[i] = (unsigned)(Rb * K + C) * 2u; }
    const size_t kstep = (size_t)(BK * 2);
    const size_t hstepA = (size_t)HALF * g.lda * 2, hstepB = (size_t)HALF * K * 2;
    const size_t tstepA = 2 * hstepA, tstepB = 2 * hstepB;
    const unsigned ldsw = (unsigned)wid * 1024u;
    const int aoff = lds_byte(wr * 64 + fr, fq * 8), boff = lds_byte(wc * 32 + fr, fq * 8);
#define PG8_SA(b, h) (((b) * 2 + (h)) * HTB)
#define PG8_SB(b, h) ((4 + (b) * 2 + (h)) * HTB)
#define PG8_STAGE(bufoff, gbase, voff) do { _Pragma("unroll") for (int _i = 0; _i < 2; ++_i) \
        __builtin_amdgcn_global_load_lds((const unsigned*)((const char*)(gbase) + (voff)[_i]), (PG8_LAS unsigned*)(lds + (bufoff) + ldsw + _i * 8192), 16, 0, 0); } while (0)
#define PG8_LDA(dst, b, h) do { _Pragma("unroll") for (int m = 0; m < 4; ++m) _Pragma("unroll") for (int k = 0; k < 2; ++k) dst[m][k] = *(const PG8_LAS bf16x8*)(lds + PG8_SA(b, h) + aoff + m * 2048 + k * 1024); } while (0)
#define PG8_LDB(dst, b, h) do { _Pragma("unroll") for (int n = 0; n < 2; ++n) _Pragma("unroll") for (int k = 0; k < 2; ++k) dst[n][k] = *(const PG8_LAS bf16x8*)(lds + PG8_SB(b, h) + boff + n * 2048 + k * 1024); } while (0)
#define PG8_MMA(ai, bj, At, Bt) do { __builtin_amdgcn_s_setprio(1); _Pragma("unroll") for (int m = 0; m < 4; ++m) _Pragma("unroll") for (int n = 0; n < 2; ++n) _Pragma("unroll") for (int k = 0; k < 2; ++k) \
        acc[ai][bj][m][n] = __builtin_amdgcn_mfma_f32_16x16x32_bf16(Bt[n][k], At[m][k], acc[ai][bj][m][n], 0, 0, 0); __builtin_amdgcn_s_setprio(0); } while (0)
#define PG8_WAIT_V(n) asm volatile("s_waitcnt vmcnt(" #n ")" ::: "memory")
#define PG8_WAIT_L(n) asm volatile("s_waitcnt lgkmcnt(" #n ")" ::: "memory")
#define PG8_BAR __builtin_amdgcn_s_barrier()
#define PG8_SCHED __builtin_amdgcn_sched_barrier(0)
    Unit cur, nxt; int ui = 0;
    if (!S.next(0, cur)) return;
    f32x4 acc[2][2][4][2];
#pragma unroll
    for (int a = 0; a < 2; ++a)
#pragma unroll
        for (int b = 0; b < 2; ++b)
#pragma unroll
            for (int m = 0; m < 4; ++m)
#pragma unroll
                for (int n = 0; n < 2; ++n) acc[a][b][m][n] = (f32x4){0.f, 0.f, 0.f, 0.f};
    bf16x8 At[4][2], B0[2][2], B1[2][2];
    float epre[8];
    const char* cA = (const char*)g.A + (size_t)cur.pm * tstepA; const char* cB = (const char*)g.Bt + (size_t)cur.pn * tstepB;
    S.a_ready(cur);
    if constexpr (SP2) {
        PG8_STAGE(PG8_SB(0, 0), cB, voffB); PG8_STAGE(PG8_SB(0, 1), cB + hstepB, voffB); PG8_STAGE(PG8_SA(0, 0), cA, voffA); PG8_STAGE(PG8_SA(0, 1), cA + hstepA, voffA);
        if (wr == 1) PG8_BAR;
        PG8_WAIT_V(2); PG8_BAR;
        PG8_STAGE(PG8_SB(1, 0), cB + kstep, voffB); PG8_STAGE(PG8_SA(1, 0), cA + kstep, voffA); PG8_STAGE(PG8_SB(1, 1), cB + hstepB + kstep, voffB);
        PG8_WAIT_V(6); PG8_BAR;
    } else {
        PG8_STAGE(PG8_SB(0, 0), cB, voffB); PG8_STAGE(PG8_SA(0, 0), cA, voffA); PG8_STAGE(PG8_SB(0, 1), cB + hstepB, voffB); PG8_STAGE(PG8_SA(0, 1), cA + hstepA, voffA);
        if (wr == 1) PG8_BAR;
        PG8_WAIT_V(4); PG8_BAR;
        PG8_STAGE(PG8_SB(1, 0), cB + kstep, voffB); PG8_STAGE(PG8_SA(1, 0), cA + kstep, voffA); PG8_STAGE(PG8_SB(1, 1), cB + hstepB + kstep, voffB);
        PG8_WAIT_V(6); PG8_BAR;
    }
    for (;;) {
        const bool has_next = S.next(ui + 1, nxt);
        const char* nA = has_next ? (const char*)g.A + (size_t)nxt.pm * tstepA : cA; const char* nB = has_next ? (const char*)g.Bt + (size_t)nxt.pn * tstepB : cB;
        for (int t = 0; t < nt; t += 2) {
            const bool last = (t == nt - 2);
            const char* a1 = cA + (size_t)(t + 1) * kstep;
            const char* a2 = last ? nA : cA + (size_t)(t + 2) * kstep; const char* b2 = last ? nB : cB + (size_t)(t + 2) * kstep;
            const char* a3 = a2 + kstep; const char* b3 = b2 + kstep;
            if (last && has_next) S.a_ready(nxt);
            if (last) E.prefetch(epre, cur, wr, fr);
            if constexpr (SP2) {
            PG8_LDB(B0, 0, 0); PG8_LDB(B1, 0, 1); PG8_SCHED; PG8_LDA(At, 0, 0); PG8_STAGE(PG8_SA(1, 1), a1 + hstepA, voffA);
            PG8_WAIT_V(8); PG8_WAIT_L(0); PG8_BAR; PG8_MMA(0, 0, At, B0); PG8_MMA(0, 1, At, B1); PG8_BAR; PG8_SCHED;
            PG8_LDA(At, 0, 1); PG8_STAGE(PG8_SB(0, 0), b2, voffB); PG8_STAGE(PG8_SB(0, 1), b2 + hstepB, voffB); PG8_STAGE(PG8_SA(0, 0), a2, voffA);
            PG8_WAIT_V(8); PG8_WAIT_L(0); PG8_BAR; PG8_MMA(1, 0, At, B0); PG8_MMA(1, 1, At, B1); PG8_BAR; PG8_SCHED;
            PG8_LDB(B0, 1, 0); PG8_LDB(B1, 1, 1); PG8_SCHED; PG8_LDA(At, 1, 0); PG8_STAGE(PG8_SA(0, 1), a2 + hstepA, voffA);
            PG8_WAIT_V(8); PG8_WAIT_L(0); PG8_BAR; PG8_MMA(0, 0, At, B0); PG8_MMA(0, 1, At, B1); PG8_BAR; PG8_SCHED;
            PG8_LDA(At, 1, 1); PG8_STAGE(PG8_SB(1, 0), b3, voffB); PG8_STAGE(PG8_SB(1, 1), b3 + hstepB, voffB); PG8_STAGE(PG8_SA(1, 0), a3, voffA);
            PG8_WAIT_V(8); PG8_WAIT_L(0); PG8_BAR; PG8_MMA(1, 0, At, B0); PG8_MMA(1, 1, At, B1); PG8_BAR; PG8_SCHED;
            } else {
            PG8_LDB(B0, 0, 0); PG8_SCHED; PG8_LDA(At, 0, 0); PG8_STAGE(PG8_SA(1, 1), a1 + hstepA, voffA);
            PG8_WAIT_L(8); PG8_BAR; PG8_WAIT_L(0); PG8_MMA(0, 0, At, B0); PG8_BAR; PG8_SCHED;
            PG8_LDB(B1, 0, 1); PG8_STAGE(PG8_SB(0, 0), b2, voffB);
            PG8_BAR; PG8_WAIT_L(0); PG8_MMA(0, 1, At, B1); PG8_BAR;
            PG8_LDA(At, 0, 1); PG8_STAGE(PG8_SA(0, 0), a2, voffA);
            PG8_BAR; PG8_WAIT_L(0); PG8_MMA(1, 0, At, B0); PG8_BAR; PG8_SCHED;
            PG8_STAGE(PG8_SB(0, 1), b2 + hstepB, voffB);
            PG8_WAIT_V(6); PG8_BAR; PG8_MMA(1, 1, At, B1); PG8_BAR;
            PG8_LDB(B0, 1, 0); PG8_SCHED; PG8_LDA(At, 1, 0); PG8_STAGE(PG8_SA(0, 1), a2 + hstepA, voffA);
            PG8_WAIT_L(8); PG8_BAR; PG8_WAIT_L(0); PG8_MMA(0, 0, At, B0); PG8_BAR; PG8_SCHED;
            PG8_LDB(B1, 1, 1); PG8_STAGE(PG8_SB(1, 0), b3, voffB);
            PG8_BAR; PG8_WAIT_L(0); PG8_MMA(0, 1, At, B1); PG8_BAR;
            PG8_LDA(At, 1, 1); PG8_STAGE(PG8_SA(1, 0), a3, voffA);
            PG8_BAR; PG8_WAIT_L(0); PG8_MMA(1, 0, At, B0); PG8_BAR; PG8_SCHED;
            PG8_STAGE(PG8_SB(1, 1), b3 + hstepB, voffB);
            PG8_WAIT_V(6); PG8_BAR; PG8_MMA(1, 1, At, B1); PG8_BAR;
            }
        }
        if constexpr (ALIGN_EPI) { if (wr == 0) PG8_BAR; }
        if constexpr (!Epi::AFTER_DRAIN) { E(acc, cur, wr, wc, fr, fq, epre); S.done(cur); }
        if (!has_next) break;
#pragma unroll
        for (int a = 0; a < 2; ++a)
#pragma unroll
            for (int b = 0; b < 2; ++b)
#pragma unroll
                for (int m = 0; m < 4; ++m)
#pragma unroll
                    for (int n = 0; n < 2; ++n) acc[a][b][m][n] = (f32x4){0.f, 0.f, 0.f, 0.f};
        cur = nxt; cA = nA; cB = nB; ++ui;
        if constexpr (ALIGN_EPI) { if (wr == 1) PG8_BAR; }
    }
    PG8_WAIT_V(0);
    if constexpr (!ALIGN_EPI) { if (wr == 0) PG8_BAR; }
    PG8_BAR;
    if constexpr (Epi::AFTER_DRAIN) { E.fused(acc, cur, wr, wc, fr, fq, lds, wid, lane); S.done(cur); }
#undef PG8_SA
#undef PG8_SB
#undef PG8_STAGE
#undef PG8_LDA
#undef PG8_LDB
#undef PG8_MMA
#undef PG8_WAIT_V
#undef PG8_WAIT_L
#undef PG8_BAR
#undef PG8_SCHED
}
}

#define LAS __attribute__((address_space(3)))
typedef unsigned short bf16;
typedef short bf16x8 __attribute__((ext_vector_type(8)));
typedef float f32x4 __attribute__((ext_vector_type(4)));
typedef float f32x16 __attribute__((ext_vector_type(16)));
typedef unsigned u32x4 __attribute__((ext_vector_type(4)));
typedef unsigned u32x2 __attribute__((ext_vector_type(2)));
typedef short v4i16_t __attribute__((ext_vector_type(4)));
typedef float f32x2_t __attribute__((ext_vector_type(2)));
typedef __bf16 bf16x2_t __attribute__((ext_vector_type(2)));

constexpr int D_MODEL = 1024, BATCH = 32, SEQ = 2048, DEPTH = 4, MTOK = BATCH * SEQ, D_FF = 4096, A_WIDTH = 2048, NQKV = 3072;
constexpr float EPS = 1e-6f;
constexpr size_t MiB = 1u << 20;
constexpr size_t WS_WIN = 1 * MiB, WS_WOUTA = 17 * MiB, WS_WQKV = 25 * MiB, WS_WOB = 37 * MiB, WS_W1 = 41 * MiB, WS_W2 = 73 * MiB, WS_WC = 105 * MiB;
constexpr size_t WS_HN = 112 * MiB, WS_Z = 240 * MiB, WS_STAT = 752 * MiB, WS_XCH = 768 * MiB, WS_XSTAT = 769 * MiB, WS_CNT = 770 * MiB, WS_XCH2 = 771 * MiB, WS_END = 772 * MiB;
constexpr int LDS_BYTES = 147456, LDS_BST = 131072 + 1024;
constexpr size_t WS_BAR = 65536;
constexpr int NWAVES = 8;
#ifndef PROBE_MIX
#define PROBE_MIX 0
#endif
#ifndef PROBE_ATTN
#define PROBE_ATTN 0
#endif


__device__ __forceinline__ unsigned cvtpk(float lo, float hi) { f32x2_t v = {lo, hi}; bf16x2_t b = __builtin_convertvector(v, bf16x2_t); return __builtin_bit_cast(unsigned, b); }
__device__ __forceinline__ float bflo(unsigned w) { return __uint_as_float(w << 16); }
__device__ __forceinline__ float bfhi(unsigned w) { return __uint_as_float(w & 0xffff0000u); }
__device__ __forceinline__ float wave_sum(float v) {
#pragma unroll
    for (int o = 1; o < 64; o <<= 1) v += __shfl_xor(v, o);
    return v;
}
__device__ __forceinline__ int crow(int r, int hi) { return (r & 3) + 8 * (r >> 2) + 4 * hi; }
__device__ __forceinline__ v4i16_t tr_read(LAS unsigned char* p) { return __builtin_amdgcn_ds_read_tr16_b64_v4i16((LAS v4i16_t*)p); }

struct EpiAct {
    static constexpr bool PERM = true, AFTER_DRAIN = false;
    bf16* O; int ldc; int act; const float* rowstat; float* stat;
    __device__ __forceinline__ void prefetch(float (&pre)[8], const pg8::Unit& u, int wr, int fr) const {
        const int row0 = u.pm * pg8::BM + wr * 64 + fr;
#pragma unroll
        for (int ai = 0; ai < 2; ++ai)
#pragma unroll
            for (int m = 0; m < 4; ++m) pre[ai * 4 + m] = rowstat ? rowstat[row0 + ai * pg8::HALF + m * 16] : 1.f;
    }
    template <int MODE>
    __device__ __forceinline__ void run(pg8::f32x4 (&acc)[2][2][4][2], const pg8::Unit& u, int wr, int wc, int fr, int fq, const float (&pre)[8], float sc) const {
        using namespace pg8;
        const int row0 = u.pm * BM + wr * 64 + fr; const int col0 = u.pn * BM + wc * 32 + 8 * fq;
#pragma unroll
        for (int ai = 0; ai < 2; ++ai)
#pragma unroll
            for (int m = 0; m < 4; ++m) { bf16* rowp = O + (size_t)(row0 + ai * HALF + m * 16) * ldc + col0;
                float rs = 0.f, rq = 0.f; const float ps = pre[ai * 4 + m] * sc;
#pragma unroll
                for (int bj = 0; bj < 2; ++bj) { pg8::f32x4 v0 = acc[ai][bj][m][0] * ps, v1 = acc[ai][bj][m][1] * ps;
                    if (MODE == 1) { f32x2 a = gelu_pk((f32x2){v0[0], v0[1]}), b = gelu_pk((f32x2){v0[2], v0[3]}), c = gelu_pk((f32x2){v1[0], v1[1]}), d = gelu_pk((f32x2){v1[2], v1[3]});
                        v0 = (pg8::f32x4){a.x, a.y, b.x, b.y}; v1 = (pg8::f32x4){c.x, c.y, d.x, d.y};
                        rs += ((v0[0] + v0[1]) + (v0[2] + v0[3])) + ((v1[0] + v1[1]) + (v1[2] + v1[3]));
                        rq += ((v0[0] * v0[0] + v0[1] * v0[1]) + (v0[2] * v0[2] + v0[3] * v0[3])) + ((v1[0] * v1[0] + v1[1] * v1[1]) + (v1[2] * v1[2] + v1[3] * v1[3])); }
                    else if (MODE == 2) {
#pragma unroll
                        for (int e = 0; e < 4; ++e) { const float a = fmaxf(v0[e], 0.f), b = fmaxf(v1[e], 0.f); v0[e] = a * a; v1[e] = b * b; } }
                    pg8::u32x4 w; w.x = cvtpk(v0[0], v0[1]); w.y = cvtpk(v0[2], v0[3]); w.z = cvtpk(v1[0], v1[1]); w.w = cvtpk(v1[2], v1[3]);
                    *(pg8::u32x4*)(rowp + bj * HALF) = w; }
                if (MODE == 1) { rs += __shfl_xor(rs, 16); rs += __shfl_xor(rs, 32); rq += __shfl_xor(rq, 16); rq += __shfl_xor(rq, 32);
                    if (fq == 0) *(f32x2*)(stat + ((size_t)(row0 + ai * HALF + m * 16) * 32 + (u.pn - 8) * 4 + wc) * 2) = (f32x2){rs, rq}; } }
    }
    __device__ __forceinline__ void operator()(pg8::f32x4 (&acc)[2][2][4][2], const pg8::Unit& u, int wr, int wc, int fr, int fq, const float (&pre)[8]) const {
        asm volatile("" : "+v"(fr), "+v"(fq));
        const float sc = (act == 3 && u.pn * pg8::BM < 1024) ? 0.125f : 1.f;
        if (act == 2) run<2>(acc, u, wr, wc, fr, fq, pre, 1.f);
        else if (act == 1 && u.pn >= 8) run<1>(acc, u, wr, wc, fr, fq, pre, 1.f);
        else run<0>(acc, u, wr, wc, fr, fq, pre, sc);
    }
};

constexpr int LDS_P = 131072 + 2048, LDS_S = LDS_P + 4096, LDS_G = LDS_S + 1024;
struct EpiRes {
    static constexpr bool PERM = true, AFTER_DRAIN = false;
    bf16* XB; float* outf; float* xch; float* xch2; unsigned* cnt; unsigned* cnt2; float* rs; LAS unsigned char* lds;
    __device__ __forceinline__ void prefetch(float (&)[8], const pg8::Unit&, int, int) const {}
    __device__ __forceinline__ void wait32(unsigned* c) const {
        unsigned sp = 0u;
        while ((unsigned)__builtin_amdgcn_readfirstlane(__hip_atomic_load(c, __ATOMIC_RELAXED, __HIP_MEMORY_SCOPE_AGENT)) < 32u) { __builtin_amdgcn_s_sleep(1); if (++sp > (1u << 22)) break; }
        __builtin_amdgcn_fence(__ATOMIC_ACQUIRE, "agent");
    }
    __device__ __forceinline__ void operator()(pg8::f32x4 (&acc)[2][2][4][2], const pg8::Unit& u, int wr, int wc, int fr, int fq, const float (&)[8]) const {
        using namespace pg8;
        asm volatile("" : "+v"(fr), "+v"(fq));
        const int lane = fq * 16 + fr, wid = wr * 4 + wc;
        LAS float* P = (LAS float*)(lds + LDS_P); LAS float* S = (LAS float*)(lds + LDS_S); LAS float* Gs = (LAS float*)(lds + LDS_G);
        const int col0 = u.pn * BM + wc * 32 + 8 * fq;
#pragma unroll
        for (int ai = 0; ai < 2; ++ai)
#pragma unroll
            for (int m = 0; m < 4; ++m) { float q = 0.f;
#pragma unroll
                for (int bj = 0; bj < 2; ++bj)
#pragma unroll
                    for (int n = 0; n < 2; ++n) { const pg8::f32x4 v = acc[ai][bj][m][n]; q += (v[0] * v[0] + v[1] * v[1]) + (v[2] * v[2] + v[3] * v[3]); }
                q += __shfl_xor(q, 16); q += __shfl_xor(q, 32);
                if (fq == 0) P[(ai * HALF + wr * 64 + m * 16 + fr) * 4 + wc] = q; }
        asm volatile("s_waitcnt lgkmcnt(0)" ::: "memory"); __builtin_amdgcn_s_barrier(); asm volatile("" ::: "memory");
        const int row = wid * 32 + (lane & 31);
        if (lane < 32) { const pg8::f32x4 pp = *(LAS pg8::f32x4*)(P + row * 4);
            __hip_atomic_store(xch + ((size_t)(u.pm * BM + row) * 4 + u.pn), (pp[0] + pp[1]) + (pp[2] + pp[3]), __ATOMIC_RELAXED, __HIP_MEMORY_SCOPE_AGENT); }
        asm volatile("" ::: "memory");
        pg8::u32x4 xpre0[4][2], xpre1[4][2];
#pragma unroll
        for (int m = 0; m < 4; ++m)
#pragma unroll
            for (int bj = 0; bj < 2; ++bj) xpre0[m][bj] = *(const pg8::u32x4*)(XB + (size_t)(u.pm * BM + wr * 64 + m * 16 + fr) * 1024 + col0 + bj * HALF);
        asm volatile("" ::: "memory");
        asm volatile("s_waitcnt vmcnt(8)" ::: "memory");
        if (lane == 0) __hip_atomic_fetch_add(cnt + 64 * u.pm, 1u, __ATOMIC_RELAXED, __HIP_MEMORY_SCOPE_AGENT);
        if (wid == 0) wait32(cnt + 64 * u.pm);
        asm volatile("s_waitcnt vmcnt(0) lgkmcnt(0)" ::: "memory"); __builtin_amdgcn_s_barrier(); asm volatile("" ::: "memory");
        if (lane < 32) { const float* sl = xch + (size_t)(u.pm * BM + row) * 4; float t = 0.f;
#pragma unroll
            for (int k = 0; k < 4; ++k) t += __hip_atomic_load(sl + k, __ATOMIC_RELAXED, __HIP_MEMORY_SCOPE_AGENT);
            S[row] = 1.0f / sqrtf(t * (1.f / 1024.f) + 1e-6f); }
        asm volatile("s_waitcnt lgkmcnt(0)" ::: "memory"); __builtin_amdgcn_s_barrier(); asm volatile("" ::: "memory");
        pg8::f32x4 gp[2][2];
#pragma unroll
        for (int bj = 0; bj < 2; ++bj) { gp[bj][0] = *(LAS pg8::f32x4*)(Gs + col0 + bj * HALF); gp[bj][1] = *(LAS pg8::f32x4*)(Gs + col0 + bj * HALF + 4); }
#pragma unroll
        for (int ai = 0; ai < 2; ++ai) {
#pragma unroll
            for (int m = 0; m < 4; ++m) { const int r = ai * HALF + wr * 64 + m * 16 + fr; const float rsm = S[r]; const size_t off = (size_t)(u.pm * BM + r) * 1024 + col0; float q2 = 0.f;
#pragma unroll
                for (int bj = 0; bj < 2; ++bj) { const pg8::u32x4 xw = ai == 0 ? xpre0[m][bj] : xpre1[m][bj];
                    pg8::f32x4 x0 = {__uint_as_float(xw.x << 16), __uint_as_float(xw.x & 0xffff0000u), __uint_as_float(xw.y << 16), __uint_as_float(xw.y & 0xffff0000u)};
                    pg8::f32x4 x1 = {__uint_as_float(xw.z << 16), __uint_as_float(xw.z & 0xffff0000u), __uint_as_float(xw.w << 16), __uint_as_float(xw.w & 0xffff0000u)};
                    x0 = x0 + acc[ai][bj][m][0] * rsm * gp[bj][0]; x1 = x1 + acc[ai][bj][m][1] * rsm * gp[bj][1];
                    q2 += ((x0[0] * x0[0] + x0[1] * x0[1]) + (x0[2] * x0[2] + x0[3] * x0[3])) + ((x1[0] * x1[0] + x1[1] * x1[1]) + (x1[2] * x1[2] + x1[3] * x1[3]));
                    acc[ai][bj][m][0] = x0; acc[ai][bj][m][1] = x1; }
                if (ai == 0) {
#pragma unroll
                    for (int bj = 0; bj < 2; ++bj) xpre1[m][bj] = *(const pg8::u32x4*)(XB + (size_t)(u.pm * BM + HALF + wr * 64 + m * 16 + fr) * 1024 + col0 + bj * HALF);
                    asm volatile("" ::: "memory"); }
                q2 += __shfl_xor(q2, 16); q2 += __shfl_xor(q2, 32);
                if (fq == 0) P[r * 4 + wc] = q2; }
            asm volatile("" ::: "memory"); }
        asm volatile("s_waitcnt lgkmcnt(0)" ::: "memory"); __builtin_amdgcn_s_barrier(); asm volatile("" ::: "memory");
        if (lane < 32) { const pg8::f32x4 pp = *(LAS pg8::f32x4*)(P + row * 4);
            __hip_atomic_store(xch2 + ((size_t)(u.pm * BM + row) * 4 + u.pn), (pp[0] + pp[1]) + (pp[2] + pp[3]), __ATOMIC_RELAXED, __HIP_MEMORY_SCOPE_AGENT); }
        asm volatile("s_waitcnt vmcnt(0)" ::: "memory");
        if (lane == 0) __hip_atomic_fetch_add(cnt2 + 64 * u.pm, 1u, __ATOMIC_RELAXED, __HIP_MEMORY_SCOPE_AGENT);
#pragma unroll
        for (int ai = 0; ai < 2; ++ai)
#pragma unroll
            for (int m = 0; m < 4; ++m) { const size_t off = (size_t)(u.pm * BM + ai * HALF + wr * 64 + m * 16 + fr) * 1024 + col0;
#pragma unroll
                for (int bj = 0; bj < 2; ++bj) { const pg8::f32x4 x0 = acc[ai][bj][m][0], x1 = acc[ai][bj][m][1];
                    if (outf) { *(pg8::f32x4*)(outf + off + bj * HALF) = x0; *(pg8::f32x4*)(outf + off + bj * HALF + 4) = x1; }
                    else { pg8::u32x4 w; w.x = cvtpk(x0[0], x0[1]); w.y = cvtpk(x0[2], x0[3]); w.z = cvtpk(x1[0], x1[1]); w.w = cvtpk(x1[2], x1[3]); *(pg8::u32x4*)(XB + off + bj * HALF) = w; } } }
        if (u.pn == (u.pm & 3)) {
            if (wid == 0) wait32(cnt2 + 64 * u.pm);
            asm volatile("s_waitcnt vmcnt(0) lgkmcnt(0)" ::: "memory"); __builtin_amdgcn_s_barrier(); asm volatile("" ::: "memory");
            if (lane < 32) { const float* sl = xch2 + (size_t)(u.pm * BM + row) * 4; float t = 0.f;
#pragma unroll
                for (int k = 0; k < 4; ++k) t += __hip_atomic_load(sl + k, __ATOMIC_RELAXED, __HIP_MEMORY_SCOPE_AGENT);
                rs[u.pm * BM + row] = 1.0f / sqrtf(t * (1.f / 1024.f) + 1e-6f); }
        }
    }
};

__device__ __forceinline__ void transpose_item(const float* W, const float* gk, int K, int N, bf16* WT, LAS float* scr, int item, int lane) {
    const int nblk = N / 32, kb = item / nblk, nb = item % nblk, k0 = 64 * kb, n0 = 32 * nb;
#pragma unroll
    for (int i = 0; i < 32; ++i) { const int kk = 2 * i + (lane >> 5); scr[kk * 33 + (lane & 31)] = W[(size_t)(k0 + kk) * N + n0 + (lane & 31)]; }
    const int c = lane & 7;
    f32x4 ga = {1.f, 1.f, 1.f, 1.f}, gb = ga;
    if (gk) { ga = *(const f32x4*)(gk + k0 + 8 * c); gb = *(const f32x4*)(gk + k0 + 8 * c + 4); }
    asm volatile("s_waitcnt lgkmcnt(0)" ::: "memory");
#pragma unroll
    for (int j = 0; j < 4; ++j) { const int n = (lane >> 3) + 8 * j; const LAS float* s = scr + (8 * c) * 33 + n;
        u32x4 o; o.x = cvtpk(s[0 * 33] * ga.x, s[1 * 33] * ga.y); o.y = cvtpk(s[2 * 33] * ga.z, s[3 * 33] * ga.w); o.z = cvtpk(s[4 * 33] * gb.x, s[5 * 33] * gb.y); o.w = cvtpk(s[6 * 33] * gb.z, s[7 * 33] * gb.w);
        *(u32x4*)(WT + (size_t)(n0 + n) * K + k0 + 8 * c) = o; }
    asm volatile("s_waitcnt lgkmcnt(0)" ::: "memory");
}
__device__ __forceinline__ void transpose_matrix(const float* W, const float* gk, int K, int N, bf16* WT, LAS float* scr, int gw, int ngw, int lane) {
    const int items = (K / 64) * (N / 32);
    for (int it = gw; it < items; it += ngw) transpose_item(W, gk, K, N, WT, scr, it, lane);
}

__device__ __forceinline__ void tr_load(float (&r)[32], const float* W, int N, int item, int lane) {
    const int nblk = N / 32, kb = item / nblk, nb = item % nblk, k0 = 64 * kb, n0 = 32 * nb;
#pragma unroll
    for (int i = 0; i < 32; ++i) { const int kk = 2 * i + (lane >> 5); r[i] = W[(size_t)(k0 + kk) * N + n0 + (lane & 31)]; }
}
__device__ __forceinline__ void tr_finish(const float (&r)[32], const float* gk, int K, int N, bf16* WT, LAS float* scr, int item, int lane) {
    const int nblk = N / 32, kb = item / nblk, nb = item % nblk, k0 = 64 * kb, n0 = 32 * nb;
#pragma unroll
    for (int i = 0; i < 32; ++i) { const int kk = 2 * i + (lane >> 5); scr[kk * 33 + (lane & 31)] = r[i]; }
    const int c = lane & 7;
    f32x4 ga = {1.f, 1.f, 1.f, 1.f}, gb = ga;
    if (gk) { ga = *(const f32x4*)(gk + k0 + 8 * c); gb = *(const f32x4*)(gk + k0 + 8 * c + 4); }
    asm volatile("s_waitcnt lgkmcnt(0)" ::: "memory");
#pragma unroll
    for (int j = 0; j < 4; ++j) { const int n = (lane >> 3) + 8 * j; const LAS float* s = scr + (8 * c) * 33 + n;
        u32x4 o; o.x = cvtpk(s[0 * 33] * ga.x, s[1 * 33] * ga.y); o.y = cvtpk(s[2 * 33] * ga.z, s[3 * 33] * ga.w); o.z = cvtpk(s[4 * 33] * gb.x, s[5 * 33] * gb.y); o.w = cvtpk(s[6 * 33] * gb.z, s[7 * 33] * gb.w);
        *(u32x4*)(WT + (size_t)(n0 + n) * K + k0 + 8 * c) = o; }
    asm volatile("s_waitcnt lgkmcnt(0)" ::: "memory");
}

__device__ __forceinline__ void x_to_bf16(const float* xin, bf16* xb, float* xstat, int wave, int lane) {
    const int gw = blockIdx.x * NWAVES + wave, ngw = gridDim.x * NWAVES;
    for (int m0 = gw * 4; m0 < MTOK; m0 += ngw * 4) {
        f32x4 v[4][4];
#pragma unroll
        for (int r = 0; r < 4; ++r) { const f32x4* xr = (const f32x4*)(xin + (size_t)(m0 + r) * D_MODEL) + lane;
#pragma unroll
            for (int j = 0; j < 4; ++j) v[r][j] = xr[64 * j]; }
#pragma unroll
        for (int r = 0; r < 4; ++r) { float ss = 0.f;
#pragma unroll
            for (int j = 0; j < 4; ++j) ss += (v[r][j].x * v[r][j].x + v[r][j].y * v[r][j].y) + (v[r][j].z * v[r][j].z + v[r][j].w * v[r][j].w);
            ss = wave_sum(ss);
            u32x2* ho = (u32x2*)(xb + (size_t)(m0 + r) * D_MODEL) + lane;
#pragma unroll
            for (int j = 0; j < 4; ++j) { u32x2 w; w.x = cvtpk(v[r][j].x, v[r][j].y); w.y = cvtpk(v[r][j].z, v[r][j].w); ho[64 * j] = w; }
            if (lane == 0) xstat[m0 + r] = 1.0f / sqrtf(ss * (1.f / D_MODEL) + EPS); }
    }
}

__device__ __forceinline__ void row_pass(bf16* xb, const bf16* mo, const float* gpost, float* outf, float* xstat, int wave, int lane) {
    const int gw = blockIdx.x * NWAVES + wave, ngw = gridDim.x * NWAVES;
    f32x4 gp[4];
#pragma unroll
    for (int j = 0; j < 4; ++j) gp[j] = *((const f32x4*)gpost + lane + 64 * j);
    for (int m0 = gw * 4; m0 < MTOK; m0 += ngw * 4) {
        u32x2 xw[4][4], mw[4][4];
#pragma unroll
        for (int r = 0; r < 4; ++r) { const u32x2* xr = (const u32x2*)(xb + (size_t)(m0 + r) * D_MODEL) + lane; const u32x2* mr = (const u32x2*)(mo + (size_t)(m0 + r) * D_MODEL) + lane;
#pragma unroll
            for (int j = 0; j < 4; ++j) { xw[r][j] = xr[64 * j]; mw[r][j] = mr[64 * j]; } }
#pragma unroll
        for (int r = 0; r < 4; ++r) {
            const int m = m0 + r;
            f32x4 mv[4], v[4]; float ss = 0.f;
#pragma unroll
            for (int j = 0; j < 4; ++j) { mv[j] = (f32x4){bflo(mw[r][j].x), bfhi(mw[r][j].x), bflo(mw[r][j].y), bfhi(mw[r][j].y)}; v[j] = (f32x4){bflo(xw[r][j].x), bfhi(xw[r][j].x), bflo(xw[r][j].y), bfhi(xw[r][j].y)};
                ss += (mv[j].x * mv[j].x + mv[j].y * mv[j].y) + (mv[j].z * mv[j].z + mv[j].w * mv[j].w); }
            const float rstd = 1.0f / sqrtf(wave_sum(ss) * (1.f / D_MODEL) + EPS);
            float s2 = 0.f;
#pragma unroll
            for (int j = 0; j < 4; ++j) { v[j] = v[j] + mv[j] * rstd * gp[j]; s2 += (v[j].x * v[j].x + v[j].y * v[j].y) + (v[j].z * v[j].z + v[j].w * v[j].w); }
            s2 = wave_sum(s2);
            if (outf) { f32x4* xo = (f32x4*)(outf + (size_t)m * D_MODEL) + lane;
#pragma unroll
                for (int j = 0; j < 4; ++j) xo[64 * j] = v[j]; }
            else { u32x2* ho = (u32x2*)(xb + (size_t)m * D_MODEL) + lane;
#pragma unroll
                for (int j = 0; j < 4; ++j) { u32x2 w; w.x = cvtpk(v[j].x, v[j].y); w.y = cvtpk(v[j].z, v[j].w); ho[64 * j] = w; }
                if (lane == 0) xstat[m] = 1.0f / sqrtf(s2 * (1.f / D_MODEL) + EPS); }
        }
    }
}

__device__ __forceinline__ void mix_phase(bf16* Z, bf16* Gout, int ldg, const float* stat, const float* vg, const float* vbias, const bf16* Wc, const float* bs, LAS unsigned char* lds, int tid, int wave, int lane) {
    constexpr int LD = 4096, PITCH = 576, WPITCH = 272, OFF_W = 128 * PITCH, OFF_ST = OFF_W + 128 * WPITCH;
    LAS float* st = (LAS float*)(lds + OFF_ST);
    const int nper = gridDim.x >> 3, g = blockIdx.x & 7, ci = blockIdx.x >> 3;
    if (nper == 0 || ci >= nper) return;
    const int r32 = lane & 31, hi = lane >> 5;
    const int troff = (8 * hi + ((lane & 15) >> 2)) * PITCH + (32 * wave + 16 * ((lane >> 4) & 1) + 4 * (lane & 3)) * 2;
#pragma unroll
    for (int it = 0; it < 4; ++it) { const int idx = it * 512 + tid, row = idx >> 4, ch = idx & 15;
        *(LAS u32x4*)(lds + OFF_W + row * WPITCH + ch * 16) = *(const u32x4*)(Wc + ((size_t)g * 128 + row) * 128 + ch * 8); }
    const int vrow = tid >> 5, vch = tid & 31;
    const f32x4 g0 = *(const f32x4*)(vg + g * 256 + vch * 8), g1 = *(const f32x4*)(vg + g * 256 + vch * 8 + 4);
    const f32x4 b0 = *(const f32x4*)(vbias + g * 256 + vch * 8), b1 = *(const f32x4*)(vbias + g * 256 + vch * 8 + 4);
    const int srow = tid >> 2, sq = tid & 3;
    float bsr[4];
#pragma unroll
    for (int tb = 0; tb < 4; ++tb) bsr[tb] = bs[g * 128 + tb * 32 + r32];
    u32x4 rawv[8]; f32x4 stp[4];
    { const size_t row0 = (size_t)ci * 128;
#pragma unroll
      for (int it = 0; it < 8; ++it) rawv[it] = *(const u32x4*)(Z + (row0 + it * 16 + vrow) * LD + 2048 + g * 256 + vch * 8);
#pragma unroll
      for (int k = 0; k < 4; ++k) stp[k] = *(const f32x4*)(stat + ((row0 + srow) * 32 + sq * 8 + k * 2) * 2); }
    for (int chunk = ci; chunk < MTOK / 128; chunk += nper) {
        const size_t row0 = (size_t)chunk * 128;
        bf16* up = Z + (row0 + r32) * LD + g * 256 + 32 * wave + 4 * hi;
        bf16* gp = Gout + (row0 + r32) * ldg + g * 256 + 32 * wave + 4 * hi;
        u32x2 uw[4][4];
#pragma unroll
        for (int tb = 0; tb < 4; ++tb)
#pragma unroll
            for (int g4 = 0; g4 < 4; ++g4) uw[tb][g4] = *(const u32x2*)(up + (size_t)tb * 32 * LD + 8 * g4);
        { float s = (stp[0].x + stp[0].z) + (stp[1].x + stp[1].z) + (stp[2].x + stp[2].z) + (stp[3].x + stp[3].z);
          float q = (stp[0].y + stp[0].w) + (stp[1].y + stp[1].w) + (stp[2].y + stp[2].w) + (stp[3].y + stp[3].w);
          s += __shfl_xor(s, 1); s += __shfl_xor(s, 2); q += __shfl_xor(q, 1); q += __shfl_xor(q, 2);
          const float mean = s * (1.f / 2048.f), var = fmaxf(q * (1.f / 2048.f) - mean * mean, 0.f);
          if (sq == 0) { st[2 * srow] = mean; st[2 * srow + 1] = 1.0f / sqrtf(var + EPS); } }
        __syncthreads();
#pragma unroll
        for (int it = 0; it < 8; ++it) {
            const int row = it * 16 + vrow; const u32x4 w = rawv[it];
            const float mean = st[2 * row], rstd = st[2 * row + 1];
            u32x4 o;
            o.x = cvtpk((bflo(w.x) - mean) * rstd * g0.x + b0.x, (bfhi(w.x) - mean) * rstd * g0.y + b0.y);
            o.y = cvtpk((bflo(w.y) - mean) * rstd * g0.z + b0.z, (bfhi(w.y) - mean) * rstd * g0.w + b0.w);
            o.z = cvtpk((bflo(w.z) - mean) * rstd * g1.x + b1.x, (bfhi(w.z) - mean) * rstd * g1.y + b1.y);
            o.w = cvtpk((bflo(w.w) - mean) * rstd * g1.z + b1.z, (bfhi(w.w) - mean) * rstd * g1.w + b1.w);
            *(LAS u32x4*)(lds + row * PITCH + vch * 16) = o;
        }
        __syncthreads();
        if (chunk + nper < MTOK / 128) { const size_t nrow0 = (size_t)(chunk + nper) * 128;
#pragma unroll
            for (int it = 0; it < 8; ++it) rawv[it] = *(const u32x4*)(Z + (nrow0 + it * 16 + vrow) * LD + 2048 + g * 256 + vch * 8);
#pragma unroll
            for (int k = 0; k < 4; ++k) stp[k] = *(const f32x4*)(stat + ((nrow0 + srow) * 32 + sq * 8 + k * 2) * 2); }
        bf16x8 af[8];
#pragma unroll
        for (int ks = 0; ks < 8; ++ks) { const v4i16_t lo = tr_read(lds + troff + (16 * ks) * PITCH), h4 = tr_read(lds + troff + (16 * ks + 4) * PITCH);
            af[ks] = (bf16x8){lo[0], lo[1], lo[2], lo[3], h4[0], h4[1], h4[2], h4[3]}; }
#pragma unroll
        for (int tb = 0; tb < 4; ++tb) {
            f32x16 acc = {};
            LAS unsigned char* wp = lds + OFF_W + (tb * 32 + r32) * WPITCH + 16 * hi;
#pragma unroll
            for (int ks = 0; ks < 2 * (tb + 1); ++ks) { const bf16x8 bfrag = *(LAS bf16x8*)(wp + 32 * ks); acc = __builtin_amdgcn_mfma_f32_32x32x16_bf16(af[ks], bfrag, acc, 0, 0, 0); }
            const float bsv = bsr[tb];
#pragma unroll
            for (int g4 = 0; g4 < 4; ++g4) { const u32x2 u2 = uw[tb][g4]; u32x2 ow;
                const pg8::f32x2 ua = pg8::gelu_pk((pg8::f32x2){bflo(u2.x), bfhi(u2.x)}), ub = pg8::gelu_pk((pg8::f32x2){bflo(u2.y), bfhi(u2.y)});
                ow.x = cvtpk(ua.x * (acc[4 * g4] + bsv), ua.y * (acc[4 * g4 + 1] + bsv));
                ow.y = cvtpk(ub.x * (acc[4 * g4 + 2] + bsv), ub.y * (acc[4 * g4 + 3] + bsv));
                *(u32x2*)(gp + (size_t)tb * 32 * ldg + 8 * g4) = ow; }
        }
        __syncthreads();
    }
}

template <bool DIAG>
__device__ __forceinline__ void attn_tile(f32x16& o0, f32x16& o1, float& carry2, const bf16x8 (&qr)[4], bf16x8 (&kf)[4], u32x4 (&vr)[4], const bf16* kpn, const bf16* vpn, bool has_next,
                                          LAS unsigned char* vcur, LAS unsigned char* vnxt, int troff, int strow, int stch, int r32, int hi) {
    constexpr int LD = NQKV; constexpr float LOG2E = 1.4426950408889634f;
    f32x16 p = {};
#pragma unroll
    for (int s = 0; s < 4; ++s) p = __builtin_amdgcn_mfma_f32_32x32x16_bf16(kf[s], qr[s], p, 0, 0, 0);
    (void)has_next;
#pragma unroll
    for (int s = 0; s < 4; ++s) { kf[s] = *(const bf16x8*)(kpn + 16 * s); vr[s] = *(const u32x4*)(vpn + (size_t)s * 8 * LD); }
    float kp[16], be[16];
#pragma unroll
    for (int r = 0; r < 16; ++r) { const float z = __builtin_amdgcn_fmed3f(p[r], -80.f, 3.0e38f);
        const float t = __builtin_amdgcn_exp2f(z * -LOG2E); be[r] = __builtin_amdgcn_rcpf(1.f + t); kp[r] = t * be[r];
        if (DIAG) { const bool msk = crow(r, hi) >= r32; kp[r] = msk ? 1.f : kp[r]; be[r] = msk ? 0.f : be[r]; } }
    float se[16], G[4], oth[4], T[4];
#pragma unroll
    for (int g = 0; g < 4; ++g) { se[4 * g + 3] = 1.f; se[4 * g + 2] = kp[4 * g + 3]; se[4 * g + 1] = se[4 * g + 2] * kp[4 * g + 2]; se[4 * g] = se[4 * g + 1] * kp[4 * g + 1]; G[g] = se[4 * g] * kp[4 * g]; }
#pragma unroll
    for (int g = 0; g < 4; ++g) {
        const auto rr = __builtin_amdgcn_permlane32_swap(__float_as_uint(G[g]), __float_as_uint(G[g]), false, false);
        oth[g] = __uint_as_float(rr[1]); T[g] = __uint_as_float(rr[0]) * __uint_as_float(rr[1]); }
    const float C = __builtin_amdgcn_exp2f(carry2);
    float base[4]; const float a2 = T[3], a1 = T[3] * T[2], a0 = a1 * T[1];
    base[3] = C; base[2] = C * a2; base[1] = C * a1; base[0] = C * a0;
    if (hi == 0) {
#pragma unroll
        for (int g = 0; g < 4; ++g) base[g] *= oth[g]; }
    carry2 += __builtin_amdgcn_logf(a0 * T[0]);
    float a[16];
#pragma unroll
    for (int r = 0; r < 16; ++r) a[r] = be[r] * (se[r] * base[r >> 2]);
    u32x4 pw0, pw1;
    pw0.x = cvtpk(a[0], a[1]); pw0.y = cvtpk(a[2], a[3]); pw0.z = cvtpk(a[4], a[5]); pw0.w = cvtpk(a[6], a[7]);
    pw1.x = cvtpk(a[8], a[9]); pw1.y = cvtpk(a[10], a[11]); pw1.z = cvtpk(a[12], a[13]); pw1.w = cvtpk(a[14], a[15]);
    const bf16x8 pf0 = __builtin_bit_cast(bf16x8, pw0), pf1 = __builtin_bit_cast(bf16x8, pw1);
    asm volatile("" ::: "memory");
#pragma unroll
    for (int dh = 0; dh < 2; ++dh)
#pragma unroll
        for (int s = 0; s < 2; ++s) {
            const v4i16_t lo = tr_read(vcur + troff + (16 * s) * 192 + dh * 64), h4 = tr_read(vcur + troff + (16 * s + 8) * 192 + dh * 64);
            const bf16x8 vf = (bf16x8){lo[0], lo[1], lo[2], lo[3], h4[0], h4[1], h4[2], h4[3]};
            if (dh == 0) o0 = __builtin_amdgcn_mfma_f32_32x32x16_bf16(vf, s == 0 ? pf0 : pf1, o0, 0, 0, 0);
            else o1 = __builtin_amdgcn_mfma_f32_32x32x16_bf16(vf, s == 0 ? pf0 : pf1, o1, 0, 0, 0);
        }
    asm volatile("" ::: "memory");
#pragma unroll
    for (int it = 0; it < 4; ++it) *(LAS u32x4*)(vnxt + (it * 8 + strow) * 192 + stch * 16) = vr[it];
    asm volatile("" ::: "memory");
}
__device__ __forceinline__ void attn_phase(bf16* QKV, bf16* Oout, int ldo, LAS unsigned char* lds, int wave, int lane) {
    constexpr int LD = NQKV;
    const int r32 = lane & 31, hi = lane >> 5;
    LAS unsigned char* vb = lds + wave * 12288;
    const int vcu = (gridDim.x % 8 == 0) ? (int)((blockIdx.x & 7) * (gridDim.x >> 3) + (blockIdx.x >> 3)) : (int)blockIdx.x;
    const int gw = vcu * NWAVES + wave, ngw = gridDim.x * NWAVES;
    const int troff = (4 * hi + ((lane & 15) >> 2)) * 192 + (16 * ((lane >> 4) & 1) + 4 * (lane & 3)) * 2;
    const int strow = lane >> 3, stch = lane & 7;
#define ATT_UNIT(unit_) const int bh = (unit_) >> 6, qb = ((unit_) + 8 * (bh >> 5)) & 63, h = bh & 15, b = bh >> 4;     \
        const size_t rowbase = (size_t)b * SEQ; \
        const bf16* qp = QKV + (rowbase + qb * 32 + r32) * LD + h * 64; \
        const bf16* kbase = QKV + (rowbase + r32) * LD + 1024 + h * 64 + 8 * hi; \
        const bf16* vbase = QKV + (rowbase + strow) * LD + 2048 + h * 64 + stch * 8;
#define ATT_LOAD(Q_) do { const bf16* kp = kbase + (size_t)qb * 32 * LD; const bf16* vp = vbase + (size_t)qb * 32 * LD; \
        _Pragma("unroll") for (int s = 0; s < 4; ++s) Q_[s] = *(const bf16x8*)(qp + 16 * s + 8 * hi); \
        _Pragma("unroll") for (int s = 0; s < 4; ++s) { kf[s] = *(const bf16x8*)(kp + 16 * s); vr[s] = *(const u32x4*)(vp + (size_t)s * 8 * LD); } } while (0)
    const int nunits = BATCH * 16 * 64;
    bf16x8 qr[4], kf[4]; u32x4 vr[4];
    if (gw < nunits) { ATT_UNIT(gw) ATT_LOAD(qr); }
    for (int unit = gw; unit < nunits; unit += ngw) {
        ATT_UNIT(unit)
        f32x16 o0 = {}, o1 = {};
        float carry2 = 0.f;
#pragma unroll
        for (int it = 0; it < 4; ++it) *(LAS u32x4*)(vb + (it * 8 + strow) * 192 + stch * 16) = vr[it];
        asm volatile("" ::: "memory");
        attn_tile<true>(o0, o1, carry2, qr, kf, vr, kbase + (size_t)(qb > 0 ? qb - 1 : 0) * 32 * LD, vbase + (size_t)(qb > 0 ? qb - 1 : 0) * 32 * LD, qb > 0, vb, vb + 6144, troff, strow, stch, r32, hi);
        int buf = 1;
        for (int kt = qb - 1; kt >= 0; --kt) {
            if (__all(carry2 <= -150.f)) break;
            attn_tile<false>(o0, o1, carry2, qr, kf, vr, kbase + (size_t)(kt > 0 ? kt - 1 : 0) * 32 * LD, vbase + (size_t)(kt > 0 ? kt - 1 : 0) * 32 * LD, kt > 0, vb + buf * 6144, vb + (buf ^ 1) * 6144, troff, strow, stch, r32, hi);
            buf ^= 1;
        }
        if (unit + ngw < nunits) { const int nu = unit + ngw; { ATT_UNIT(nu) ATT_LOAD(qr); } }
        bf16* op = Oout + (rowbase + qb * 32 + r32) * ldo + h * 64;
#pragma unroll
        for (int g = 0; g < 4; ++g) {
            u32x2 w0, w1;
            w0.x = cvtpk(o0[4 * g], o0[4 * g + 1]); w0.y = cvtpk(o0[4 * g + 2], o0[4 * g + 3]);
            w1.x = cvtpk(o1[4 * g], o1[4 * g + 1]); w1.y = cvtpk(o1[4 * g + 2], o1[4 * g + 3]);
            *(u32x2*)(op + 8 * g + 4 * hi) = w0; *(u32x2*)(op + 32 + 8 * g + 4 * hi) = w1;
        }
    }
#undef ATT_UNIT
#undef ATT_LOAD
}

#define XB_TMO      128
#define XB_XCNT(j)  (256  + 64 * (j))
#define XB_XSUB(j)  (1280 + 64 * (j))
#define XB_XGEN(j)  (2304 + 64 * (j))
#define XB_TOP      3328
#define XB_TOPGEN   3392
#define XCD_BAR_WORDS 3456
#define XB_SPIN_CAP (1u << 18)

__device__ __forceinline__ unsigned xb_ld(unsigned* p)              { return __hip_atomic_load(p, __ATOMIC_RELAXED, __HIP_MEMORY_SCOPE_AGENT); }
__device__ __forceinline__ unsigned xb_add(unsigned* p, unsigned v) { return __hip_atomic_fetch_add(p, v, __ATOMIC_RELAXED, __HIP_MEMORY_SCOPE_AGENT); }
__device__ __forceinline__ unsigned xb_xcc_id() { return (unsigned)__builtin_amdgcn_s_getreg((3 << 11) | 20) & 0xFu; }
#define XB_SPIN(cond, bar) do { unsigned _sp = 0; while (cond) { __builtin_amdgcn_s_sleep(1); \
    if ((++_sp & 255u) == 0u) { if (xb_ld(&(bar)[XB_TMO])) break; if (_sp > XB_SPIN_CAP) { atomicAdd(&(bar)[XB_TMO], 1u); break; } } } } while (0)

struct XcdBarrier {
    unsigned* bar; unsigned x;
    volatile LAS unsigned* st;
};

__device__ __forceinline__ XcdBarrier xcd_barrier_post(unsigned* bar, volatile LAS unsigned* st) {
    XcdBarrier b; b.bar = bar; b.x = xb_xcc_id(); b.st = st;
    if (threadIdx.x == 0) (void)xb_add(&bar[XB_XCNT(b.x)], 1u);
    return b;
}
__device__ __forceinline__ void xcd_barrier_complete(unsigned* bar, unsigned x, unsigned& nloc, unsigned& nx) {
    const unsigned G = gridDim.x * gridDim.y * gridDim.z;
    unsigned sum, cnt, mine, sp = 0u;
    for (;;) {
        sum = 0u; cnt = 0u; mine = 0u;
#pragma unroll
        for (unsigned j = 0; j < 16; ++j) { const unsigned c = xb_ld(&bar[XB_XCNT(j)]); sum += c; cnt += (c > 0u) ? 1u : 0u; mine = (j == x) ? c : mine; }
        if (sum == G) break;
        __builtin_amdgcn_s_sleep(1);
        if ((++sp & 255u) == 0u) { if (xb_ld(&bar[XB_TMO])) break; if (sp > XB_SPIN_CAP) { atomicAdd(&bar[XB_TMO], 1u); break; } }
    }
    nloc = mine > 0u ? mine : 1u; nx = cnt > 0u ? cnt : 1u;
}

__device__ __forceinline__ void xcd_barrier(const XcdBarrier& b) {
    asm volatile("s_waitcnt vmcnt(0)" ::: "memory");
    __syncthreads();
    if (threadIdx.x == 0) {
        unsigned* bar = b.bar;
        __builtin_amdgcn_s_waitcnt(0);
        unsigned nloc = b.st[0], nx = b.st[1];
        if (nloc == 0u) { xcd_barrier_complete(bar, b.x, nloc, nx); b.st[0] = nloc; b.st[1] = nx; }
        const unsigned old = xb_add(&bar[XB_XSUB(b.x)], 1u);
        const unsigned gen = old / nloc;
        if (old + 1u == (gen + 1u) * nloc) {
            __builtin_amdgcn_fence(__ATOMIC_RELEASE, "agent");
            asm volatile("s_waitcnt vmcnt(0)" ::: "memory");
            const unsigned og = xb_add(&bar[XB_TOP], 1u);
            const unsigned tg = og / nx;
            if (og + 1u == (tg + 1u) * nx) xb_add(&bar[XB_TOPGEN], 1u);
            else XB_SPIN(xb_ld(&bar[XB_TOPGEN]) == tg, bar);
            __builtin_amdgcn_fence(__ATOMIC_ACQUIRE, "agent");
            xb_add(&bar[XB_XGEN(b.x)], 1u);
            asm volatile("s_waitcnt vmcnt(0)" ::: "memory");
        } else {
            XB_SPIN(xb_ld(&bar[XB_XGEN(b.x)]) == gen, bar);
            __builtin_amdgcn_fence(__ATOMIC_ACQUIRE, "agent");
            asm volatile("s_waitcnt vmcnt(0)" ::: "memory");
        }
    }
    __syncthreads();
}

struct Params { const float* in[15]; float* out; unsigned char* ws; };

__global__ void __launch_bounds__(NWAVES * 64, 2) fwd_kernel(Params p) {
    extern __shared__ __attribute__((aligned(16))) unsigned char lds_raw[];
    cg::grid_group grid = cg::this_grid();
    LAS unsigned char* lds = (LAS unsigned char*)lds_raw;
    unsigned char* ws = p.ws;
    const float* x = p.in[0]; const float* n_mix_pre = p.in[1]; const float* n_mix_post = p.in[2]; const float* n_ffn_pre = p.in[3]; const float* n_ffn_post = p.in[4];
    const float* a_v_g = p.in[6]; const float* a_v_b = p.in[7]; const float* a_w_s = p.in[8]; const float* a_b_s = p.in[9];
    bf16* Win_t = (bf16*)(ws + WS_WIN); bf16* Wouta_t = (bf16*)(ws + WS_WOUTA); bf16* Wqkv_t = (bf16*)(ws + WS_WQKV); bf16* Wob_t = (bf16*)(ws + WS_WOB);
    bf16* W1_t = (bf16*)(ws + WS_W1); bf16* W2_t = (bf16*)(ws + WS_W2); bf16* Wc = (bf16*)(ws + WS_WC);
    bf16* XB = (bf16*)(ws + WS_HN); bf16* Z = (bf16*)(ws + WS_Z); float* STAT = (float*)(ws + WS_STAT);
    float* XCH = (float*)(ws + WS_XCH); float* XCH2 = (float*)(ws + WS_XCH2); float* XSTAT = (float*)(ws + WS_XSTAT); unsigned* CNT = (unsigned*)(ws + WS_CNT);
    float* out = p.out;
    unsigned* barw = (unsigned*)(ws + WS_BAR);
    volatile LAS unsigned* bst = (volatile LAS unsigned*)(lds + LDS_BST);
    if (threadIdx.x == 0) { bst[0] = 0u; bst[1] = 0u; }
    if (blockIdx.x == 0) for (int i = threadIdx.x; i < XCD_BAR_WORDS; i += NWAVES * 64) __hip_atomic_store(barw + i, 0u, __ATOMIC_RELAXED, __HIP_MEMORY_SCOPE_AGENT);
    __syncthreads();

    {
        const int tid = threadIdx.x, lane = tid & 63, wave = __builtin_amdgcn_readfirstlane(tid >> 6);
        const int gw = blockIdx.x * NWAVES + wave, ngw = gridDim.x * NWAVES;
        for (int i = blockIdx.x * 512 + tid; i < 16 * 256 * 64; i += gridDim.x * 512) __hip_atomic_store(CNT + i, 0u, __ATOMIC_RELAXED, __HIP_MEMORY_SCOPE_AGENT);
        LAS float* scr = (LAS float*)(lds + wave * 16384);
        if (ngw >= 2048) {
            float ra[32], rb[32];
#define TRM_W(m)  ((m) < 8 ? (((m) & 3) == 0 ? p.in[5] + (size_t)((m) >> 2) * 1024 * 4096 : ((m) & 3) == 1 ? p.in[10] + (size_t)((m) >> 2) * 2048 * 1024 : ((m) & 3) == 2 ? p.in[11] + (size_t)((m) >> 2) * 1024 * 3072 : p.in[12] + (size_t)((m) >> 2) * 1024 * 1024) \
                           : (m) < 12 ? p.in[13] + (size_t)((m) - 8) * 1024 * 4096 : p.in[14] + (size_t)((m) - 12) * 4096 * 1024)
#define TRM_K(m)  ((m) < 8 ? (((m) & 3) == 1 ? 2048 : 1024) : (m) < 12 ? 1024 : 4096)
#define TRM_N(m)  ((m) < 8 ? (((m) & 3) == 0 ? 4096 : ((m) & 3) == 1 ? 1024 : ((m) & 3) == 2 ? 3072 : 1024) : (m) < 12 ? 4096 : 1024)
#define TRM_G(m)  ((m) < 8 ? (((m) & 3) == 0 ? n_mix_pre + (2 * ((m) >> 2)) * 1024 : ((m) & 3) == 2 ? n_mix_pre + (2 * ((m) >> 2) + 1) * 1024 : (const float*)nullptr) : (m) < 12 ? n_ffn_pre + ((m) - 8) * 1024 : (const float*)nullptr)
#define TRM_T(m)  ((m) < 8 ? (((m) & 3) == 0 ? Win_t + (size_t)((m) >> 2) * 4096 * 1024 : ((m) & 3) == 1 ? Wouta_t + (size_t)((m) >> 2) * 1024 * 2048 : ((m) & 3) == 2 ? Wqkv_t + (size_t)((m) >> 2) * 3072 * 1024 : Wob_t + (size_t)((m) >> 2) * 1024 * 1024) \
                           : (m) < 12 ? W1_t + (size_t)((m) - 8) * 4096 * 1024 : W2_t + (size_t)((m) - 12) * 1024 * 4096)
#define TRM_HAS(m) (gw < (TRM_K(m) / 64) * (TRM_N(m) / 32))
            if (TRM_HAS(0)) tr_load(ra, TRM_W(0), TRM_N(0), gw, lane);
#pragma unroll
            for (int m = 0; m < 16; m += 2) {
                if (TRM_HAS(m + 1)) tr_load(rb, TRM_W(m + 1), TRM_N(m + 1), gw, lane);
                if (TRM_HAS(m)) tr_finish(ra, TRM_G(m), TRM_K(m), TRM_N(m), TRM_T(m), scr, gw, lane);
                if (m + 2 < 16) { if (TRM_HAS(m + 2)) tr_load(ra, TRM_W(m + 2), TRM_N(m + 2), gw, lane); }
                if (TRM_HAS(m + 1)) tr_finish(rb, TRM_G(m + 1), TRM_K(m + 1), TRM_N(m + 1), TRM_T(m + 1), scr, gw, lane);
            }
#undef TRM_W
#undef TRM_K
#undef TRM_N
#undef TRM_G
#undef TRM_T
#undef TRM_HAS
        } else {
        for (int l = 0; l < 2; ++l) {
            transpose_matrix(p.in[5] + (size_t)l * 1024 * 4096, n_mix_pre + (2 * l) * 1024, 1024, 4096, Win_t + (size_t)l * 4096 * 1024, scr, gw, ngw, lane);
            transpose_matrix(p.in[10] + (size_t)l * 2048 * 1024, nullptr, 2048, 1024, Wouta_t + (size_t)l * 1024 * 2048, scr, gw, ngw, lane);
            transpose_matrix(p.in[11] + (size_t)l * 1024 * 3072, n_mix_pre + (2 * l + 1) * 1024, 1024, 3072, Wqkv_t + (size_t)l * 3072 * 1024, scr, gw, ngw, lane);
            transpose_matrix(p.in[12] + (size_t)l * 1024 * 1024, nullptr, 1024, 1024, Wob_t + (size_t)l * 1024 * 1024, scr, gw, ngw, lane);
        }
        for (int l = 0; l < 4; ++l) {
            transpose_matrix(p.in[13] + (size_t)l * 1024 * 4096, n_ffn_pre + l * 1024, 1024, 4096, W1_t + (size_t)l * 4096 * 1024, scr, gw, ngw, lane);
            transpose_matrix(p.in[14] + (size_t)l * 4096 * 1024, nullptr, 4096, 1024, W2_t + (size_t)l * 1024 * 4096, scr, gw, ngw, lane);
        }
        }
        for (int i = blockIdx.x * 512 + tid; i < 2 * 8 * 128 * 128; i += gridDim.x * 512) { const int s = i & 127, t = (i >> 7) & 127; Wc[i] = (s <= t) ? (bf16)(cvtpk(a_w_s[i], 0.f) & 0xffffu) : (bf16)0; }
        x_to_bf16(x, XB, XSTAT, wave, lane);
    }
    grid.sync();
    const XcdBarrier xbar = xcd_barrier_post(barw, bst);

#pragma unroll 1
    for (int ph = 0; ph < 20; ++ph) {
        const int layer = ph / 5, step = ph % 5, j = layer >> 1; const bool even = (layer & 1) == 0;
        int tid = threadIdx.x; asm volatile("" : "+v"(tid));
        const int lane = tid & 63, wave = __builtin_amdgcn_readfirstlane(tid >> 6);
        if (step == 0 || step == 3) {
            pg8::Gemm g; EpiAct E; E.stat = STAT; E.rowstat = XSTAT; g.A = XB; g.lda = 1024; g.K = 1024; g.M = MTOK; E.O = Z;
            if (step == 0) { g.N = even ? 4096 : 3072; g.Bt = even ? Win_t + (size_t)j * 4096 * 1024 : Wqkv_t + (size_t)j * 3072 * 1024; E.ldc = g.N; E.act = even ? 1 : 3; }
            else { g.N = 4096; g.Bt = W1_t + (size_t)layer * 4096 * 1024; E.ldc = 4096; E.act = 2; }
            pg8::StaticOrder S; S.init(g.M, g.N, (int)gridDim.x, (int)blockIdx.x);
            pg8::gemm_phase<EpiAct, pg8::StaticOrder, true, true>(lds, g, S, E);
        } else if (step == 2 || step == 4) {
            pg8::Gemm g; EpiRes E; g.A = Z; g.M = MTOK; g.N = 1024;
            if (step == 2) { g.lda = even ? 4096 : 3072; g.K = even ? 2048 : 1024; g.Bt = even ? Wouta_t + (size_t)j * 1024 * 2048 : Wob_t + (size_t)j * 1024 * 1024; }
            else { g.lda = 4096; g.K = 4096; g.Bt = W2_t + (size_t)layer * 1024 * 4096; }
            const int bank = layer * 2 + (step == 4 ? 1 : 0);
            E.XB = XB; E.outf = (ph == 19) ? out : nullptr; E.xch = XCH; E.xch2 = XCH2; E.cnt = CNT + (size_t)bank * 256 * 64; E.cnt2 = CNT + (size_t)(8 + bank) * 256 * 64; E.rs = XSTAT; E.lds = lds;
            pg8::StaticOrder S; S.init(g.M, g.N, (int)gridDim.x, (int)blockIdx.x);
            pg8::gemm_phase<EpiRes, pg8::StaticOrder, true, true>(lds, g, S, E);
        } else {
#if PROBE_MIX
            if (even) { mix_phase(Z, (bf16*)(ws + 900 * MiB), 2048, STAT, a_v_g + (size_t)j * 2048, a_v_b + (size_t)j * 2048, Wc + (size_t)j * 8 * 128 * 128, a_b_s + (size_t)j * 8 * 128, lds, tid, wave, lane); __syncthreads(); }
#endif
#if PROBE_ATTN
            if (!even) attn_phase(Z, (bf16*)(ws + 900 * MiB), 1024, lds, wave, lane);
#endif
            if (even) mix_phase(Z, Z, 4096, STAT, a_v_g + (size_t)j * 2048, a_v_b + (size_t)j * 2048, Wc + (size_t)j * 8 * 128 * 128, a_b_s + (size_t)j * 8 * 128, lds, tid, wave, lane);
            else attn_phase(Z, Z, NQKV, lds, wave, lane);
        }
        if (step == 1 || step == 3) {
            const float* gsrc = (step == 1 ? n_mix_post : n_ffn_post) + layer * 1024;
            for (int i = tid; i < 1024; i += NWAVES * 64) ((LAS float*)(lds + LDS_G))[i] = gsrc[i];
        }
        if (ph != 19) xcd_barrier(xbar);
    }
}

extern "C" void kernel_launch(void* const* d_in, const int* in_sizes, int n_in, void* d_out, int out_size, void* d_ws, size_t ws_size, hipStream_t stream) {
    static int grid = 0;
    if (grid == 0) {
        if (n_in != 15 || out_size != MTOK * D_MODEL || ws_size < WS_END) { fprintf(stderr, "kernel_launch: unexpected sizes (n_in %d out %d ws %zu)\n", n_in, out_size, ws_size); grid = -1; return; }
        int dev = 0, cus = 0, per_cu = 0;
        hipGetDevice(&dev); hipDeviceGetAttribute(&cus, hipDeviceAttributeMultiprocessorCount, dev);
        if (hipFuncSetAttribute((const void*)fwd_kernel, hipFuncAttributeMaxDynamicSharedMemorySize, LDS_BYTES) != hipSuccess) fprintf(stderr, "kernel_launch: hipFuncSetAttribute failed\n");
        if (hipOccupancyMaxActiveBlocksPerMultiprocessor(&per_cu, (const void*)fwd_kernel, NWAVES * 64, LDS_BYTES) != hipSuccess || per_cu < 1) { fprintf(stderr, "kernel_launch: occupancy query gave %d\n", per_cu); per_cu = 1; }
        (void)hipGetLastError();
        grid = cus * per_cu;
    }
    if (grid < 0) return;
    Params p{};
    for (int i = 0; i < 15; ++i) p.in[i] = (const float*)d_in[i];
    p.out = (float*)d_out; p.ws = (unsigned char*)d_ws;
    void* args[] = {&p};
    hipError_t e = hipLaunchCooperativeKernel((const void*)fwd_kernel, dim3(grid), dim3(NWAVES * 64), args, LDS_BYTES, stream);
    if (e != hipSuccess) fprintf(stderr, "kernel_launch: cooperative launch failed: %s (grid %d)\n", hipGetErrorString(e), grid);
}
```

```cpp
#include <hip/hip_runtime.h>
#include <hip/hip_cooperative_groups.h>
#include <cstdio>
#include <cstdint>
namespace cg = cooperative_groups;

namespace pg8 {
#define PG8_LAS __attribute__((address_space(3)))
typedef unsigned short bf16_t;
typedef short bf16x8 __attribute__((ext_vector_type(8)));
typedef float f32x4 __attribute__((ext_vector_type(4)));
typedef unsigned u32x4 __attribute__((ext_vector_type(4)));
constexpr int BM = 256, BK = 64, HALF = 128, HTB = HALF * BK * 2  , STAGE_BYTES = 8 * HTB, NXCD = 8, WGM = 8;

__host__ __device__ __forceinline__ int lds_byte(int r, int c) { const int st = (r >> 4) * 2 + (c >> 5), rr = r & 15, cc = c & 31, ob = rr * 64 + cc * 2; return st * 1024 + (ob ^ (((ob >> 9) & 1) << 5)); }
__host__ __device__ __forceinline__ void stage_rc(int b, int& R, int& C) { const int st = b / 1024, sb = b % 1024, swz = sb ^ (((sb >> 9) & 1) << 5); R = (st >> 1) * 16 + swz / 64; C = (st & 1) * 32 + (swz % 64) / 2; }
__host__ __device__ __forceinline__ int perm32(int rho) { const int n = rho >> 4, i = rho & 15; return 8 * (i >> 2) + 4 * n + (i & 3); }

struct Unit { int pm, pn; };
struct Gemm { const bf16_t* A; const bf16_t* Bt; int M, N, K, lda; };

struct StaticOrder {
    int nM, nN, nwg, G, c;
    __host__ __device__ void init(int M, int N, int G_, int c_) { nM = M / BM; nN = N / BM; nwg = nM * nN; G = G_; c = c_; }
    __host__ __device__ bool next(int i, Unit& u) const {
        const long L = (long)i * G + c; if (L >= nwg) return false;
        int wgid = (int)L; { const int q = nwg / NXCD, r = nwg % NXCD, xcd = wgid % NXCD, off = wgid / NXCD; wgid = (xcd < r ? xcd * (q + 1) : r * (q + 1) + (xcd - r) * q) + off; }
        const int nig = WGM * nN, gid = wgid / nig, fm = gid * WGM, gsz = (nM - fm) < WGM ? (nM - fm) : WGM;
        u.pm = fm + ((wgid % nig) % gsz); u.pn = (wgid % nig) / gsz; return true;
    }
    __device__ __forceinline__ void a_ready(const Unit&) const {}
    __device__ __forceinline__ void done(const Unit&) const {}
};

__device__ __forceinline__ unsigned cvt_pk_bf16(float lo, float hi) { unsigned r; asm volatile("v_cvt_pk_bf16_f32 %0, %1, %2" : "=v"(r) : "v"(lo), "v"(hi)); return r; }
typedef float f32x2 __attribute__((ext_vector_type(2)));
__device__ __forceinline__ f32x2 gelu_pk(f32x2 v) {
    const f32x2 av = __builtin_elementwise_abs(v), d = av * 0.2316418882f + 1.0f;
    f32x2 t; t.x = __builtin_amdgcn_rcpf(d.x); t.y = __builtin_amdgcn_rcpf(d.y);
    f32x2 q = t * 0.5307027145f + (-0.7265760135f); q = q * t + 0.7107068705f; q = q * t + (-0.142248368f); q = q * t + 0.127414796f; q = q * t;
    const f32x2 s = (v * v) * (-0.72134752044f);
    f32x2 e; e.x = __builtin_amdgcn_exp2f(s.x); e.y = __builtin_amdgcn_exp2f(s.y);
    const f32x2 m = v * (q * e), r = v - m;
    f32x2 o; o.x = v.x < 0.f ? m.x : r.x; o.y = v.y < 0.f ? m.y : r.y; return o;
}

template <int ACT  > struct EpiBf16 {
    static constexpr bool PERM = true, AFTER_DRAIN = false; static_assert(ACT == 0 || ACT == 1, "EpiBf16: ACT is 0 (none) or 1 (gelu_pk)");
    bf16_t* O; int ldc; const float* bias; int split_cols; size_t split_stride; float scale0;
    __device__ __forceinline__ void operator()(const f32x4 (&acc)[2][2][4][2], const Unit& u, int wr, int wc, int fr, int fq) const {
        const int row0 = u.pm * BM + wr * 64 + fr; int colt = u.pn * BM; bf16_t* base = O;
        float sc = 1.f; if (split_cols) { const int t = colt / split_cols; base += (size_t)t * split_stride; colt -= t * split_cols; if (t == 0) sc = scale0; }
        const int col0 = colt + wc * 32 + 8 * fq, bcol0 = u.pn * BM + wc * 32 + 8 * fq;
        f32x4 bv[2][2];
#pragma unroll
        for (int bj = 0; bj < 2; ++bj)
#pragma unroll
            for (int n = 0; n < 2; ++n) bv[bj][n] = bias ? *(const f32x4*)(bias + bcol0 + bj * HALF + 4 * n) : (f32x4){0.f, 0.f, 0.f, 0.f};
#pragma unroll
        for (int ai = 0; ai < 2; ++ai)
#pragma unroll
            for (int m = 0; m < 4; ++m) { bf16_t* rowp = base + (size_t)(row0 + ai * HALF + m * 16) * ldc + col0;
#pragma unroll
                for (int bj = 0; bj < 2; ++bj) { f32x4 v0 = acc[ai][bj][m][0] + bv[bj][0], v1 = acc[ai][bj][m][1] + bv[bj][1];
                    if (ACT == 1) { f32x2 a = gelu_pk((f32x2){v0[0], v0[1]}), b = gelu_pk((f32x2){v0[2], v0[3]}), c = gelu_pk((f32x2){v1[0], v1[1]}), d = gelu_pk((f32x2){v1[2], v1[3]});
                        v0 = (f32x4){a.x, a.y, b.x, b.y}; v1 = (f32x4){c.x, c.y, d.x, d.y}; }
                    v0 = v0 * sc; v1 = v1 * sc; u32x4 w; w.x = cvt_pk_bf16(v0[0], v0[1]); w.y = cvt_pk_bf16(v0[2], v0[3]); w.z = cvt_pk_bf16(v1[0], v1[1]); w.w = cvt_pk_bf16(v1[2], v1[3]);
                    *(u32x4*)(rowp + bj * HALF) = w; } }
    }
};
template <class Epi, class Sched, bool ALIGN_EPI = false, bool SP2 = false>
__device__ __forceinline__ void gemm_phase(PG8_LAS unsigned char* lds, const Gemm g, const Sched& S, const Epi& E) {
    int tid = threadIdx.x; asm volatile("" : "+v"(tid));
    const int wid = __builtin_amdgcn_readfirstlane(tid >> 6), lane = tid & 63, wr = wid >> 2, wc = wid & 3, fr = lane & 15, fq = lane >> 4;
    const int K = g.K, nt = K / BK;
    unsigned voffA[2], voffB[2];
#pragma unroll
    for (int i = 0; i < 2; ++i) { int R, C; stage_rc(tid * 16 + i * 8192, R, C); const int Rb = Epi::PERM ? ((R & ~31) + perm32(R & 31)) : R;
        voffA[i] = (unsigned)(R * g.lda + C) * 2u; voffB[i] = (unsigned)(Rb * K + C) * 2u; }
    const size_t kstep = (size_t)(BK * 2);
    const size_t hstepA = (size_t)HALF * g.lda * 2, hstepB = (size_t)HALF * K * 2;
    const size_t tstepA = 2 * hstepA, tstepB = 2 * hstepB;
    const unsigned ldsw = (unsigned)wid * 1024u;
    const int aoff = lds_byte(wr * 64 + fr, fq * 8), boff = lds_byte(wc * 32 + fr, fq * 8);
#define PG8_SA(b, h) (((b) * 2 + (h)) * HTB)
#define PG8_SB(b, h) ((4 + (b) * 2 + (h)) * HTB)
#define PG8_STAGE(bufoff, gbase, voff) do { _Pragma("unroll") for (int _i = 0; _i < 2; ++_i) \
        __builtin_amdgcn_global_load_lds((const unsigned*)((const char*)(gbase) + (voff)[_i]), (PG8_LAS unsigned*)(lds + (bufoff) + ldsw + _i * 8192), 16, 0, 0); } while (0)
#define PG8_LDA(dst, b, h) do { _Pragma("unroll") for (int m = 0; m < 4; ++m) _Pragma("unroll") for (int k = 0; k < 2; ++k) dst[m][k] = *(const PG8_LAS bf16x8*)(lds + PG8_SA(b, h) + aoff + m * 2048 + k * 1024); } while (0)
#define PG8_LDB(dst, b, h) do { _Pragma("unroll") for (int n = 0; n < 2; ++n) _Pragma("unroll") for (int k = 0; k < 2; ++k) dst[n][k] = *(const PG8_LAS bf16x8*)(lds + PG8_SB(b, h) + boff + n * 2048 + k * 1024); } while (0)
#define PG8_MMA(ai, bj, At, Bt) do { __builtin_amdgcn_s_setprio(1); _Pragma("unroll") for (int m = 0; m < 4; ++m) _Pragma("unroll") for (int n = 0; n < 2; ++n) _Pragma("unroll") for (int k = 0; k < 2; ++k) \
        acc[ai][bj][m][n] = __builtin_amdgcn_mfma_f32_16x16x32_bf16(Bt[n][k], At[m][k], acc[ai][bj][m][n], 0, 0, 0); __builtin_amdgcn_s_setprio(0); } while (0)
#define PG8_WAIT_V(n) asm volatile("s_waitcnt vmcnt(" #n ")" ::: "memory")
#define PG8_WAIT_L(n) asm volatile("s_waitcnt lgkmcnt(" #n ")" ::: "memory")
#define PG8_BAR __builtin_amdgcn_s_barrier()
#define PG8_SCHED __builtin_amdgcn_sched_barrier(0)
    Unit cur, nxt; int ui = 0;
    if (!S.next(0, cur)) return;
    f32x4 acc[2][2][4][2];
#pragma unroll
    for (int a = 0; a < 2; ++a)
#pragma unroll
        for (int b = 0; b < 2; ++b)
#pragma unroll
            for (int m = 0; m < 4; ++m)
#pragma unroll
                for (int n = 0; n < 2; ++n) acc[a][b][m][n] = (f32x4){0.f, 0.f, 0.f, 0.f};
    bf16x8 At[4][2], B0[2][2], B1[2][2];
    float epre[8];
    const char* cA = (const char*)g.A + (size_t)cur.pm * tstepA; const char* cB = (const char*)g.Bt + (size_t)cur.pn * tstepB;
    S.a_ready(cur);
    if constexpr (SP2) {
        PG8_STAGE(PG8_SB(0, 0), cB, voffB); PG8_STAGE(PG8_SB(0, 1), cB + hstepB, voffB); PG8_STAGE(PG8_SA(0, 0), cA, voffA); PG8_STAGE(PG8_SA(0, 1), cA + hstepA, voffA);
        if (wr == 1) PG8_BAR;
        PG8_WAIT_V(2); PG8_BAR;
        PG8_STAGE(PG8_SB(1, 0), cB + kstep, voffB); PG8_STAGE(PG8_SA(1, 0), cA + kstep, voffA); PG8_STAGE(PG8_SB(1, 1), cB + hstepB + kstep, voffB);
        PG8_WAIT_V(6); PG8_BAR;
    } else {
        PG8_STAGE(PG8_SB(0, 0), cB, voffB); PG8_STAGE(PG8_SA(0, 0), cA, voffA); PG8_STAGE(PG8_SB(0, 1), cB + hstepB, voffB); PG8_STAGE(PG8_SA(0, 1), cA + hstepA, voffA);
        if (wr == 1) PG8_BAR;
        PG8_WAIT_V(4); PG8_BAR;
        PG8_STAGE(PG8_SB(1, 0), cB + kstep, voffB); PG8_STAGE(PG8_SA(1, 0), cA + kstep, voffA); PG8_STAGE(PG8_SB(1, 1), cB + hstepB + kstep, voffB);
        PG8_WAIT_V(6); PG8_BAR;
    }
    for (;;) {
        const bool has_next = S.next(ui + 1, nxt);
        const char* nA = has_next ? (const char*)g.A + (size_t)nxt.pm * tstepA : cA; const char* nB = has_next ? (const char*)g.Bt + (size_t)nxt.pn * tstepB : cB;
        for (int t = 0; t < nt; t += 2) {
            const bool last = (t == nt - 2);
            const char* a1 = cA + (size_t)(t + 1) * kstep;
            const char* a2 = last ? nA : cA + (size_t)(t + 2) * kstep; const char* b2 = last ? nB : cB + (size_t)(t + 2) * kstep;
            const char* a3 = a2 + kstep; const char* b3 = b2 + kstep;
            if (last && has_next) S.a_ready(nxt);
            if (last) E.prefetch(epre, cur, wr, fr);
            if constexpr (SP2) {
            PG8_LDB(B0, 0, 0); PG8_LDB(B1, 0, 1); PG8_SCHED; PG8_LDA(At, 0, 0); PG8_STAGE(PG8_SA(1, 1), a1 + hstepA, voffA);
            PG8_WAIT_V(8); PG8_WAIT_L(0); PG8_BAR; PG8_MMA(0, 0, At, B0); PG8_MMA(0, 1, At, B1); PG8_BAR; PG8_SCHED;
            PG8_LDA(At, 0, 1); PG8_STAGE(PG8_SB(0, 0), b2, voffB); PG8_STAGE(PG8_SB(0, 1), b2 + hstepB, voffB); PG8_STAGE(PG8_SA(0, 0), a2, voffA);
            PG8_WAIT_V(8); PG8_WAIT_L(0); PG8_BAR; PG8_MMA(1, 0, At, B0); PG8_MMA(1, 1, At, B1); PG8_BAR; PG8_SCHED;
            PG8_LDB(B0, 1, 0); PG8_LDB(B1, 1, 1); PG8_SCHED; PG8_LDA(At, 1, 0); PG8_STAGE(PG8_SA(0, 1), a2 + hstepA, voffA);
            PG8_WAIT_V(8); PG8_WAIT_L(0); PG8_BAR; PG8_MMA(0, 0, At, B0); PG8_MMA(0, 1, At, B1); PG8_BAR; PG8_SCHED;
            PG8_LDA(At, 1, 1); PG8_STAGE(PG8_SB(1, 0), b3, voffB); PG8_STAGE(PG8_SB(1, 1), b3 + hstepB, voffB); PG8_STAGE(PG8_SA(1, 0), a3, voffA);
            PG8_WAIT_V(8); PG8_WAIT_L(0); PG8_BAR; PG8_MMA(1, 0, At, B0); PG8_MMA(1, 1, At, B1); PG8_BAR; PG8_SCHED;
            } else {
            PG8_LDB(B0, 0, 0); PG8_SCHED; PG8_LDA(At, 0, 0); PG8_STAGE(PG8_SA(1, 1), a1 + hstepA, voffA);
            PG8_WAIT_L(8); PG8_BAR; PG8_WAIT_L(0); PG8_MMA(0, 0, At, B0); PG8_BAR; PG8_SCHED;
            PG8_LDB(B1, 0, 1); PG8_STAGE(PG8_SB(0, 0), b2, voffB);
            PG8_BAR; PG8_WAIT_L(0); PG8_MMA(0, 1, At, B1); PG8_BAR;
            PG8_LDA(At, 0, 1); PG8_STAGE(PG8_SA(0, 0), a2, voffA);
            PG8_BAR; PG8_WAIT_L(0); PG8_MMA(1, 0, At, B0); PG8_BAR; PG8_SCHED;
            PG8_STAGE(PG8_SB(0, 1), b2 + hstepB, voffB);
            PG8_WAIT_V(6); PG8_BAR; PG8_MMA(1, 1, At, B1); PG8_BAR;
            PG8_LDB(B0, 1, 0); PG8_SCHED; PG8_LDA(At, 1, 0); PG8_STAGE(PG8_SA(0, 1), a2 + hstepA, voffA);
            PG8_WAIT_L(8); PG8_BAR; PG8_WAIT_L(0); PG8_MMA(0, 0, At, B0); PG8_BAR; PG8_SCHED;
            PG8_LDB(B1, 1, 1); PG8_STAGE(PG8_SB(1, 0), b3, voffB);
            PG8_BAR; PG8_WAIT_L(0); PG8_MMA(0, 1, At, B1); PG8_BAR;
            PG8_LDA(At, 1, 1); PG8_STAGE(PG8_SA(1, 0), a3, voffA);
            PG8_BAR; PG8_WAIT_L(0); PG8_MMA(1, 0, At, B0); PG8_BAR; PG8_SCHED;
            PG8_STAGE(PG8_SB(1, 1), b3 + hstepB, voffB);
            PG8_WAIT_V(6); PG8_BAR; PG8_MMA(1, 1, At, B1); PG8_BAR;
            }
        }
        if constexpr (ALIGN_EPI) { if (wr == 0) PG8_BAR; }
        if constexpr (!Epi::AFTER_DRAIN) { E(acc, cur, wr, wc, fr, fq, epre); S.done(cur); }
        if (!has_next) break;
#pragma unroll
        for (int a = 0; a < 2; ++a)
#pragma unroll
            for (int b = 0; b < 2; ++b)
#pragma unroll
                for (int m = 0; m < 4; ++m)
#pragma unroll
                    for (int n = 0; n < 2; ++n) acc[a][b][m][n] = (f32x4){0.f, 0.f, 0.f, 0.f};
        cur = nxt; cA = nA; cB = nB; ++ui;
        if constexpr (ALIGN_EPI) { if (wr == 1) PG8_BAR; }
    }
    PG8_WAIT_V(0);
    if constexpr (!ALIGN_EPI) { if (wr == 0) PG8_BAR; }
    PG8_BAR;
    if constexpr (Epi::AFTER_DRAIN) { E.fused(acc, cur, wr, wc, fr, fq, lds, wid, lane); S.done(cur); }
#undef PG8_SA
#undef PG8_SB
#undef PG8_STAGE
#undef PG8_LDA
#undef PG8_LDB
#undef PG8_MMA
#undef PG8_WAIT_V
#undef PG8_WAIT_L
#undef PG8_BAR
#undef PG8_SCHED
}
}

#define LAS __attribute__((address_space(3)))
typedef unsigned short bf16;
typedef short bf16x8 __attribute__((ext_vector_type(8)));
typedef float f32x4 __attribute__((ext_vector_type(4)));
typedef float f32x16 __attribute__((ext_vector_type(16)));
typedef unsigned u32x4 __attribute__((ext_vector_type(4)));
typedef unsigned u32x2 __attribute__((ext_vector_type(2)));
typedef short v4i16_t __attribute__((ext_vector_type(4)));
typedef float f32x2_t __attribute__((ext_vector_type(2)));
typedef __bf16 bf16x2_t __attribute__((ext_vector_type(2)));

constexpr int D_MODEL = 1024, BATCH = 32, SEQ = 2048, DEPTH = 4, MTOK = BATCH * SEQ, D_FF = 4096, A_WIDTH = 2048, NQKV = 3072;
constexpr float EPS = 1e-6f;
constexpr size_t MiB = 1u << 20;
constexpr size_t WS_WIN = 1 * MiB, WS_WOUTA = 17 * MiB, WS_WQKV = 25 * MiB, WS_WOB = 37 * MiB, WS_W1 = 41 * MiB, WS_W2 = 73 * MiB, WS_WC = 105 * MiB;
constexpr size_t WS_HN = 112 * MiB, WS_Z = 240 * MiB, WS_STAT = 752 * MiB, WS_XCH = 768 * MiB, WS_XSTAT = 769 * MiB, WS_CNT = 770 * MiB, WS_XCH2 = 771 * MiB, WS_END = 772 * MiB;
constexpr int LDS_BYTES = 147456, LDS_BST = 131072 + 1024;
constexpr size_t WS_BAR = 65536;
constexpr int NWAVES = 8;
#ifndef PROBE_MIX
#define PROBE_MIX 0
#endif
#ifndef PROBE_ATTN
#define PROBE_ATTN 0
#endif


__device__ __forceinline__ unsigned cvtpk(float lo, float hi) { f32x2_t v = {lo, hi}; bf16x2_t b = __builtin_convertvector(v, bf16x2_t); return __builtin_bit_cast(unsigned, b); }
__device__ __forceinline__ float bflo(unsigned w) { return __uint_as_float(w << 16); }
__device__ __forceinline__ float bfhi(unsigned w) { return __uint_as_float(w & 0xffff0000u); }
__device__ __forceinline__ float wave_sum(float v) {
#pragma unroll
    for (int o = 1; o < 64; o <<= 1) v += __shfl_xor(v, o);
    return v;
}
__device__ __forceinline__ int crow(int r, int hi) { return (r & 3) + 8 * (r >> 2) + 4 * hi; }
__device__ __forceinline__ v4i16_t tr_read(LAS unsigned char* p) { return __builtin_amdgcn_ds_read_tr16_b64_v4i16((LAS v4i16_t*)p); }

struct EpiAct {
    static constexpr bool PERM = true, AFTER_DRAIN = false;
    bf16* O; int ldc; int act; const float* rowstat; float* stat;
    __device__ __forceinline__ void prefetch(float (&pre)[8], const pg8::Unit& u, int wr, int fr) const {
        const int row0 = u.pm * pg8::BM + wr * 64 + fr;
#pragma unroll
        for (int ai = 0; ai < 2; ++ai)
#pragma unroll
            for (int m = 0; m < 4; ++m) pre[ai * 4 + m] = rowstat ? rowstat[row0 + ai * pg8::HALF + m * 16] : 1.f;
    }
    template <int MODE>
    __device__ __forceinline__ void run(pg8::f32x4 (&acc)[2][2][4][2], const pg8::Unit& u, int wr, int wc, int fr, int fq, const float (&pre)[8], float sc) const {
        using namespace pg8;
        const int row0 = u.pm * BM + wr * 64 + fr; const int col0 = u.pn * BM + wc * 32 + 8 * fq;
#pragma unroll
        for (int ai = 0; ai < 2; ++ai)
#pragma unroll
            for (int m = 0; m < 4; ++m) { bf16* rowp = O + (size_t)(row0 + ai * HALF + m * 16) * ldc + col0;
                float rs = 0.f, rq = 0.f; const float ps = pre[ai * 4 + m] * sc;
#pragma unroll
                for (int bj = 0; bj < 2; ++bj) { pg8::f32x4 v0 = acc[ai][bj][m][0] * ps, v1 = acc[ai][bj][m][1] * ps;
                    if (MODE == 1) { f32x2 a = gelu_pk((f32x2){v0[0], v0[1]}), b = gelu_pk((f32x2){v0[2], v0[3]}), c = gelu_pk((f32x2){v1[0], v1[1]}), d = gelu_pk((f32x2){v1[2], v1[3]});
                        v0 = (pg8::f32x4){a.x, a.y, b.x, b.y}; v1 = (pg8::f32x4){c.x, c.y, d.x, d.y};
                        rs += ((v0[0] + v0[1]) + (v0[2] + v0[3])) + ((v1[0] + v1[1]) + (v1[2] + v1[3]));
                        rq += ((v0[0] * v0[0] + v0[1] * v0[1]) + (v0[2] * v0[2] + v0[3] * v0[3])) + ((v1[0] * v1[0] + v1[1] * v1[1]) + (v1[2] * v1[2] + v1[3] * v1[3])); }
                    else if (MODE == 2) {
#pragma unroll
                        for (int e = 0; e < 4; ++e) { const float a = fmaxf(v0[e], 0.f), b = fmaxf(v1[e], 0.f); v0[e] = a * a; v1[e] = b * b; } }
                    pg8::u32x4 w; w.x = cvtpk(v0[0], v0[1]); w.y = cvtpk(v0[2], v0[3]); w.z = cvtpk(v1[0], v1[1]); w.w = cvtpk(v1[2], v1[3]);
                    *(pg8::u32x4*)(rowp + bj * HALF) = w; }
                if (MODE == 1) { rs += __shfl_xor(rs, 16); rs += __shfl_xor(rs, 32); rq += __shfl_xor(rq, 16); rq += __shfl_xor(rq, 32);
                    if (fq == 0) *(f32x2*)(stat + ((size_t)(row0 + ai * HALF + m * 16) * 32 + (u.pn - 8) * 4 + wc) * 2) = (f32x2){rs, rq}; } }
    }
    __device__ __forceinline__ void operator()(pg8::f32x4 (&acc)[2][2][4][2], const pg8::Unit& u, int wr, int wc, int fr, int fq, const float (&pre)[8]) const {
        asm volatile("" : "+v"(fr), "+v"(fq));
        const float sc = (act == 3 && u.pn * pg8::BM < 1024) ? 0.125f : 1.f;
        if (act == 2) run<2>(acc, u, wr, wc, fr, fq, pre, 1.f);
        else if (act == 1 && u.pn >= 8) run<1>(acc, u, wr, wc, fr, fq, pre, 1.f);
        else run<0>(acc, u, wr, wc, fr, fq, pre, sc);
    }
};

constexpr int LDS_P = 131072 + 2048, LDS_S = LDS_P + 4096, LDS_G = LDS_S + 1024;
struct EpiRes {
    static constexpr bool PERM = true, AFTER_DRAIN = false;
    bf16* XB; float* outf; float* xch; float* xch2; unsigned* cnt; unsigned* cnt2; float* rs; LAS unsigned char* lds;
    __device__ __forceinline__ void prefetch(float (&)[8], const pg8::Unit&, int, int) const {}
    __device__ __forceinline__ void wait32(unsigned* c) const {
        unsigned sp = 0u;
        while ((unsigned)__builtin_amdgcn_readfirstlane(__hip_atomic_load(c, __ATOMIC_RELAXED, __HIP_MEMORY_SCOPE_AGENT)) < 32u) { __builtin_amdgcn_s_sleep(1); if (++sp > (1u << 22)) break; }
        __builtin_amdgcn_fence(__ATOMIC_ACQUIRE, "agent");
    }
    __device__ __forceinline__ void operator()(pg8::f32x4 (&acc)[2][2][4][2], const pg8::Unit& u, int wr, int wc, int fr, int fq, const float (&)[8]) const {
        using namespace pg8;
        asm volatile("" : "+v"(fr), "+v"(fq));
        const int lane = fq * 16 + fr, wid = wr * 4 + wc;
        LAS float* P = (LAS float*)(lds + LDS_P); LAS float* S = (LAS float*)(lds + LDS_S); LAS float* Gs = (LAS float*)(lds + LDS_G);
        const int col0 = u.pn * BM + wc * 32 + 8 * fq;
#pragma unroll
        for (int ai = 0; ai < 2; ++ai)
#pragma unroll
            for (int m = 0; m < 4; ++m) { float q = 0.f;
#pragma unroll
                for (int bj = 0; bj < 2; ++bj)
#pragma unroll
                    for (int n = 0; n < 2; ++n) { const pg8::f32x4 v = acc[ai][bj][m][n]; q += (v[0] * v[0] + v[1] * v[1]) + (v[2] * v[2] + v[3] * v[3]); }
                q += __shfl_xor(q, 16); q += __shfl_xor(q, 32);
                if (fq == 0) P[(ai * HALF + wr * 64 + m * 16 + fr) * 4 + wc] = q; }
        asm volatile("s_waitcnt lgkmcnt(0)" ::: "memory"); __builtin_amdgcn_s_barrier(); asm volatile("" ::: "memory");
        const int row = wid * 32 + (lane & 31);
        if (lane < 32) { const pg8::f32x4 pp = *(LAS pg8::f32x4*)(P + row * 4);
            __hip_atomic_store(xch + ((size_t)(u.pm * BM + row) * 4 + u.pn), (pp[0] + pp[1]) + (pp[2] + pp[3]), __ATOMIC_RELAXED, __HIP_MEMORY_SCOPE_AGENT); }
        asm volatile("" ::: "memory");
        pg8::u32x4 xpre0[4][2], xpre1[4][2];
#pragma unroll
        for (int m = 0; m < 4; ++m)
#pragma unroll
            for (int bj = 0; bj < 2; ++bj) xpre0[m][bj] = *(const pg8::u32x4*)(XB + (size_t)(u.pm * BM + wr * 64 + m * 16 + fr) * 1024 + col0 + bj * HALF);
        asm volatile("" ::: "memory");
        asm volatile("s_waitcnt vmcnt(8)" ::: "memory");
        if (lane == 0) __hip_atomic_fetch_add(cnt + 64 * u.pm, 1u, __ATOMIC_RELAXED, __HIP_MEMORY_SCOPE_AGENT);
        if (wid == 0) wait32(cnt + 64 * u.pm);
        asm volatile("s_waitcnt vmcnt(0) lgkmcnt(0)" ::: "memory"); __builtin_amdgcn_s_barrier(); asm volatile("" ::: "memory");
        if (lane < 32) { const float* sl = xch + (size_t)(u.pm * BM + row) * 4; float t = 0.f;
#pragma unroll
            for (int k = 0; k < 4; ++k) t += __hip_atomic_load(sl + k, __ATOMIC_RELAXED, __HIP_MEMORY_SCOPE_AGENT);
            S[row] = 1.0f / sqrtf(t * (1.f / 1024.f) + 1e-6f); }
        asm volatile("s_waitcnt lgkmcnt(0)" ::: "memory"); __builtin_amdgcn_s_barrier(); asm volatile("" ::: "memory");
        pg8::f32x4 gp[2][2];
#pragma unroll
        for (int bj = 0; bj < 2; ++bj) { gp[bj][0] = *(LAS pg8::f32x4*)(Gs + col0 + bj * HALF); gp[bj][1] = *(LAS pg8::f32x4*)(Gs + col0 + bj * HALF + 4); }
#pragma unroll
        for (int ai = 0; ai < 2; ++ai) {
#pragma unroll
            for (int m = 0; m < 4; ++m) { const int r = ai * HALF + wr * 64 + m * 16 + fr; const float rsm = S[r]; const size_t off = (size_t)(u.pm * BM + r) * 1024 + col0; float q2 = 0.f;
#pragma unroll
                for (int bj = 0; bj < 2; ++bj) { const pg8::u32x4 xw = ai == 0 ? xpre0[m][bj] : xpre1[m][bj];
                    pg8::f32x4 x0 = {__uint_as_float(xw.x << 16), __uint_as_float(xw.x & 0xffff0000u), __uint_as_float(xw.y << 16), __uint_as_float(xw.y & 0xffff0000u)};
                    pg8::f32x4 x1 = {__uint_as_float(xw.z << 16), __uint_as_float(xw.z & 0xffff0000u), __uint_as_float(xw.w << 16), __uint_as_float(xw.w & 0xffff0000u)};
                    x0 = x0 + acc[ai][bj][m][0] * rsm * gp[bj][0]; x1 = x1 + acc[ai][bj][m][1] * rsm * gp[bj][1];
                    q2 += ((x0[0] * x0[0] + x0[1] * x0[1]) + (x0[2] * x0[2] + x0[3] * x0[3])) + ((x1[0] * x1[0] + x1[1] * x1[1]) + (x1[2] * x1[2] + x1[3] * x1[3]));
                    acc[ai][bj][m][0] = x0; acc[ai][bj][m][1] = x1; }
                if (ai == 0) {
#pragma unroll
                    for (int bj = 0; bj < 2; ++bj) xpre1[m][bj] = *(const pg8::u32x4*)(XB + (size_t)(u.pm * BM + HALF + wr * 64 + m * 16 + fr) * 1024 + col0 + bj * HALF);
                    asm volatile("" ::: "memory"); }
                q2 += __shfl_xor(q2, 16); q2 += __shfl_xor(q2, 32);
                if (fq == 0) P[r * 4 + wc] = q2; }
            asm volatile("" ::: "memory"); }
        asm volatile("s_waitcnt lgkmcnt(0)" ::: "memory"); __builtin_amdgcn_s_barrier(); asm volatile("" ::: "memory");
        if (lane < 32) { const pg8::f32x4 pp = *(LAS pg8::f32x4*)(P + row * 4);
            __hip_atomic_store(xch2 + ((size_t)(u.pm * BM + row) * 4 + u.pn), (pp[0] + pp[1]) + (pp[2] + pp[3]), __ATOMIC_RELAXED, __HIP_MEMORY_SCOPE_AGENT); }
        asm volatile("s_waitcnt vmcnt(0)" ::: "memory");
        if (lane == 0) __hip_atomic_fetch_add(cnt2 + 64 * u.pm, 1u, __ATOMIC_RELAXED, __HIP_MEMORY_SCOPE_AGENT);
#pragma unroll
        for (int ai = 0; ai < 2; ++ai)
#pragma unroll
            for (int m = 0; m < 4; ++m) { const size_t off = (size_t)(u.pm * BM + ai * HALF + wr * 64 + m * 16 + fr) * 1024 + col0;
#pragma unroll
                for (int bj = 0; bj < 2; ++bj) { const pg8::f32x4 x0 = acc[ai][bj][m][0], x1 = acc[ai][bj][m][1];
                    if (outf) { *(pg8::f32x4*)(outf + off + bj * HALF) = x0; *(pg8::f32x4*)(outf + off + bj * HALF + 4) = x1; }
                    else { pg8::u32x4 w; w.x = cvtpk(x0[0], x0[1]); w.y = cvtpk(x0[2], x0[3]); w.z = cvtpk(x1[0], x1[1]); w.w = cvtpk(x1[2], x1[3]); *(pg8::u32x4*)(XB + off + bj * HALF) = w; } } }
        if (u.pn == (u.pm & 3)) {
            if (wid == 0) wait32(cnt2 + 64 * u.pm);
            asm volatile("s_waitcnt vmcnt(0) lgkmcnt(0)" ::: "memory"); __builtin_amdgcn_s_barrier(); asm volatile("" ::: "memory");
            if (lane < 32) { const float* sl = xch2 + (size_t)(u.pm * BM + row) * 4; float t = 0.f;
#pragma unroll
                for (int k = 0; k < 4; ++k) t += __hip_atomic_load(sl + k, __ATOMIC_RELAXED, __HIP_MEMORY_SCOPE_AGENT);
                rs[u.pm * BM + row] = 1.0f / sqrtf(t * (1.f / 1024.f) + 1e-6f); }
        }
    }
};

__device__ __forceinline__ void transpose_item(const float* W, const float* gk, int K, int N, bf16* WT, LAS float* scr, int item, int lane) {
    const int nblk = N / 32, kb = item / nblk, nb = item % nblk, k0 = 64 * kb, n0 = 32 * nb;
#pragma unroll
    for (int i = 0; i < 32; ++i) { const int kk = 2 * i + (lane >> 5); scr[kk * 33 + (lane & 31)] = W[(size_t)(k0 + kk) * N + n0 + (lane & 31)]; }
    const int c = lane & 7;
    f32x4 ga = {1.f, 1.f, 1.f, 1.f}, gb = ga;
    if (gk) { ga = *(const f32x4*)(gk + k0 + 8 * c); gb = *(const f32x4*)(gk + k0 + 8 * c + 4); }
    asm volatile("s_waitcnt lgkmcnt(0)" ::: "memory");
#pragma unroll
    for (int j = 0; j < 4; ++j) { const int n = (lane >> 3) + 8 * j; const LAS float* s = scr + (8 * c) * 33 + n;
        u32x4 o; o.x = cvtpk(s[0 * 33] * ga.x, s[1 * 33] * ga.y); o.y = cvtpk(s[2 * 33] * ga.z, s[3 * 33] * ga.w); o.z = cvtpk(s[4 * 33] * gb.x, s[5 * 33] * gb.y); o.w = cvtpk(s[6 * 33] * gb.z, s[7 * 33] * gb.w);
        *(u32x4*)(WT + (size_t)(n0 + n) * K + k0 + 8 * c) = o; }
    asm volatile("s_waitcnt lgkmcnt(0)" ::: "memory");
}
__device__ __forceinline__ void transpose_matrix(const float* W, const float* gk, int K, int N, bf16* WT, LAS float* scr, int gw, int ngw, int lane) {
    const int items = (K / 64) * (N / 32);
    for (int it = gw; it < items; it += ngw) transpose_item(W, gk, K, N, WT, scr, it, lane);
}

__device__ __forceinline__ void tr_load(float (&r)[32], const float* W, int N, int item, int lane) {
    const int nblk = N / 32, kb = item / nblk, nb = item % nblk, k0 = 64 * kb, n0 = 32 * nb;
#pragma unroll
    for (int i = 0; i < 32; ++i) { const int kk = 2 * i + (lane >> 5); r[i] = W[(size_t)(k0 + kk) * N + n0 + (lane & 31)]; }
}
__device__ __forceinline__ void tr_finish(const float (&r)[32], const float* gk, int K, int N, bf16* WT, LAS float* scr, int item, int lane) {
    const int nblk = N / 32, kb = item / nblk, nb = item % nblk, k0 = 64 * kb, n0 = 32 * nb;
#pragma unroll
    for (int i = 0; i < 32; ++i) { const int kk = 2 * i + (lane >> 5); scr[kk * 33 + (lane & 31)] = r[i]; }
    const int c = lane & 7;
    f32x4 ga = {1.f, 1.f, 1.f, 1.f}, gb = ga;
    if (gk) { ga = *(const f32x4*)(gk + k0 + 8 * c); gb = *(const f32x4*)(gk + k0 + 8 * c + 4); }
    asm volatile("s_waitcnt lgkmcnt(0)" ::: "memory");
#pragma unroll
    for (int j = 0; j < 4; ++j) { const int n = (lane >> 3) + 8 * j; const LAS float* s = scr + (8 * c) * 33 + n;
        u32x4 o; o.x = cvtpk(s[0 * 33] * ga.x, s[1 * 33] * ga.y); o.y = cvtpk(s[2 * 33] * ga.z, s[3 * 33] * ga.w); o.z = cvtpk(s[4 * 33] * gb.x, s[5 * 33] * gb.y); o.w = cvtpk(s[6 * 33] * gb.z, s[7 * 33] * gb.w);
        *(u32x4*)(WT + (size_t)(n0 + n) * K + k0 + 8 * c) = o; }
    asm volatile("s_waitcnt lgkmcnt(0)" ::: "memory");
}

__device__ __forceinline__ void x_to_bf16(const float* xin, bf16* xb, float* xstat, int wave, int lane) {
    const int gw = blockIdx.x * NWAVES + wave, ngw = gridDim.x * NWAVES;
    for (int m0 = gw * 4; m0 < MTOK; m0 += ngw * 4) {
        f32x4 v[4][4];
#pragma unroll
        for (int r = 0; r < 4; ++r) { const f32x4* xr = (const f32x4*)(xin + (size_t)(m0 + r) * D_MODEL) + lane;
#pragma unroll
            for (int j = 0; j < 4; ++j) v[r][j] = xr[64 * j]; }
#pragma unroll
        for (int r = 0; r < 4; ++r) { float ss = 0.f;
#pragma unroll
            for (int j = 0; j < 4; ++j) ss += (v[r][j].x * v[r][j].x + v[r][j].y * v[r][j].y) + (v[r][j].z * v[r][j].z + v[r][j].w * v[r][j].w);
            ss = wave_sum(ss);
            u32x2* ho = (u32x2*)(xb + (size_t)(m0 + r) * D_MODEL) + lane;
#pragma unroll
            for (int j = 0; j < 4; ++j) { u32x2 w; w.x = cvtpk(v[r][j].x, v[r][j].y); w.y = cvtpk(v[r][j].z, v[r][j].w); ho[64 * j] = w; }
            if (lane == 0) xstat[m0 + r] = 1.0f / sqrtf(ss * (1.f / D_MODEL) + EPS); }
    }
}

__device__ __forceinline__ void row_pass(bf16* xb, const bf16* mo, const float* gpost, float* outf, float* xstat, int wave, int lane) {
    const int gw = blockIdx.x * NWAVES + wave, ngw = gridDim.x * NWAVES;
    f32x4 gp[4];
#pragma unroll
    for (int j = 0; j < 4; ++j) gp[j] = *((const f32x4*)gpost + lane + 64 * j);
    for (int m0 = gw * 4; m0 < MTOK; m0 += ngw * 4) {
        u32x2 xw[4][4], mw[4][4];
#pragma unroll
        for (int r = 0; r < 4; ++r) { const u32x2* xr = (const u32x2*)(xb + (size_t)(m0 + r) * D_MODEL) + lane; const u32x2* mr = (const u32x2*)(mo + (size_t)(m0 + r) * D_MODEL) + lane;
#pragma unroll
            for (int j = 0; j < 4; ++j) { xw[r][j] = xr[64 * j]; mw[r][j] = mr[64 * j]; } }
#pragma unroll
        for (int r = 0; r < 4; ++r) {
            const int m = m0 + r;
            f32x4 mv[4], v[4]; float ss = 0.f;
#pragma unroll
            for (int j = 0; j < 4; ++j) { mv[j] = (f32x4){bflo(mw[r][j].x), bfhi(mw[r][j].x), bflo(mw[r][j].y), bfhi(mw[r][j].y)}; v[j] = (f32x4){bflo(xw[r][j].x), bfhi(xw[r][j].x), bflo(xw[r][j].y), bfhi(xw[r][j].y)};
                ss += (mv[j].x * mv[j].x + mv[j].y * mv[j].y) + (mv[j].z * mv[j].z + mv[j].w * mv[j].w); }
            const float rstd = 1.0f / sqrtf(wave_sum(ss) * (1.f / D_MODEL) + EPS);
            float s2 = 0.f;
#pragma unroll
            for (int j = 0; j < 4; ++j) { v[j] = v[j] + mv[j] * rstd * gp[j]; s2 += (v[j].x * v[j].x + v[j].y * v[j].y) + (v[j].z * v[j].z + v[j].w * v[j].w); }
            s2 = wave_sum(s2);
            if (outf) { f32x4* xo = (f32x4*)(outf + (size_t)m * D_MODEL) + lane;
#pragma unroll
                for (int j = 0; j < 4; ++j) xo[64 * j] = v[j]; }
            else { u32x2* ho = (u32x2*)(xb + (size_t)m * D_MODEL) + lane;
#pragma unroll
                for (int j = 0; j < 4; ++j) { u32x2 w; w.x = cvtpk(v[j].x, v[j].y); w.y = cvtpk(v[j].z, v[j].w); ho[64 * j] = w; }
                if (lane == 0) xstat[m] = 1.0f / sqrtf(s2 * (1.f / D_MODEL) + EPS); }
        }
    }
}

__device__ __forceinline__ void mix_phase(bf16* Z, bf16* Gout, int ldg, const float* stat, const float* vg, const float* vbias, const bf16* Wc, const float* bs, LAS unsigned char* lds, int tid, int wave, int lane) {
    constexpr int LD = 4096, PITCH = 576, WPITCH = 272, OFF_W = 128 * PITCH, OFF_ST = OFF_W + 128 * WPITCH;
    LAS float* st = (LAS float*)(lds + OFF_ST);
    const int nper = gridDim.x >> 3, g = blockIdx.x & 7, ci = blockIdx.x >> 3;
    if (nper == 0 || ci >= nper) return;
    const int r32 = lane & 31, hi = lane >> 5;
    const int troff = (8 * hi + ((lane & 15) >> 2)) * PITCH + (32 * wave + 16 * ((lane >> 4) & 1) + 4 * (lane & 3)) * 2;
#pragma unroll
    for (int it = 0; it < 4; ++it) { const int idx = it * 512 + tid, row = idx >> 4, ch = idx & 15;
        *(LAS u32x4*)(lds + OFF_W + row * WPITCH + ch * 16) = *(const u32x4*)(Wc + ((size_t)g * 128 + row) * 128 + ch * 8); }
    const int vrow = tid >> 5, vch = tid & 31;
    const f32x4 g0 = *(const f32x4*)(vg + g * 256 + vch * 8), g1 = *(const f32x4*)(vg + g * 256 + vch * 8 + 4);
    const f32x4 b0 = *(const f32x4*)(vbias + g * 256 + vch * 8), b1 = *(const f32x4*)(vbias + g * 256 + vch * 8 + 4);
    const int srow = tid >> 2, sq = tid & 3;
    float bsr[4];
#pragma unroll
    for (int tb = 0; tb < 4; ++tb) bsr[tb] = bs[g * 128 + tb * 32 + r32];
    u32x4 rawv[8]; f32x4 stp[4];
    { const size_t row0 = (size_t)ci * 128;
#pragma unroll
      for (int it = 0; it < 8; ++it) rawv[it] = *(const u32x4*)(Z + (row0 + it * 16 + vrow) * LD + 2048 + g * 256 + vch * 8);
#pragma unroll
      for (int k = 0; k < 4; ++k) stp[k] = *(const f32x4*)(stat + ((row0 + srow) * 32 + sq * 8 + k * 2) * 2); }
    for (int chunk = ci; chunk < MTOK / 128; chunk += nper) {
        const size_t row0 = (size_t)chunk * 128;
        bf16* up = Z + (row0 + r32) * LD + g * 256 + 32 * wave + 8 * hi;
        bf16* gp = Gout + (row0 + r32) * ldg + g * 256 + 32 * wave + 8 * hi;
        u32x4 ul[4][2];
#pragma unroll
        for (int tb = 0; tb < 4; ++tb)
#pragma unroll
            for (int j = 0; j < 2; ++j) ul[tb][j] = *(const u32x4*)(up + (size_t)tb * 32 * LD + 16 * j);
        { float s = (stp[0].x + stp[0].z) + (stp[1].x + stp[1].z) + (stp[2].x + stp[2].z) + (stp[3].x + stp[3].z);
          float q = (stp[0].y + stp[0].w) + (stp[1].y + stp[1].w) + (stp[2].y + stp[2].w) + (stp[3].y + stp[3].w);
          s += __shfl_xor(s, 1); s += __shfl_xor(s, 2); q += __shfl_xor(q, 1); q += __shfl_xor(q, 2);
          const float mean = s * (1.f / 2048.f), var = fmaxf(q * (1.f / 2048.f) - mean * mean, 0.f);
          if (sq == 0) { st[2 * srow] = mean; st[2 * srow + 1] = 1.0f / sqrtf(var + EPS); } }
        __syncthreads();
#pragma unroll
        for (int it = 0; it < 8; ++it) {
            const int row = it * 16 + vrow; const u32x4 w = rawv[it];
            const float mean = st[2 * row], rstd = st[2 * row + 1];
            u32x4 o;
            o.x = cvtpk((bflo(w.x) - mean) * rstd * g0.x + b0.x, (bfhi(w.x) - mean) * rstd * g0.y + b0.y);
            o.y = cvtpk((bflo(w.y) - mean) * rstd * g0.z + b0.z, (bfhi(w.y) - mean) * rstd * g0.w + b0.w);
            o.z = cvtpk((bflo(w.z) - mean) * rstd * g1.x + b1.x, (bfhi(w.z) - mean) * rstd * g1.y + b1.y);
            o.w = cvtpk((bflo(w.w) - mean) * rstd * g1.z + b1.z, (bfhi(w.w) - mean) * rstd * g1.w + b1.w);
            *(LAS u32x4*)(lds + row * PITCH + vch * 16) = o;
        }
        __syncthreads();
        if (chunk + nper < MTOK / 128) { const size_t nrow0 = (size_t)(chunk + nper) * 128;
#pragma unroll
            for (int it = 0; it < 8; ++it) rawv[it] = *(const u32x4*)(Z + (nrow0 + it * 16 + vrow) * LD + 2048 + g * 256 + vch * 8);
#pragma unroll
            for (int k = 0; k < 4; ++k) stp[k] = *(const f32x4*)(stat + ((nrow0 + srow) * 32 + sq * 8 + k * 2) * 2); }
        bf16x8 af[8];
#pragma unroll
        for (int ks = 0; ks < 8; ++ks) { const v4i16_t lo = tr_read(lds + troff + (16 * ks) * PITCH), h4 = tr_read(lds + troff + (16 * ks + 4) * PITCH);
            af[ks] = (bf16x8){lo[0], lo[1], lo[2], lo[3], h4[0], h4[1], h4[2], h4[3]}; }
#pragma unroll
        for (int tb = 0; tb < 4; ++tb) {
            f32x16 acc = {};
            LAS unsigned char* wp = lds + OFF_W + (tb * 32 + r32) * WPITCH + 16 * hi;
#pragma unroll
            for (int ks = 0; ks < 2 * (tb + 1); ++ks) { const bf16x8 bfrag = *(LAS bf16x8*)(wp + 32 * ks); acc = __builtin_amdgcn_mfma_f32_32x32x16_bf16(af[ks], bfrag, acc, 0, 0, 0); }
            const float bsv = bsr[tb];
#pragma unroll
            for (int j = 0; j < 2; ++j) {
                const u32x4 L = ul[tb][j];
                const auto s0 = __builtin_amdgcn_permlane32_swap(L.x, L.z, false, false), s1 = __builtin_amdgcn_permlane32_swap(L.y, L.w, false, false);
                u32x2 ow[2];
#pragma unroll
                for (int e = 0; e < 2; ++e) { const int g4 = 2 * j + e; const unsigned w0 = s0[e], w1 = s1[e];
                    const pg8::f32x2 ua = pg8::gelu_pk((pg8::f32x2){bflo(w0), bfhi(w0)}), ub = pg8::gelu_pk((pg8::f32x2){bflo(w1), bfhi(w1)});
                    ow[e].x = cvtpk(ua.x * (acc[4 * g4] + bsv), ua.y * (acc[4 * g4 + 1] + bsv));
                    ow[e].y = cvtpk(ub.x * (acc[4 * g4 + 2] + bsv), ub.y * (acc[4 * g4 + 3] + bsv)); }
                const auto t0 = __builtin_amdgcn_permlane32_swap(ow[0].x, ow[1].x, false, false), t1 = __builtin_amdgcn_permlane32_swap(ow[0].y, ow[1].y, false, false);
                u32x4 o; o.x = t0[0]; o.y = t1[0]; o.z = t0[1]; o.w = t1[1];
                *(u32x4*)(gp + (size_t)tb * 32 * ldg + 16 * j) = o; }
        }
        __syncthreads();
    }
}

template <bool DIAG>
__device__ __forceinline__ void attn_tile(f32x16& o0, f32x16& o1, float& carry2, const bf16x8 (&qr)[4], bf16x8 (&kf)[4], u32x4 (&vr)[4], const bf16* kpn, const bf16* vpn, bool has_next,
                                          LAS unsigned char* vcur, LAS unsigned char* vnxt, int troff, int strow, int stch, int r32, int hi) {
    constexpr int LD = NQKV; constexpr float LOG2E = 1.4426950408889634f;
    f32x16 p = {};
#pragma unroll
    for (int s = 0; s < 4; ++s) p = __builtin_amdgcn_mfma_f32_32x32x16_bf16(kf[s], qr[s], p, 0, 0, 0);
    (void)has_next;
#pragma unroll
    for (int s = 0; s < 4; ++s) { kf[s] = *(const bf16x8*)(kpn + 16 * s); vr[s] = *(const u32x4*)(vpn + (size_t)s * 8 * LD); }
    float kp[16], be[16];
#pragma unroll
    for (int r = 0; r < 16; ++r) { const float z = __builtin_amdgcn_fmed3f(p[r], -80.f, 3.0e38f);
        const float t = __builtin_amdgcn_exp2f(z * -LOG2E); be[r] = __builtin_amdgcn_rcpf(1.f + t); kp[r] = t * be[r];
        if (DIAG) { const bool msk = crow(r, hi) >= r32; kp[r] = msk ? 1.f : kp[r]; be[r] = msk ? 0.f : be[r]; } }
    float se[16], G[4], oth[4], T[4];
#pragma unroll
    for (int g = 0; g < 4; ++g) { se[4 * g + 3] = 1.f; se[4 * g + 2] = kp[4 * g + 3]; se[4 * g + 1] = se[4 * g + 2] * kp[4 * g + 2]; se[4 * g] = se[4 * g + 1] * kp[4 * g + 1]; G[g] = se[4 * g] * kp[4 * g]; }
#pragma unroll
    for (int g = 0; g < 4; ++g) {
        const auto rr = __builtin_amdgcn_permlane32_swap(__float_as_uint(G[g]), __float_as_uint(G[g]), false, false);
        oth[g] = __uint_as_float(rr[1]); T[g] = __uint_as_float(rr[0]) * __uint_as_float(rr[1]); }
    const float C = __builtin_amdgcn_exp2f(carry2);
    float base[4]; const float a2 = T[3], a1 = T[3] * T[2], a0 = a1 * T[1];
    base[3] = C; base[2] = C * a2; base[1] = C * a1; base[0] = C * a0;
    if (hi == 0) {
#pragma unroll
        for (int g = 0; g < 4; ++g) base[g] *= oth[g]; }
    carry2 += __builtin_amdgcn_logf(a0 * T[0]);
    float a[16];
#pragma unroll
    for (int r = 0; r < 16; ++r) a[r] = be[r] * (se[r] * base[r >> 2]);
    u32x4 pw0, pw1;
    pw0.x = cvtpk(a[0], a[1]); pw0.y = cvtpk(a[2], a[3]); pw0.z = cvtpk(a[4], a[5]); pw0.w = cvtpk(a[6], a[7]);
    pw1.x = cvtpk(a[8], a[9]); pw1.y = cvtpk(a[10], a[11]); pw1.z = cvtpk(a[12], a[13]); pw1.w = cvtpk(a[14], a[15]);
    const bf16x8 pf0 = __builtin_bit_cast(bf16x8, pw0), pf1 = __builtin_bit_cast(bf16x8, pw1);
    asm volatile("" ::: "memory");
#pragma unroll
    for (int dh = 0; dh < 2; ++dh)
#pragma unroll
        for (int s = 0; s < 2; ++s) {
            const v4i16_t lo = tr_read(vcur + troff + (16 * s) * 192 + dh * 64), h4 = tr_read(vcur + troff + (16 * s + 8) * 192 + dh * 64);
            const bf16x8 vf = (bf16x8){lo[0], lo[1], lo[2], lo[3], h4[0], h4[1], h4[2], h4[3]};
            if (dh == 0) o0 = __builtin_amdgcn_mfma_f32_32x32x16_bf16(vf, s == 0 ? pf0 : pf1, o0, 0, 0, 0);
            else o1 = __builtin_amdgcn_mfma_f32_32x32x16_bf16(vf, s == 0 ? pf0 : pf1, o1, 0, 0, 0);
        }
    asm volatile("" ::: "memory");
#pragma unroll
    for (int it = 0; it < 4; ++it) *(LAS u32x4*)(vnxt + (it * 8 + strow) * 192 + stch * 16) = vr[it];
    asm volatile("" ::: "memory");
}
__device__ __forceinline__ void attn_phase(bf16* QKV, bf16* Oout, int ldo, LAS unsigned char* lds, int wave, int lane) {
    constexpr int LD = NQKV;
    const int r32 = lane & 31, hi = lane >> 5;
    LAS unsigned char* vb = lds + wave * 12288;
    const int vcu = (gridDim.x % 8 == 0) ? (int)((blockIdx.x & 7) * (gridDim.x >> 3) + (blockIdx.x >> 3)) : (int)blockIdx.x;
    const int gw = vcu * NWAVES + wave, ngw = gridDim.x * NWAVES;
    const int troff = (4 * hi + ((lane & 15) >> 2)) * 192 + (16 * ((lane >> 4) & 1) + 4 * (lane & 3)) * 2;
    const int strow = lane >> 3, stch = lane & 7;
#define ATT_UNIT(unit_) const int bh = (unit_) >> 6, qb = ((unit_) + 8 * (bh >> 5)) & 63, h = bh & 15, b = bh >> 4;     \
        const size_t rowbase = (size_t)b * SEQ; \
        const bf16* qp = QKV + (rowbase + qb * 32 + r32) * LD + h * 64; \
        const bf16* kbase = QKV + (rowbase + r32) * LD + 1024 + h * 64 + 8 * hi; \
        const bf16* vbase = QKV + (rowbase + strow) * LD + 2048 + h * 64 + stch * 8;
#define ATT_LOAD(Q_) do { const bf16* kp = kbase + (size_t)qb * 32 * LD; const bf16* vp = vbase + (size_t)qb * 32 * LD; \
        _Pragma("unroll") for (int s = 0; s < 4; ++s) Q_[s] = *(const bf16x8*)(qp + 16 * s + 8 * hi); \
        _Pragma("unroll") for (int s = 0; s < 4; ++s) { kf[s] = *(const bf16x8*)(kp + 16 * s); vr[s] = *(const u32x4*)(vp + (size_t)s * 8 * LD); } } while (0)
    const int nunits = BATCH * 16 * 64;
    bf16x8 qr[4], kf[4]; u32x4 vr[4];
    if (gw < nunits) { ATT_UNIT(gw) ATT_LOAD(qr); }
    for (int unit = gw; unit < nunits; unit += ngw) {
        ATT_UNIT(unit)
        f32x16 o0 = {}, o1 = {};
        float carry2 = 0.f;
#pragma unroll
        for (int it = 0; it < 4; ++it) *(LAS u32x4*)(vb + (it * 8 + strow) * 192 + stch * 16) = vr[it];
        asm volatile("" ::: "memory");
        attn_tile<true>(o0, o1, carry2, qr, kf, vr, kbase + (size_t)(qb > 0 ? qb - 1 : 0) * 32 * LD, vbase + (size_t)(qb > 0 ? qb - 1 : 0) * 32 * LD, qb > 0, vb, vb + 6144, troff, strow, stch, r32, hi);
        int buf = 1;
        for (int kt = qb - 1; kt >= 0; --kt) {
            if (__all(carry2 <= -150.f)) break;
            attn_tile<false>(o0, o1, carry2, qr, kf, vr, kbase + (size_t)(kt > 0 ? kt - 1 : 0) * 32 * LD, vbase + (size_t)(kt > 0 ? kt - 1 : 0) * 32 * LD, kt > 0, vb + buf * 6144, vb + (buf ^ 1) * 6144, troff, strow, stch, r32, hi);
            buf ^= 1;
        }
        if (unit + ngw < nunits) { const int nu = unit + ngw; { ATT_UNIT(nu) ATT_LOAD(qr); } }
        bf16* op = Oout + (rowbase + qb * 32 + r32) * ldo + h * 64;
#pragma unroll
        for (int g = 0; g < 4; ++g) {
            u32x2 w0, w1;
            w0.x = cvtpk(o0[4 * g], o0[4 * g + 1]); w0.y = cvtpk(o0[4 * g + 2], o0[4 * g + 3]);
            w1.x = cvtpk(o1[4 * g], o1[4 * g + 1]); w1.y = cvtpk(o1[4 * g + 2], o1[4 * g + 3]);
            *(u32x2*)(op + 8 * g + 4 * hi) = w0; *(u32x2*)(op + 32 + 8 * g + 4 * hi) = w1;
        }
    }
#undef ATT_UNIT
#undef ATT_LOAD
}

#define XB_TMO      128
#define XB_XCNT(j)  (256  + 64 * (j))
#define XB_XSUB(j)  (1280 + 64 * (j))
#define XB_XGEN(j)  (2304 + 64 * (j))
#define XB_TOP      3328
#define XB_TOPGEN   3392
#define XCD_BAR_WORDS 3456
#define XB_SPIN_CAP (1u << 18)

__device__ __forceinline__ unsigned xb_ld(unsigned* p)              { return __hip_atomic_load(p, __ATOMIC_RELAXED, __HIP_MEMORY_SCOPE_AGENT); }
__device__ __forceinline__ unsigned xb_add(unsigned* p, unsigned v) { return __hip_atomic_fetch_add(p, v, __ATOMIC_RELAXED, __HIP_MEMORY_SCOPE_AGENT); }
__device__ __forceinline__ unsigned xb_xcc_id() { return (unsigned)__builtin_amdgcn_s_getreg((3 << 11) | 20) & 0xFu; }
#define XB_SPIN(cond, bar) do { unsigned _sp = 0; while (cond) { __builtin_amdgcn_s_sleep(1); \
    if ((++_sp & 255u) == 0u) { if (xb_ld(&(bar)[XB_TMO])) break; if (_sp > XB_SPIN_CAP) { atomicAdd(&(bar)[XB_TMO], 1u); break; } } } } while (0)

struct XcdBarrier {
    unsigned* bar; unsigned x;
    volatile LAS unsigned* st;
};

__device__ __forceinline__ XcdBarrier xcd_barrier_post(unsigned* bar, volatile LAS unsigned* st) {
    XcdBarrier b; b.bar = bar; b.x = xb_xcc_id(); b.st = st;
    if (threadIdx.x == 0) (void)xb_add(&bar[XB_XCNT(b.x)], 1u);
    return b;
}
__device__ __forceinline__ void xcd_barrier_complete(unsigned* bar, unsigned x, unsigned& nloc, unsigned& nx) {
    const unsigned G = gridDim.x * gridDim.y * gridDim.z;
    unsigned sum, cnt, mine, sp = 0u;
    for (;;) {
        sum = 0u; cnt = 0u; mine = 0u;
#pragma unroll
        for (unsigned j = 0; j < 16; ++j) { const unsigned c = xb_ld(&bar[XB_XCNT(j)]); sum += c; cnt += (c > 0u) ? 1u : 0u; mine = (j == x) ? c : mine; }
        if (sum == G) break;
        __builtin_amdgcn_s_sleep(1);
        if ((++sp & 255u) == 0u) { if (xb_ld(&bar[XB_TMO])) break; if (sp > XB_SPIN_CAP) { atomicAdd(&bar[XB_TMO], 1u); break; } }
    }
    nloc = mine > 0u ? mine : 1u; nx = cnt > 0u ? cnt : 1u;
}

__device__ __forceinline__ void xcd_barrier(const XcdBarrier& b) {
    asm volatile("s_waitcnt vmcnt(0)" ::: "memory");
    __syncthreads();
    if (threadIdx.x == 0) {
        unsigned* bar = b.bar;
        __builtin_amdgcn_s_waitcnt(0);
        unsigned nloc = b.st[0], nx = b.st[1];
        if (nloc == 0u) { xcd_barrier_complete(bar, b.x, nloc, nx); b.st[0] = nloc; b.st[1] = nx; }
        const unsigned old = xb_add(&bar[XB_XSUB(b.x)], 1u);
        const unsigned gen = old / nloc;
        if (old + 1u == (gen + 1u) * nloc) {
            __builtin_amdgcn_fence(__ATOMIC_RELEASE, "agent");
            asm volatile("s_waitcnt vmcnt(0)" ::: "memory");
            const unsigned og = xb_add(&bar[XB_TOP], 1u);
            const unsigned tg = og / nx;
            if (og + 1u == (tg + 1u) * nx) xb_add(&bar[XB_TOPGEN], 1u);
            else XB_SPIN(xb_ld(&bar[XB_TOPGEN]) == tg, bar);
            __builtin_amdgcn_fence(__ATOMIC_ACQUIRE, "agent");
            xb_add(&bar[XB_XGEN(b.x)], 1u);
            asm volatile("s_waitcnt vmcnt(0)" ::: "memory");
        } else {
            XB_SPIN(xb_ld(&bar[XB_XGEN(b.x)]) == gen, bar);
            __builtin_amdgcn_fence(__ATOMIC_ACQUIRE, "agent");
            asm volatile("s_waitcnt vmcnt(0)" ::: "memory");
        }
    }
    __syncthreads();
}

struct Params { const float* in[15]; float* out; unsigned char* ws; };

__global__ void __launch_bounds__(NWAVES * 64, 2) fwd_kernel(Params p) {
    extern __shared__ __attribute__((aligned(16))) unsigned char lds_raw[];
    cg::grid_group grid = cg::this_grid();
    LAS unsigned char* lds = (LAS unsigned char*)lds_raw;
    unsigned char* ws = p.ws;
    const float* x = p.in[0]; const float* n_mix_pre = p.in[1]; const float* n_mix_post = p.in[2]; const float* n_ffn_pre = p.in[3]; const float* n_ffn_post = p.in[4];
    const float* a_v_g = p.in[6]; const float* a_v_b = p.in[7]; const float* a_w_s = p.in[8]; const float* a_b_s = p.in[9];
    bf16* Win_t = (bf16*)(ws + WS_WIN); bf16* Wouta_t = (bf16*)(ws + WS_WOUTA); bf16* Wqkv_t = (bf16*)(ws + WS_WQKV); bf16* Wob_t = (bf16*)(ws + WS_WOB);
    bf16* W1_t = (bf16*)(ws + WS_W1); bf16* W2_t = (bf16*)(ws + WS_W2); bf16* Wc = (bf16*)(ws + WS_WC);
    bf16* XB = (bf16*)(ws + WS_HN); bf16* Z = (bf16*)(ws + WS_Z); float* STAT = (float*)(ws + WS_STAT);
    float* XCH = (float*)(ws + WS_XCH); float* XCH2 = (float*)(ws + WS_XCH2); float* XSTAT = (float*)(ws + WS_XSTAT); unsigned* CNT = (unsigned*)(ws + WS_CNT);
    float* out = p.out;
    unsigned* barw = (unsigned*)(ws + WS_BAR);
    volatile LAS unsigned* bst = (volatile LAS unsigned*)(lds + LDS_BST);
    if (threadIdx.x == 0) { bst[0] = 0u; bst[1] = 0u; }
    if (blockIdx.x == 0) for (int i = threadIdx.x; i < XCD_BAR_WORDS; i += NWAVES * 64) __hip_atomic_store(barw + i, 0u, __ATOMIC_RELAXED, __HIP_MEMORY_SCOPE_AGENT);
    __syncthreads();

    {
        const int tid = threadIdx.x, lane = tid & 63, wave = __builtin_amdgcn_readfirstlane(tid >> 6);
        const int gw = blockIdx.x * NWAVES + wave, ngw = gridDim.x * NWAVES;
        for (int i = blockIdx.x * 512 + tid; i < 16 * 256 * 64; i += gridDim.x * 512) __hip_atomic_store(CNT + i, 0u, __ATOMIC_RELAXED, __HIP_MEMORY_SCOPE_AGENT);
        LAS float* scr = (LAS float*)(lds + wave * 16384);
        if (ngw >= 2048) {
            float ra[32], rb[32];
#define TRM_W(m)  ((m) < 8 ? (((m) & 3) == 0 ? p.in[5] + (size_t)((m) >> 2) * 1024 * 4096 : ((m) & 3) == 1 ? p.in[10] + (size_t)((m) >> 2) * 2048 * 1024 : ((m) & 3) == 2 ? p.in[11] + (size_t)((m) >> 2) * 1024 * 3072 : p.in[12] + (size_t)((m) >> 2) * 1024 * 1024) \
                           : (m) < 12 ? p.in[13] + (size_t)((m) - 8) * 1024 * 4096 : p.in[14] + (size_t)((m) - 12) * 4096 * 1024)
#define TRM_K(m)  ((m) < 8 ? (((m) & 3) == 1 ? 2048 : 1024) : (m) < 12 ? 1024 : 4096)
#define TRM_N(m)  ((m) < 8 ? (((m) & 3) == 0 ? 4096 : ((m) & 3) == 1 ? 1024 : ((m) & 3) == 2 ? 3072 : 1024) : (m) < 12 ? 4096 : 1024)
#define TRM_G(m)  ((m) < 8 ? (((m) & 3) == 0 ? n_mix_pre + (2 * ((m) >> 2)) * 1024 : ((m) & 3) == 2 ? n_mix_pre + (2 * ((m) >> 2) + 1) * 1024 : (const float*)nullptr) : (m) < 12 ? n_ffn_pre + ((m) - 8) * 1024 : (const float*)nullptr)
#define TRM_T(m)  ((m) < 8 ? (((m) & 3) == 0 ? Win_t + (size_t)((m) >> 2) * 4096 * 1024 : ((m) & 3) == 1 ? Wouta_t + (size_t)((m) >> 2) * 1024 * 2048 : ((m) & 3) == 2 ? Wqkv_t + (size_t)((m) >> 2) * 3072 * 1024 : Wob_t + (size_t)((m) >> 2) * 1024 * 1024) \
                           : (m) < 12 ? W1_t + (size_t)((m) - 8) * 4096 * 1024 : W2_t + (size_t)((m) - 12) * 1024 * 4096)
#define TRM_HAS(m) (gw < (TRM_K(m) / 64) * (TRM_N(m) / 32))
            if (TRM_HAS(0)) tr_load(ra, TRM_W(0), TRM_N(0), gw, lane);
#pragma unroll
            for (int m = 0; m < 16; m += 2) {
                if (TRM_HAS(m + 1)) tr_load(rb, TRM_W(m + 1), TRM_N(m + 1), gw, lane);
                if (TRM_HAS(m)) tr_finish(ra, TRM_G(m), TRM_K(m), TRM_N(m), TRM_T(m), scr, gw, lane);
                if (m + 2 < 16) { if (TRM_HAS(m + 2)) tr_load(ra, TRM_W(m + 2), TRM_N(m + 2), gw, lane); }
                if (TRM_HAS(m + 1)) tr_finish(rb, TRM_G(m + 1), TRM_K(m + 1), TRM_N(m + 1), TRM_T(m + 1), scr, gw, lane);
            }
#undef TRM_W
#undef TRM_K
#undef TRM_N
#undef TRM_G
#undef TRM_T
#undef TRM_HAS
        } else {
        for (int l = 0; l < 2; ++l) {
            transpose_matrix(p.in[5] + (size_t)l * 1024 * 4096, n_mix_pre + (2 * l) * 1024, 1024, 4096, Win_t + (size_t)l * 4096 * 1024, scr, gw, ngw, lane);
            transpose_matrix(p.in[10] + (size_t)l * 2048 * 1024, nullptr, 2048, 1024, Wouta_t + (size_t)l * 1024 * 2048, scr, gw, ngw, lane);
            transpose_matrix(p.in[11] + (size_t)l * 1024 * 3072, n_mix_pre + (2 * l + 1) * 1024, 1024, 3072, Wqkv_t + (size_t)l * 3072 * 1024, scr, gw, ngw, lane);
            transpose_matrix(p.in[12] + (size_t)l * 1024 * 1024, nullptr, 1024, 1024, Wob_t + (size_t)l * 1024 * 1024, scr, gw, ngw, lane);
        }
        for (int l = 0; l < 4; ++l) {
            transpose_matrix(p.in[13] + (size_t)l * 1024 * 4096, n_ffn_pre + l * 1024, 1024, 4096, W1_t + (size_t)l * 4096 * 1024, scr, gw, ngw, lane);
            transpose_matrix(p.in[14] + (size_t)l * 4096 * 1024, nullptr, 4096, 1024, W2_t + (size_t)l * 1024 * 4096, scr, gw, ngw, lane);
        }
        }
        for (int i = blockIdx.x * 512 + tid; i < 2 * 8 * 128 * 128; i += gridDim.x * 512) { const int s = i & 127, t = (i >> 7) & 127; Wc[i] = (s <= t) ? (bf16)(cvtpk(a_w_s[i], 0.f) & 0xffffu) : (bf16)0; }
        x_to_bf16(x, XB, XSTAT, wave, lane);
    }
    grid.sync();
    const XcdBarrier xbar = xcd_barrier_post(barw, bst);

#pragma unroll 1
    for (int ph = 0; ph < 20; ++ph) {
        const int layer = ph / 5, step = ph % 5, j = layer >> 1; const bool even = (layer & 1) == 0;
        int tid = threadIdx.x; asm volatile("" : "+v"(tid));
        const int lane = tid & 63, wave = __builtin_amdgcn_readfirstlane(tid >> 6);
        if (step == 0 || step == 3) {
            pg8::Gemm g; EpiAct E; E.stat = STAT; E.rowstat = XSTAT; g.A = XB; g.lda = 1024; g.K = 1024; g.M = MTOK; E.O = Z;
            if (step == 0) { g.N = even ? 4096 : 3072; g.Bt = even ? Win_t + (size_t)j * 4096 * 1024 : Wqkv_t + (size_t)j * 3072 * 1024; E.ldc = g.N; E.act = even ? 1 : 3; }
            else { g.N = 4096; g.Bt = W1_t + (size_t)layer * 4096 * 1024; E.ldc = 4096; E.act = 2; }
            pg8::StaticOrder S; S.init(g.M, g.N, (int)gridDim.x, (int)blockIdx.x);
            pg8::gemm_phase<EpiAct, pg8::StaticOrder, true, true>(lds, g, S, E);
        } else if (step == 2 || step == 4) {
            pg8::Gemm g; EpiRes E; g.A = Z; g.M = MTOK; g.N = 1024;
            if (step == 2) { g.lda = even ? 4096 : 3072; g.K = even ? 2048 : 1024; g.Bt = even ? Wouta_t + (size_t)j * 1024 * 2048 : Wob_t + (size_t)j * 1024 * 1024; }
            else { g.lda = 4096; g.K = 4096; g.Bt = W2_t + (size_t)layer * 1024 * 4096; }
            const int bank = layer * 2 + (step == 4 ? 1 : 0);
            E.XB = XB; E.outf = (ph == 19) ? out : nullptr; E.xch = XCH; E.xch2 = XCH2; E.cnt = CNT + (size_t)bank * 256 * 64; E.cnt2 = CNT + (size_t)(8 + bank) * 256 * 64; E.rs = XSTAT; E.lds = lds;
            pg8::StaticOrder S; S.init(g.M, g.N, (int)gridDim.x, (int)blockIdx.x);
            pg8::gemm_phase<EpiRes, pg8::StaticOrder, true, true>(lds, g, S, E);
        } else {
#if PROBE_MIX
            if (even) { mix_phase(Z, (bf16*)(ws + 900 * MiB), 2048, STAT, a_v_g + (size_t)j * 2048, a_v_b + (size_t)j * 2048, Wc + (size_t)j * 8 * 128 * 128, a_b_s + (size_t)j * 8 * 128, lds, tid, wave, lane); __syncthreads(); }
#endif
#if PROBE_ATTN
            if (!even) attn_phase(Z, (bf16*)(ws + 900 * MiB), 1024, lds, wave, lane);
#endif
            if (even) mix_phase(Z, Z, 4096, STAT, a_v_g + (size_t)j * 2048, a_v_b + (size_t)j * 2048, Wc + (size_t)j * 8 * 128 * 128, a_b_s + (size_t)j * 8 * 128, lds, tid, wave, lane);
            else attn_phase(Z, Z, NQKV, lds, wave, lane);
        }
        if (step == 1 || step == 3) {
            const float* gsrc = (step == 1 ? n_mix_post : n_ffn_post) + layer * 1024;
            for (int i = tid; i < 1024; i += NWAVES * 64) ((LAS float*)(lds + LDS_G))[i] = gsrc[i];
        }
        if (ph != 19) xcd_barrier(xbar);
    }
}

extern "C" void kernel_launch(void* const* d_in, const int* in_sizes, int n_in, void* d_out, int out_size, void* d_ws, size_t ws_size, hipStream_t stream) {
    static int grid = 0;
    if (grid == 0) {
        if (n_in != 15 || out_size != MTOK * D_MODEL || ws_size < WS_END) { fprintf(stderr, "kernel_launch: unexpected sizes (n_in %d out %d ws %zu)\n", n_in, out_size, ws_size); grid = -1; return; }
        int dev = 0, cus = 0, per_cu = 0;
        hipGetDevice(&dev); hipDeviceGetAttribute(&cus, hipDeviceAttributeMultiprocessorCount, dev);
        if (hipFuncSetAttribute((const void*)fwd_kernel, hipFuncAttributeMaxDynamicSharedMemorySize, LDS_BYTES) != hipSuccess) fprintf(stderr, "kernel_launch: hipFuncSetAttribute failed\n");
        if (hipOccupancyMaxActiveBlocksPerMultiprocessor(&per_cu, (const void*)fwd_kernel, NWAVES * 64, LDS_BYTES) != hipSuccess || per_cu < 1) { fprintf(stderr, "kernel_launch: occupancy query gave %d\n", per_cu); per_cu = 1; }
        (void)hipGetLastError();
        grid = cus * per_cu;
    }
    if (grid < 0) return;
    Params p{};
    for (int i = 0; i < 15; ++i) p.in[i] = (const float*)d_in[i];
    p.out = (float*)d_out; p.ws = (unsigned char*)d_ws;
    void* args[] = {&p};
    hipError_t e = hipLaunchCooperativeKernel((const void*)fwd_kernel, dim3(grid), dim3(NWAVES * 64), args, LDS_BYTES, stream);
    if (e != hipSuccess) fprintf(stderr, "kernel_launch: cooperative launch failed: %s (grid %d)\n", hipGetErrorString(e), grid);
}
```

```cpp
#include <hip/hip_runtime.h>
#include <hip/hip_cooperative_groups.h>
#include <cstdio>
#include <cstdint>
namespace cg = cooperative_groups;

namespace pg8 {
#define PG8_LAS __attribute__((address_space(3)))
typedef unsigned short bf16_t;
typedef short bf16x8 __attribute__((ext_vector_type(8)));
typedef float f32x4 __attribute__((ext_vector_type(4)));
typedef unsigned u32x4 __attribute__((ext_vector_type(4)));
constexpr int BM = 256, BK = 64, HALF = 128, HTB = HALF * BK * 2  , STAGE_BYTES = 8 * HTB, NXCD = 8, WGM = 8;

__host__ __device__ __forceinline__ int lds_byte(int r, int c) { const int st = (r >> 4) * 2 + (c >> 5), rr = r & 15, cc = c & 31, ob = rr * 64 + cc * 2; return st * 1024 + (ob ^ (((ob >> 9) & 1) << 5)); }
__host__ __device__ __forceinline__ void stage_rc(int b, int& R, int& C) { const int st = b / 1024, sb = b % 1024, swz = sb ^ (((sb >> 9) & 1) << 5); R = (st >> 1) * 16 + swz / 64; C = (st & 1) * 32 + (swz % 64) / 2; }
__host__ __device__ __forceinline__ int perm32(int rho) { const int n = rho >> 4, i = rho & 15; return 8 * (i >> 2) + 4 * n + (i & 3); }

struct Unit { int pm, pn; };
struct Gemm { const bf16_t* A; const bf16_t* Bt; int M, N, K, lda; };

struct StaticOrder {
    int nM, nN, nwg, G, c;
    __host__ __device__ void init(int M, int N, int G_, int c_) { nM = M / BM; nN = N / BM; nwg = nM * nN; G = G_; c = c_; }
    __host__ __device__ bool next(int i, Unit& u) const {
        const long L = (long)i * G + c; if (L >= nwg) return false;
        int wgid = (int)L; { const int q = nwg / NXCD, r = nwg % NXCD, xcd = wgid % NXCD, off = wgid / NXCD; wgid = (xcd < r ? xcd * (q + 1) : r * (q + 1) + (xcd - r) * q) + off; }
        const int nig = WGM * nN, gid = wgid / nig, fm = gid * WGM, gsz = (nM - fm) < WGM ? (nM - fm) : WGM;
        u.pm = fm + ((wgid % nig) % gsz); u.pn = (wgid % nig) / gsz; return true;
    }
    __device__ __forceinline__ void a_ready(const Unit&) const {}
    __device__ __forceinline__ void done(const Unit&) const {}
};

__device__ __forceinline__ unsigned cvt_pk_bf16(float lo, float hi) { unsigned r; asm volatile("v_cvt_pk_bf16_f32 %0, %1, %2" : "=v"(r) : "v"(lo), "v"(hi)); return r; }
typedef float f32x2 __attribute__((ext_vector_type(2)));
__device__ __forceinline__ f32x2 gelu_pk(f32x2 v) {
    const f32x2 av = __builtin_elementwise_abs(v), d = av * 0.2316418882f + 1.0f;
    f32x2 t; t.x = __builtin_amdgcn_rcpf(d.x); t.y = __builtin_amdgcn_rcpf(d.y);
    f32x2 q = t * 0.5307027145f + (-0.7265760135f); q = q * t + 0.7107068705f; q = q * t + (-0.142248368f); q = q * t + 0.127414796f; q = q * t;
    const f32x2 s = (v * v) * (-0.72134752044f);
    f32x2 e; e.x = __builtin_amdgcn_exp2f(s.x); e.y = __builtin_amdgcn_exp2f(s.y);
    const f32x2 m = v * (q * e), r = v - m;
    f32x2 o; o.x = v.x < 0.f ? m.x : r.x; o.y = v.y < 0.f ? m.y : r.y; return o;
}

template <int ACT  > struct EpiBf16 {
    static constexpr bool PERM = true, AFTER_DRAIN = false; static_assert(ACT == 0 || ACT == 1, "EpiBf16: ACT is 0 (none) or 1 (gelu_pk)");
    bf16_t* O; int ldc; const float* bias; int split_cols; size_t split_stride; float scale0;
    __device__ __forceinline__ void operator()(const f32x4 (&acc)[2][2][4][2], const Unit& u, int wr, int wc, int fr, int fq) const {
        const int row0 = u.pm * BM + wr * 64 + fr; int colt = u.pn * BM; bf16_t* base = O;
        float sc = 1.f; if (split_cols) { const int t = colt / split_cols; base += (size_t)t * split_stride; colt -= t * split_cols; if (t == 0) sc = scale0; }
        const int col0 = colt + wc * 32 + 8 * fq, bcol0 = u.pn * BM + wc * 32 + 8 * fq;
        f32x4 bv[2][2];
#pragma unroll
        for (int bj = 0; bj < 2; ++bj)
#pragma unroll
            for (int n = 0; n < 2; ++n) bv[bj][n] = bias ? *(const f32x4*)(bias + bcol0 + bj * HALF + 4 * n) : (f32x4){0.f, 0.f, 0.f, 0.f};
#pragma unroll
        for (int ai = 0; ai < 2; ++ai)
#pragma unroll
            for (int m = 0; m < 4; ++m) { bf16_t* rowp = base + (size_t)(row0 + ai * HALF + m * 16) * ldc + col0;
#pragma unroll
                for (int bj = 0; bj < 2; ++bj) { f32x4 v0 = acc[ai][bj][m][0] + bv[bj][0], v1 = acc[ai][bj][m][1] + bv[bj][1];
                    if (ACT == 1) { f32x2 a = gelu_pk((f32x2){v0[0], v0[1]}), b = gelu_pk((f32x2){v0[2], v0[3]}), c = gelu_pk((f32x2){v1[0], v1[1]}), d = gelu_pk((f32x2){v1[2], v1[3]});
                        v0 = (f32x4){a.x, a.y, b.x, b.y}; v1 = (f32x4){c.x, c.y, d.x, d.y}; }
                    v0 = v0 * sc; v1 = v1 * sc; u32x4 w; w.x = cvt_pk_bf16(v0[0], v0[1]); w.y = cvt_pk_bf16(v0[2], v0[3]); w.z = cvt_pk_bf16(v1[0], v1[1]); w.w = cvt_pk_bf16(v1[2], v1[3]);
                    *(u32x4*)(rowp + bj * HALF) = w; } }
    }
};
template <class Epi, class Sched, bool ALIGN_EPI = false, bool SP2 = false>
__device__ __forceinline__ void gemm_phase(PG8_LAS unsigned char* lds, const Gemm g, const Sched& S, const Epi& E) {
    int tid = threadIdx.x; asm volatile("" : "+v"(tid));
    const int wid = __builtin_amdgcn_readfirstlane(tid >> 6), lane = tid & 63, wr = wid >> 2, wc = wid & 3, fr = lane & 15, fq = lane >> 4;
    const int K = g.K, nt = K / BK;
    unsigned voffA[2], voffB[2];
#pragma unroll
    for (int i = 0; i < 2; ++i) { int R, C; stage_rc(tid * 16 + i * 8192, R, C); const int Rb = Epi::PERM ? ((R & ~31) + perm32(R & 31)) : R;
        voffA[i] = (unsigned)(R * g.lda + C) * 2u; voffB[i] = (unsigned)(Rb * K + C) * 2u; }
    const size_t kstep = (size_t)(BK * 2);
    const size_t hstepA = (size_t)HALF * g.lda * 2, hstepB = (size_t)HALF * K * 2;
    const size_t tstepA = 2 * hstepA, tstepB = 2 * hstepB;
    const unsigned ldsw = (unsigned)wid * 1024u;
    const int aoff = lds_byte(wr * 64 + fr, fq * 8), boff = lds_byte(wc * 32 + fr, fq * 8);
#define PG8_SA(b, h) (((b) * 2 + (h)) * HTB)
#define PG8_SB(b, h) ((4 + (b) * 2 + (h)) * HTB)
#define PG8_STAGE(bufoff, gbase, voff) do { _Pragma("unroll") for (int _i = 0; _i < 2; ++_i) \
        __builtin_amdgcn_global_load_lds((const unsigned*)((const char*)(gbase) + (voff)[_i]), (PG8_LAS unsigned*)(lds + (bufoff) + ldsw + _i * 8192), 16, 0, 0); } while (0)
#define PG8_LDA(dst, b, h) do { _Pragma("unroll") for (int m = 0; m < 4; ++m) _Pragma("unroll") for (int k = 0; k < 2; ++k) dst[m][k] = *(const PG8_LAS bf16x8*)(lds + PG8_SA(b, h) + aoff + m * 2048 + k * 1024); } while (0)
#define PG8_LDB(dst, b, h) do { _Pragma("unroll") for (int n = 0; n < 2; ++n) _Pragma("unroll") for (int k = 0; k < 2; ++k) dst[n][k] = *(const PG8_LAS bf16x8*)(lds + PG8_SB(b, h) + boff + n * 2048 + k * 1024); } while (0)
#define PG8_MMA(ai, bj, At, Bt) do { __builtin_amdgcn_s_setprio(1); _Pragma("unroll") for (int m = 0; m < 4; ++m) _Pragma("unroll") for (int n = 0; n < 2; ++n) _Pragma("unroll") for (int k = 0; k < 2; ++k) \
        acc[ai][bj][m][n] = __builtin_amdgcn_mfma_f32_16x16x32_bf16(Bt[n][k], At[m][k], acc[ai][bj][m][n], 0, 0, 0); __builtin_amdgcn_s_setprio(0); } while (0)
#define PG8_WAIT_V(n) asm volatile("s_waitcnt vmcnt(" #n ")" ::: "memory")
#define PG8_WAIT_L(n) asm volatile("s_waitcnt lgkmcnt(" #n ")" ::: "memory")
#define PG8_BAR __builtin_amdgcn_s_barrier()
#define PG8_SCHED __builtin_amdgcn_sched_barrier(0)
    Unit cur, nxt; int ui = 0;
    if (!S.next(0, cur)) return;
    f32x4 acc[2][2][4][2];
#pragma unroll
    for (int a = 0; a < 2; ++a)
#pragma unroll
        for (int b = 0; b < 2; ++b)
#pragma unroll
            for (int m = 0; m < 4; ++m)
#pragma unroll
                for (int n = 0; n < 2; ++n) acc[a][b][m][n] = (f32x4){0.f, 0.f, 0.f, 0.f};
    bf16x8 At[4][2], B0[2][2], B1[2][2];
    float epre[8];
    const char* cA = (const char*)g.A + (size_t)cur.pm * tstepA; const char* cB = (const char*)g.Bt + (size_t)cur.pn * tstepB;
    S.a_ready(cur);
    if constexpr (SP2) {
        PG8_STAGE(PG8_SB(0, 0), cB, voffB); PG8_STAGE(PG8_SB(0, 1), cB + hstepB, voffB); PG8_STAGE(PG8_SA(0, 0), cA, voffA); PG8_STAGE(PG8_SA(0, 1), cA + hstepA, voffA);
        if (wr == 1) PG8_BAR;
        PG8_WAIT_V(2); PG8_BAR;
        PG8_STAGE(PG8_SB(1, 0), cB + kstep, voffB); PG8_STAGE(PG8_SA(1, 0), cA + kstep, voffA); PG8_STAGE(PG8_SB(1, 1), cB + hstepB + kstep, voffB);
        PG8_WAIT_V(6); PG8_BAR;
    } else {
        PG8_STAGE(PG8_SB(0, 0), cB, voffB); PG8_STAGE(PG8_SA(0, 0), cA, voffA); PG8_STAGE(PG8_SB(0, 1), cB + hstepB, voffB); PG8_STAGE(PG8_SA(0, 1), cA + hstepA, voffA);
        if (wr == 1) PG8_BAR;
        PG8_WAIT_V(4); PG8_BAR;
        PG8_STAGE(PG8_SB(1, 0), cB + kstep, voffB); PG8_STAGE(PG8_SA(1, 0), cA + kstep, voffA); PG8_STAGE(PG8_SB(1, 1), cB + hstepB + kstep, voffB);
        PG8_WAIT_V(6); PG8_BAR;
    }
    for (;;) {
        const bool has_next = S.next(ui + 1, nxt);
        const char* nA = has_next ? (const char*)g.A + (size_t)nxt.pm * tstepA : cA; const char* nB = has_next ? (const char*)g.Bt + (size_t)nxt.pn * tstepB : cB;
        for (int t = 0; t < nt; t += 2) {
            const bool last = (t == nt - 2);
            const char* a1 = cA + (size_t)(t + 1) * kstep;
            const char* a2 = last ? nA : cA + (size_t)(t + 2) * kstep; const char* b2 = last ? nB : cB + (size_t)(t + 2) * kstep;
            const char* a3 = a2 + kstep; const char* b3 = b2 + kstep;
            if (last && has_next) S.a_ready(nxt);
            if (last) E.prefetch(epre, cur, wr, fr);
            if constexpr (SP2) {
            PG8_LDB(B0, 0, 0); PG8_LDB(B1, 0, 1); PG8_SCHED; PG8_LDA(At, 0, 0); PG8_STAGE(PG8_SA(1, 1), a1 + hstepA, voffA);
            PG8_WAIT_V(8); PG8_WAIT_L(0); PG8_BAR; PG8_MMA(0, 0, At, B0); PG8_MMA(0, 1, At, B1); PG8_BAR; PG8_SCHED;
            PG8_LDA(At, 0, 1); PG8_STAGE(PG8_SB(0, 0), b2, voffB); PG8_STAGE(PG8_SB(0, 1), b2 + hstepB, voffB); PG8_STAGE(PG8_SA(0, 0), a2, voffA);
            PG8_WAIT_V(8); PG8_WAIT_L(0); PG8_BAR; PG8_MMA(1, 0, At, B0); PG8_MMA(1, 1, At, B1); PG8_BAR; PG8_SCHED;
            PG8_LDB(B0, 1, 0); PG8_LDB(B1, 1, 1); PG8_SCHED; PG8_LDA(At, 1, 0); PG8_STAGE(PG8_SA(0, 1), a2 + hstepA, voffA);
            PG8_WAIT_V(8); PG8_WAIT_L(0); PG8_BAR; PG8_MMA(0, 0, At, B0); PG8_MMA(0, 1, At, B1); PG8_BAR; PG8_SCHED;
            PG8_LDA(At, 1, 1); PG8_STAGE(PG8_SB(1, 0), b3, voffB); PG8_STAGE(PG8_SB(1, 1), b3 + hstepB, voffB); PG8_STAGE(PG8_SA(1, 0), a3, voffA);
            PG8_WAIT_V(8); PG8_WAIT_L(0); PG8_BAR; PG8_MMA(1, 0, At, B0); PG8_MMA(1, 1, At, B1); PG8_BAR; PG8_SCHED;
            } else {
            PG8_LDB(B0, 0, 0); PG8_SCHED; PG8_LDA(At, 0, 0); PG8_STAGE(PG8_SA(1, 1), a1 + hstepA, voffA);
            PG8_WAIT_L(8); PG8_BAR; PG8_WAIT_L(0); PG8_MMA(0, 0, At, B0); PG8_BAR; PG8_SCHED;
            PG8_LDB(B1, 0, 1); PG8_STAGE(PG8_SB(0, 0), b2, voffB);
            PG8_BAR; PG8_WAIT_L(0); PG8_MMA(0, 1, At, B1); PG8_BAR;
            PG8_LDA(At, 0, 1); PG8_STAGE(PG8_SA(0, 0), a2, voffA);
            PG8_BAR; PG8_WAIT_L(0); PG8_MMA(1, 0, At, B0); PG8_BAR; PG8_SCHED;
            PG8_STAGE(PG8_SB(0, 1), b2 + hstepB, voffB);
            PG8_WAIT_V(6); PG8_BAR; PG8_MMA(1, 1, At, B1); PG8_BAR;
            PG8_LDB(B0, 1, 0); PG8_SCHED; PG8_LDA(At, 1, 0); PG8_STAGE(PG8_SA(0, 1), a2 + hstepA, voffA);
            PG8_WAIT_L(8); PG8_BAR; PG8_WAIT_L(0); PG8_MMA(0, 0, At, B0); PG8_BAR; PG8_SCHED;
            PG8_LDB(B1, 1, 1); PG8_STAGE(PG8_SB(1, 0), b3, voffB);
            PG8_BAR; PG8_WAIT_L(0); PG8_MMA(0, 1, At, B1); PG8_BAR;
            PG8_LDA(At, 1, 1); PG8_STAGE(PG8_SA(1, 0), a3, voffA);
            PG8_BAR; PG8_WAIT_L(0); PG8_MMA(1, 0, At, B0); PG8_BAR; PG8_SCHED;
            PG8_STAGE(PG8_SB(1, 1), b3 + hstepB, voffB);
            PG8_WAIT_V(6); PG8_BAR; PG8_MMA(1, 1, At, B1); PG8_BAR;
            }
        }
        if constexpr (ALIGN_EPI) { if (wr == 0) PG8_BAR; }
        if constexpr (!Epi::AFTER_DRAIN) { E(acc, cur, wr, wc, fr, fq, epre); S.done(cur); }
        if (!has_next) break;
#pragma unroll
        for (int a = 0; a < 2; ++a)
#pragma unroll
            for (int b = 0; b < 2; ++b)
#pragma unroll
                for (int m = 0; m < 4; ++m)
#pragma unroll
                    for (int n = 0; n < 2; ++n) acc[a][b][m][n] = (f32x4){0.f, 0.f, 0.f, 0.f};
        cur = nxt; cA = nA; cB = nB; ++ui;
        if constexpr (ALIGN_EPI) { if (wr == 1) PG8_BAR; }
    }
    PG8_WAIT_V(0);
    if constexpr (!ALIGN_EPI) { if (wr == 0) PG8_BAR; }
    PG8_BAR;
    if constexpr (Epi::AFTER_DRAIN) { E.fused(acc, cur, wr, wc, fr, fq, lds, wid, lane); S.done(cur); }
#undef PG8_SA
#undef PG8_SB
#undef PG8_STAGE
#undef PG8_LDA
#undef PG8_LDB
#undef PG8_MMA
#undef PG8_WAIT_V
#undef PG8_WAIT_L
#undef PG8_BAR
#undef PG8_SCHED
}
}

#define LAS __attribute__((address_space(3)))
typedef unsigned short bf16;
typedef short bf16x8 __attribute__((ext_vector_type(8)));
typedef float f32x4 __attribute__((ext_vector_type(4)));
typedef float f32x16 __attribute__((ext_vector_type(16)));
typedef unsigned u32x4 __attribute__((ext_vector_type(4)));
typedef unsigned u32x2 __attribute__((ext_vector_type(2)));
typedef short v4i16_t __attribute__((ext_vector_type(4)));
typedef float f32x2_t __attribute__((ext_vector_type(2)));
typedef __bf16 bf16x2_t __attribute__((ext_vector_type(2)));

constexpr int D_MODEL = 1024, BATCH = 32, SEQ = 2048, DEPTH = 4, MTOK = BATCH * SEQ, D_FF = 4096, A_WIDTH = 2048, NQKV = 3072;
constexpr float EPS = 1e-6f;
constexpr size_t MiB = 1u << 20;
constexpr size_t WS_WIN = 1 * MiB, WS_WOUTA = 17 * MiB, WS_WQKV = 25 * MiB, WS_WOB = 37 * MiB, WS_W1 = 41 * MiB, WS_W2 = 73 * MiB, WS_WC = 105 * MiB;
constexpr size_t WS_HN = 112 * MiB, WS_Z = 240 * MiB, WS_STAT = 752 * MiB, WS_XCH = 768 * MiB, WS_XSTAT = 769 * MiB, WS_CNT = 770 * MiB, WS_XCH2 = 771 * MiB, WS_END = 772 * MiB;
constexpr int LDS_BYTES = 147456, LDS_BST = 131072 + 1024;
constexpr size_t WS_BAR = 65536;
constexpr int NWAVES = 8;
#ifndef PROBE_MIX
#define PROBE_MIX 0
#endif
#ifndef PROBE_ATTN
#define PROBE_ATTN 0
#endif


__device__ __forceinline__ unsigned cvtpk(float lo, float hi) { f32x2_t v = {lo, hi}; bf16x2_t b = __builtin_convertvector(v, bf16x2_t); return __builtin_bit_cast(unsigned, b); }
__device__ __forceinline__ float bflo(unsigned w) { return __uint_as_float(w << 16); }
__device__ __forceinline__ float bfhi(unsigned w) { return __uint_as_float(w & 0xffff0000u); }
__device__ __forceinline__ float wave_sum(float v) {
#pragma unroll
    for (int o = 1; o < 64; o <<= 1) v += __shfl_xor(v, o);
    return v;
}
__device__ __forceinline__ int crow(int r, int hi) { return (r & 3) + 8 * (r >> 2) + 4 * hi; }
__device__ __forceinline__ v4i16_t tr_read(LAS unsigned char* p) { return __builtin_amdgcn_ds_read_tr16_b64_v4i16((LAS v4i16_t*)p); }

struct EpiAct {
    static constexpr bool PERM = true, AFTER_DRAIN = false;
    bf16* O; int ldc; int act; const float* rowstat; float* stat;
    __device__ __forceinline__ void prefetch(float (&pre)[8], const pg8::Unit& u, int wr, int fr) const {
        const int row0 = u.pm * pg8::BM + wr * 64 + fr;
#pragma unroll
        for (int ai = 0; ai < 2; ++ai)
#pragma unroll
            for (int m = 0; m < 4; ++m) pre[ai * 4 + m] = rowstat ? rowstat[row0 + ai * pg8::HALF + m * 16] : 1.f;
    }
    template <int MODE>
    __device__ __forceinline__ void run(pg8::f32x4 (&acc)[2][2][4][2], const pg8::Unit& u, int wr, int wc, int fr, int fq, const float (&pre)[8], float sc) const {
        using namespace pg8;
        const int row0 = u.pm * BM + wr * 64 + fr; const int col0 = u.pn * BM + wc * 32 + 8 * fq;
#pragma unroll
        for (int ai = 0; ai < 2; ++ai)
#pragma unroll
            for (int m = 0; m < 4; ++m) { bf16* rowp = O + (size_t)(row0 + ai * HALF + m * 16) * ldc + col0;
                float rs = 0.f, rq = 0.f; const float ps = pre[ai * 4 + m] * sc;
#pragma unroll
                for (int bj = 0; bj < 2; ++bj) { pg8::f32x4 v0 = acc[ai][bj][m][0] * ps, v1 = acc[ai][bj][m][1] * ps;
                    if (MODE == 1) { f32x2 a = gelu_pk((f32x2){v0[0], v0[1]}), b = gelu_pk((f32x2){v0[2], v0[3]}), c = gelu_pk((f32x2){v1[0], v1[1]}), d = gelu_pk((f32x2){v1[2], v1[3]});
                        v0 = (pg8::f32x4){a.x, a.y, b.x, b.y}; v1 = (pg8::f32x4){c.x, c.y, d.x, d.y};
                        rs += ((v0[0] + v0[1]) + (v0[2] + v0[3])) + ((v1[0] + v1[1]) + (v1[2] + v1[3]));
                        rq += ((v0[0] * v0[0] + v0[1] * v0[1]) + (v0[2] * v0[2] + v0[3] * v0[3])) + ((v1[0] * v1[0] + v1[1] * v1[1]) + (v1[2] * v1[2] + v1[3] * v1[3])); }
                    else if (MODE == 2) {
#pragma unroll
                        for (int e = 0; e < 4; ++e) { const float a = fmaxf(v0[e], 0.f), b = fmaxf(v1[e], 0.f); v0[e] = a * a; v1[e] = b * b; } }
                    pg8::u32x4 w; w.x = cvtpk(v0[0], v0[1]); w.y = cvtpk(v0[2], v0[3]); w.z = cvtpk(v1[0], v1[1]); w.w = cvtpk(v1[2], v1[3]);
                    *(pg8::u32x4*)(rowp + bj * HALF) = w; }
                if (MODE == 1) { rs += __shfl_xor(rs, 16); rs += __shfl_xor(rs, 32); rq += __shfl_xor(rq, 16); rq += __shfl_xor(rq, 32);
                    if (fq == 0) *(f32x2*)(stat + ((size_t)(row0 + ai * HALF + m * 16) * 32 + (u.pn - 8) * 4 + wc) * 2) = (f32x2){rs, rq}; } }
    }
    __device__ __forceinline__ void operator()(pg8::f32x4 (&acc)[2][2][4][2], const pg8::Unit& u, int wr, int wc, int fr, int fq, const float (&pre)[8]) const {
        asm volatile("" : "+v"(fr), "+v"(fq));
        const float sc = (act == 3 && u.pn * pg8::BM < 1024) ? 0.125f : 1.f;
        if (act == 2) run<2>(acc, u, wr, wc, fr, fq, pre, 1.f);
        else if (act == 1 && u.pn >= 8) run<1>(acc, u, wr, wc, fr, fq, pre, 1.f);
        else run<0>(acc, u, wr, wc, fr, fq, pre, sc);
    }
};

constexpr int LDS_P = 131072 + 2048, LDS_S = LDS_P + 4096, LDS_G = LDS_S + 1024;
struct EpiRes {
    static constexpr bool PERM = true, AFTER_DRAIN = false;
    bf16* XB; float* outf; float* xch; float* xch2; unsigned* cnt; unsigned* cnt2; float* rs; LAS unsigned char* lds;
    __device__ __forceinline__ void prefetch(float (&)[8], const pg8::Unit&, int, int) const {}
    __device__ __forceinline__ void wait32(unsigned* c) const {
        unsigned sp = 0u;
        while ((unsigned)__builtin_amdgcn_readfirstlane(__hip_atomic_load(c, __ATOMIC_RELAXED, __HIP_MEMORY_SCOPE_AGENT)) < 32u) { __builtin_amdgcn_s_sleep(1); if (++sp > (1u << 22)) break; }
        __builtin_amdgcn_fence(__ATOMIC_ACQUIRE, "agent");
    }
    __device__ __forceinline__ void operator()(pg8::f32x4 (&acc)[2][2][4][2], const pg8::Unit& u, int wr, int wc, int fr, int fq, const float (&)[8]) const {
        using namespace pg8;
        asm volatile("" : "+v"(fr), "+v"(fq));
        const int lane = fq * 16 + fr, wid = wr * 4 + wc;
        LAS float* P = (LAS float*)(lds + LDS_P); LAS float* S = (LAS float*)(lds + LDS_S); LAS float* Gs = (LAS float*)(lds + LDS_G);
        const int col0 = u.pn * BM + wc * 32 + 8 * fq;
#pragma unroll
        for (int ai = 0; ai < 2; ++ai)
#pragma unroll
            for (int m = 0; m < 4; ++m) { float q = 0.f;
#pragma unroll
                for (int bj = 0; bj < 2; ++bj)
#pragma unroll
                    for (int n = 0; n < 2; ++n) { const pg8::f32x4 v = acc[ai][bj][m][n]; q += (v[0] * v[0] + v[1] * v[1]) + (v[2] * v[2] + v[3] * v[3]); }
                q += __shfl_xor(q, 16); q += __shfl_xor(q, 32);
                if (fq == 0) P[(ai * HALF + wr * 64 + m * 16 + fr) * 4 + wc] = q; }
        asm volatile("s_waitcnt lgkmcnt(0)" ::: "memory"); __builtin_amdgcn_s_barrier(); asm volatile("" ::: "memory");
        const int row = wid * 32 + (lane & 31);
        if (lane < 32) { const pg8::f32x4 pp = *(LAS pg8::f32x4*)(P + row * 4);
            __hip_atomic_store(xch + ((size_t)(u.pm * BM + row) * 4 + u.pn), (pp[0] + pp[1]) + (pp[2] + pp[3]), __ATOMIC_RELAXED, __HIP_MEMORY_SCOPE_AGENT); }
        asm volatile("" ::: "memory");
        pg8::u32x4 xpre0[4][2], xpre1[4][2];
#pragma unroll
        for (int m = 0; m < 4; ++m)
#pragma unroll
            for (int bj = 0; bj < 2; ++bj) xpre0[m][bj] = *(const pg8::u32x4*)(XB + (size_t)(u.pm * BM + wr * 64 + m * 16 + fr) * 1024 + col0 + bj * HALF);
        asm volatile("" ::: "memory");
        asm volatile("s_waitcnt vmcnt(8)" ::: "memory");
        if (lane == 0) __hip_atomic_fetch_add(cnt + 64 * u.pm, 1u, __ATOMIC_RELAXED, __HIP_MEMORY_SCOPE_AGENT);
        if (wid == 0) wait32(cnt + 64 * u.pm);
        asm volatile("s_waitcnt vmcnt(0) lgkmcnt(0)" ::: "memory"); __builtin_amdgcn_s_barrier(); asm volatile("" ::: "memory");
        if (lane < 32) { const float* sl = xch + (size_t)(u.pm * BM + row) * 4; float t = 0.f;
#pragma unroll
            for (int k = 0; k < 4; ++k) t += __hip_atomic_load(sl + k, __ATOMIC_RELAXED, __HIP_MEMORY_SCOPE_AGENT);
            S[row] = 1.0f / sqrtf(t * (1.f / 1024.f) + 1e-6f); }
        asm volatile("s_waitcnt lgkmcnt(0)" ::: "memory"); __builtin_amdgcn_s_barrier(); asm volatile("" ::: "memory");
        pg8::f32x4 gp[2][2];
#pragma unroll
        for (int bj = 0; bj < 2; ++bj) { gp[bj][0] = *(LAS pg8::f32x4*)(Gs + col0 + bj * HALF); gp[bj][1] = *(LAS pg8::f32x4*)(Gs + col0 + bj * HALF + 4); }
#pragma unroll
        for (int ai = 0; ai < 2; ++ai) {
#pragma unroll
            for (int m = 0; m < 4; ++m) { const int r = ai * HALF + wr * 64 + m * 16 + fr; const float rsm = S[r]; const size_t off = (size_t)(u.pm * BM + r) * 1024 + col0; float q2 = 0.f;
#pragma unroll
                for (int bj = 0; bj < 2; ++bj) { const pg8::u32x4 xw = ai == 0 ? xpre0[m][bj] : xpre1[m][bj];
                    pg8::f32x4 x0 = {__uint_as_float(xw.x << 16), __uint_as_float(xw.x & 0xffff0000u), __uint_as_float(xw.y << 16), __uint_as_float(xw.y & 0xffff0000u)};
                    pg8::f32x4 x1 = {__uint_as_float(xw.z << 16), __uint_as_float(xw.z & 0xffff0000u), __uint_as_float(xw.w << 16), __uint_as_float(xw.w & 0xffff0000u)};
                    x0 = x0 + acc[ai][bj][m][0] * rsm * gp[bj][0]; x1 = x1 + acc[ai][bj][m][1] * rsm * gp[bj][1];
                    q2 += ((x0[0] * x0[0] + x0[1] * x0[1]) + (x0[2] * x0[2] + x0[3] * x0[3])) + ((x1[0] * x1[0] + x1[1] * x1[1]) + (x1[2] * x1[2] + x1[3] * x1[3]));
                    acc[ai][bj][m][0] = x0; acc[ai][bj][m][1] = x1; }
                if (ai == 0) {
#pragma unroll
                    for (int bj = 0; bj < 2; ++bj) xpre1[m][bj] = *(const pg8::u32x4*)(XB + (size_t)(u.pm * BM + HALF + wr * 64 + m * 16 + fr) * 1024 + col0 + bj * HALF);
                    asm volatile("" ::: "memory"); }
                q2 += __shfl_xor(q2, 16); q2 += __shfl_xor(q2, 32);
                if (fq == 0) P[r * 4 + wc] = q2; }
            asm volatile("" ::: "memory"); }
        asm volatile("s_waitcnt lgkmcnt(0)" ::: "memory"); __builtin_amdgcn_s_barrier(); asm volatile("" ::: "memory");
        if (lane < 32) { const pg8::f32x4 pp = *(LAS pg8::f32x4*)(P + row * 4);
            __hip_atomic_store(xch2 + ((size_t)(u.pm * BM + row) * 4 + u.pn), (pp[0] + pp[1]) + (pp[2] + pp[3]), __ATOMIC_RELAXED, __HIP_MEMORY_SCOPE_AGENT); }
        asm volatile("s_waitcnt vmcnt(0)" ::: "memory");
        if (lane == 0) __hip_atomic_fetch_add(cnt2 + 64 * u.pm, 1u, __ATOMIC_RELAXED, __HIP_MEMORY_SCOPE_AGENT);
#pragma unroll
        for (int ai = 0; ai < 2; ++ai)
#pragma unroll
            for (int m = 0; m < 4; ++m) { const size_t off = (size_t)(u.pm * BM + ai * HALF + wr * 64 + m * 16 + fr) * 1024 + col0;
#pragma unroll
                for (int bj = 0; bj < 2; ++bj) { const pg8::f32x4 x0 = acc[ai][bj][m][0], x1 = acc[ai][bj][m][1];
                    if (outf) { *(pg8::f32x4*)(outf + off + bj * HALF) = x0; *(pg8::f32x4*)(outf + off + bj * HALF + 4) = x1; }
                    else { pg8::u32x4 w; w.x = cvtpk(x0[0], x0[1]); w.y = cvtpk(x0[2], x0[3]); w.z = cvtpk(x1[0], x1[1]); w.w = cvtpk(x1[2], x1[3]); *(pg8::u32x4*)(XB + off + bj * HALF) = w; } } }
        if (u.pn == (u.pm & 3)) {
            if (wid == 0) wait32(cnt2 + 64 * u.pm);
            asm volatile("s_waitcnt vmcnt(0) lgkmcnt(0)" ::: "memory"); __builtin_amdgcn_s_barrier(); asm volatile("" ::: "memory");
            if (lane < 32) { const float* sl = xch2 + (size_t)(u.pm * BM + row) * 4; float t = 0.f;
#pragma unroll
                for (int k = 0; k < 4; ++k) t += __hip_atomic_load(sl + k, __ATOMIC_RELAXED, __HIP_MEMORY_SCOPE_AGENT);
                rs[u.pm * BM + row] = 1.0f / sqrtf(t * (1.f / 1024.f) + 1e-6f); }
        }
    }
};

__device__ __forceinline__ void transpose_item(const float* W, const float* gk, int K, int N, bf16* WT, LAS float* scr, int item, int lane) {
    const int nblk = N / 32, kb = item / nblk, nb = item % nblk, k0 = 64 * kb, n0 = 32 * nb;
#pragma unroll
    for (int i = 0; i < 32; ++i) { const int kk = 2 * i + (lane >> 5); scr[kk * 33 + (lane & 31)] = W[(size_t)(k0 + kk) * N + n0 + (lane & 31)]; }
    const int c = lane & 7;
    f32x4 ga = {1.f, 1.f, 1.f, 1.f}, gb = ga;
    if (gk) { ga = *(const f32x4*)(gk + k0 + 8 * c); gb = *(const f32x4*)(gk + k0 + 8 * c + 4); }
    asm volatile("s_waitcnt lgkmcnt(0)" ::: "memory");
#pragma unroll
    for (int j = 0; j < 4; ++j) { const int n = (lane >> 3) + 8 * j; const LAS float* s = scr + (8 * c) * 33 + n;
        u32x4 o; o.x = cvtpk(s[0 * 33] * ga.x, s[1 * 33] * ga.y); o.y = cvtpk(s[2 * 33] * ga.z, s[3 * 33] * ga.w); o.z = cvtpk(s[4 * 33] * gb.x, s[5 * 33] * gb.y); o.w = cvtpk(s[6 * 33] * gb.z, s[7 * 33] * gb.w);
        *(u32x4*)(WT + (size_t)(n0 + n) * K + k0 + 8 * c) = o; }
    asm volatile("s_waitcnt lgkmcnt(0)" ::: "memory");
}
__device__ __forceinline__ void transpose_matrix(const float* W, const float* gk, int K, int N, bf16* WT, LAS float* scr, int gw, int ngw, int lane) {
    const int items = (K / 64) * (N / 32);
    for (int it = gw; it < items; it += ngw) transpose_item(W, gk, K, N, WT, scr, it, lane);
}

__device__ __forceinline__ void tr_load(float (&r)[32], const float* W, int N, int item, int lane) {
    const int nblk = N / 32, kb = item / nblk, nb = item % nblk, k0 = 64 * kb, n0 = 32 * nb;
#pragma unroll
    for (int i = 0; i < 32; ++i) { const int kk = 2 * i + (lane >> 5); r[i] = W[(size_t)(k0 + kk) * N + n0 + (lane & 31)]; }
}
__device__ __forceinline__ void tr_finish(const float (&r)[32], const float* gk, int K, int N, bf16* WT, LAS float* scr, int item, int lane) {
    const int nblk = N / 32, kb = item / nblk, nb = item % nblk, k0 = 64 * kb, n0 = 32 * nb;
#pragma unroll
    for (int i = 0; i < 32; ++i) { const int kk = 2 * i + (lane >> 5); scr[kk * 33 + (lane & 31)] = r[i]; }
    const int c = lane & 7;
    f32x4 ga = {1.f, 1.f, 1.f, 1.f}, gb = ga;
    if (gk) { ga = *(const f32x4*)(gk + k0 + 8 * c); gb = *(const f32x4*)(gk + k0 + 8 * c + 4); }
    asm volatile("s_waitcnt lgkmcnt(0)" ::: "memory");
#pragma unroll
    for (int j = 0; j < 4; ++j) { const int n = (lane >> 3) + 8 * j; const LAS float* s = scr + (8 * c) * 33 + n;
        u32x4 o; o.x = cvtpk(s[0 * 33] * ga.x, s[1 * 33] * ga.y); o.y = cvtpk(s[2 * 33] * ga.z, s[3 * 33] * ga.w); o.z = cvtpk(s[4 * 33] * gb.x, s[5 * 33] * gb.y); o.w = cvtpk(s[6 * 33] * gb.z, s[7 * 33] * gb.w);
        *(u32x4*)(WT + (size_t)(n0 + n) * K + k0 + 8 * c) = o; }
    asm volatile("s_waitcnt lgkmcnt(0)" ::: "memory");
}

__device__ __forceinline__ void x_to_bf16(const float* xin, bf16* xb, float* xstat, int wave, int lane) {
    const int gw = blockIdx.x * NWAVES + wave, ngw = gridDim.x * NWAVES;
    for (int m0 = gw * 4; m0 < MTOK; m0 += ngw * 4) {
        f32x4 v[4][4];
#pragma unroll
        for (int r = 0; r < 4; ++r) { const f32x4* xr = (const f32x4*)(xin + (size_t)(m0 + r) * D_MODEL) + lane;
#pragma unroll
            for (int j = 0; j < 4; ++j) v[r][j] = xr[64 * j]; }
#pragma unroll
        for (int r = 0; r < 4; ++r) { float ss = 0.f;
#pragma unroll
            for (int j = 0; j < 4; ++j) ss += (v[r][j].x * v[r][j].x + v[r][j].y * v[r][j].y) + (v[r][j].z * v[r][j].z + v[r][j].w * v[r][j].w);
            ss = wave_sum(ss);
            u32x2* ho = (u32x2*)(xb + (size_t)(m0 + r) * D_MODEL) + lane;
#pragma unroll
            for (int j = 0; j < 4; ++j) { u32x2 w; w.x = cvtpk(v[r][j].x, v[r][j].y); w.y = cvtpk(v[r][j].z, v[r][j].w); ho[64 * j] = w; }
            if (lane == 0) xstat[m0 + r] = 1.0f / sqrtf(ss * (1.f / D_MODEL) + EPS); }
    }
}

__device__ __forceinline__ void row_pass(bf16* xb, const bf16* mo, const float* gpost, float* outf, float* xstat, int wave, int lane) {
    const int gw = blockIdx.x * NWAVES + wave, ngw = gridDim.x * NWAVES;
    f32x4 gp[4];
#pragma unroll
    for (int j = 0; j < 4; ++j) gp[j] = *((const f32x4*)gpost + lane + 64 * j);
    for (int m0 = gw * 4; m0 < MTOK; m0 += ngw * 4) {
        u32x2 xw[4][4], mw[4][4];
#pragma unroll
        for (int r = 0; r < 4; ++r) { const u32x2* xr = (const u32x2*)(xb + (size_t)(m0 + r) * D_MODEL) + lane; const u32x2* mr = (const u32x2*)(mo + (size_t)(m0 + r) * D_MODEL) + lane;
#pragma unroll
            for (int j = 0; j < 4; ++j) { xw[r][j] = xr[64 * j]; mw[r][j] = mr[64 * j]; } }
#pragma unroll
        for (int r = 0; r < 4; ++r) {
            const int m = m0 + r;
            f32x4 mv[4], v[4]; float ss = 0.f;
#pragma unroll
            for (int j = 0; j < 4; ++j) { mv[j] = (f32x4){bflo(mw[r][j].x), bfhi(mw[r][j].x), bflo(mw[r][j].y), bfhi(mw[r][j].y)}; v[j] = (f32x4){bflo(xw[r][j].x), bfhi(xw[r][j].x), bflo(xw[r][j].y), bfhi(xw[r][j].y)};
                ss += (mv[j].x * mv[j].x + mv[j].y * mv[j].y) + (mv[j].z * mv[j].z + mv[j].w * mv[j].w); }
            const float rstd = 1.0f / sqrtf(wave_sum(ss) * (1.f / D_MODEL) + EPS);
            float s2 = 0.f;
#pragma unroll
            for (int j = 0; j < 4; ++j) { v[j] = v[j] + mv[j] * rstd * gp[j]; s2 += (v[j].x * v[j].x + v[j].y * v[j].y) + (v[j].z * v[j].z + v[j].w * v[j].w); }
            s2 = wave_sum(s2);
            if (outf) { f32x4* xo = (f32x4*)(outf + (size_t)m * D_MODEL) + lane;
#pragma unroll
                for (int j = 0; j < 4; ++j) xo[64 * j] = v[j]; }
            else { u32x2* ho = (u32x2*)(xb + (size_t)m * D_MODEL) + lane;
#pragma unroll
                for (int j = 0; j < 4; ++j) { u32x2 w; w.x = cvtpk(v[j].x, v[j].y); w.y = cvtpk(v[j].z, v[j].w); ho[64 * j] = w; }
                if (lane == 0) xstat[m] = 1.0f / sqrtf(s2 * (1.f / D_MODEL) + EPS); }
        }
    }
}

__device__ __forceinline__ void mix_phase(bf16* Z, bf16* Gout, int ldg, const float* stat, const float* vg, const float* vbias, const bf16* Wc, const float* bs, LAS unsigned char* lds, int tid, int wave, int lane) {
    constexpr int LD = 4096, PITCH = 576, WPITCH = 272, OFF_W = 128 * PITCH, OFF_ST = OFF_W + 128 * WPITCH;
    LAS float* st = (LAS float*)(lds + OFF_ST);
    const int nper = gridDim.x >> 3, g = blockIdx.x & 7, ci = blockIdx.x >> 3;
    if (nper == 0 || ci >= nper) return;
    const int r32 = lane & 31, hi = lane >> 5;
    const int troff = (8 * hi + ((lane & 15) >> 2)) * PITCH + (32 * wave + 16 * ((lane >> 4) & 1) + 4 * (lane & 3)) * 2;
#pragma unroll
    for (int it = 0; it < 4; ++it) { const int idx = it * 512 + tid, row = idx >> 4, ch = idx & 15;
        *(LAS u32x4*)(lds + OFF_W + row * WPITCH + ch * 16) = *(const u32x4*)(Wc + ((size_t)g * 128 + row) * 128 + ch * 8); }
    const int vrow = tid >> 5, vch = tid & 31;
    const f32x4 g0 = *(const f32x4*)(vg + g * 256 + vch * 8), g1 = *(const f32x4*)(vg + g * 256 + vch * 8 + 4);
    const f32x4 b0 = *(const f32x4*)(vbias + g * 256 + vch * 8), b1 = *(const f32x4*)(vbias + g * 256 + vch * 8 + 4);
    const int srow = tid >> 2, sq = tid & 3;
    float bsr[4];
#pragma unroll
    for (int tb = 0; tb < 4; ++tb) bsr[tb] = bs[g * 128 + tb * 32 + r32];
    u32x4 rawv[8]; f32x4 stp[4];
    { const size_t row0 = (size_t)ci * 128;
#pragma unroll
      for (int it = 0; it < 8; ++it) rawv[it] = *(const u32x4*)(Z + (row0 + it * 16 + vrow) * LD + 2048 + g * 256 + vch * 8);
#pragma unroll
      for (int k = 0; k < 4; ++k) stp[k] = *(const f32x4*)(stat + ((row0 + srow) * 32 + (k * 4 + sq) * 2) * 2); }
    for (int chunk = ci; chunk < MTOK / 128; chunk += nper) {
        const size_t row0 = (size_t)chunk * 128;
        bf16* up = Z + (row0 + r32) * LD + g * 256 + 32 * wave + 8 * hi;
        bf16* gp = Gout + (row0 + r32) * ldg + g * 256 + 32 * wave + 8 * hi;
        u32x4 ul[4][2];
#pragma unroll
        for (int tb = 0; tb < 4; ++tb)
#pragma unroll
            for (int j = 0; j < 2; ++j) ul[tb][j] = *(const u32x4*)(up + (size_t)tb * 32 * LD + 16 * j);
        { float s = (stp[0].x + stp[0].z) + (stp[1].x + stp[1].z) + (stp[2].x + stp[2].z) + (stp[3].x + stp[3].z);
          float q = (stp[0].y + stp[0].w) + (stp[1].y + stp[1].w) + (stp[2].y + stp[2].w) + (stp[3].y + stp[3].w);
          s += __shfl_xor(s, 1); s += __shfl_xor(s, 2); q += __shfl_xor(q, 1); q += __shfl_xor(q, 2);
          const float mean = s * (1.f / 2048.f), var = fmaxf(q * (1.f / 2048.f) - mean * mean, 0.f);
          if (sq == 0) { st[2 * srow] = mean; st[2 * srow + 1] = 1.0f / sqrtf(var + EPS); } }
        __syncthreads();
#pragma unroll
        for (int it = 0; it < 8; ++it) {
            const int row = it * 16 + vrow; const u32x4 w = rawv[it];
            const float mean = st[2 * row], rstd = st[2 * row + 1];
            u32x4 o;
            o.x = cvtpk((bflo(w.x) - mean) * rstd * g0.x + b0.x, (bfhi(w.x) - mean) * rstd * g0.y + b0.y);
            o.y = cvtpk((bflo(w.y) - mean) * rstd * g0.z + b0.z, (bfhi(w.y) - mean) * rstd * g0.w + b0.w);
            o.z = cvtpk((bflo(w.z) - mean) * rstd * g1.x + b1.x, (bfhi(w.z) - mean) * rstd * g1.y + b1.y);
            o.w = cvtpk((bflo(w.w) - mean) * rstd * g1.z + b1.z, (bfhi(w.w) - mean) * rstd * g1.w + b1.w);
            *(LAS u32x4*)(lds + row * PITCH + vch * 16) = o;
        }
        __syncthreads();
        if (chunk + nper < MTOK / 128) { const size_t nrow0 = (size_t)(chunk + nper) * 128;
#pragma unroll
            for (int it = 0; it < 8; ++it) rawv[it] = *(const u32x4*)(Z + (nrow0 + it * 16 + vrow) * LD + 2048 + g * 256 + vch * 8);
#pragma unroll
            for (int k = 0; k < 4; ++k) stp[k] = *(const f32x4*)(stat + ((nrow0 + srow) * 32 + (k * 4 + sq) * 2) * 2); }
        bf16x8 af[8];
#pragma unroll
        for (int ks = 0; ks < 8; ++ks) { const v4i16_t lo = tr_read(lds + troff + (16 * ks) * PITCH), h4 = tr_read(lds + troff + (16 * ks + 4) * PITCH);
            af[ks] = (bf16x8){lo[0], lo[1], lo[2], lo[3], h4[0], h4[1], h4[2], h4[3]}; }
#pragma unroll
        for (int tb = 0; tb < 4; ++tb) {
            f32x16 acc = {};
            LAS unsigned char* wp = lds + OFF_W + (tb * 32 + r32) * WPITCH + 16 * hi;
#pragma unroll
            for (int ks = 0; ks < 2 * (tb + 1); ++ks) { const bf16x8 bfrag = *(LAS bf16x8*)(wp + 32 * ks); acc = __builtin_amdgcn_mfma_f32_32x32x16_bf16(af[ks], bfrag, acc, 0, 0, 0); }
            const float bsv = bsr[tb];
#pragma unroll
            for (int j = 0; j < 2; ++j) {
                const u32x4 L = ul[tb][j];
                const auto s0 = __builtin_amdgcn_permlane32_swap(L.x, L.z, false, false), s1 = __builtin_amdgcn_permlane32_swap(L.y, L.w, false, false);
                u32x2 ow[2];
#pragma unroll
                for (int e = 0; e < 2; ++e) { const int g4 = 2 * j + e; const unsigned w0 = s0[e], w1 = s1[e];
                    const pg8::f32x2 ua = pg8::gelu_pk((pg8::f32x2){bflo(w0), bfhi(w0)}), ub = pg8::gelu_pk((pg8::f32x2){bflo(w1), bfhi(w1)});
                    ow[e].x = cvtpk(ua.x * (acc[4 * g4] + bsv), ua.y * (acc[4 * g4 + 1] + bsv));
                    ow[e].y = cvtpk(ub.x * (acc[4 * g4 + 2] + bsv), ub.y * (acc[4 * g4 + 3] + bsv)); }
                const auto t0 = __builtin_amdgcn_permlane32_swap(ow[0].x, ow[1].x, false, false), t1 = __builtin_amdgcn_permlane32_swap(ow[0].y, ow[1].y, false, false);
                u32x4 o; o.x = t0[0]; o.y = t1[0]; o.z = t0[1]; o.w = t1[1];
                *(u32x4*)(gp + (size_t)tb * 32 * ldg + 16 * j) = o; }
        }
        __syncthreads();
    }
}

template <bool DIAG>
__device__ __forceinline__ void attn_tile(f32x16& o0, f32x16& o1, float& carry2, const bf16x8 (&qr)[4], bf16x8 (&kf)[4], u32x4 (&vr)[4], const bf16* kpn, const bf16* vpn, bool has_next,
                                          LAS unsigned char* vcur, LAS unsigned char* vnxt, int troff, int strow, int stch, int r32, int hi) {
    constexpr int LD = NQKV; constexpr float LOG2E = 1.4426950408889634f;
    f32x16 p = {};
#pragma unroll
    for (int s = 0; s < 4; ++s) p = __builtin_amdgcn_mfma_f32_32x32x16_bf16(kf[s], qr[s], p, 0, 0, 0);
    (void)has_next;
#pragma unroll
    for (int s = 0; s < 4; ++s) { kf[s] = *(const bf16x8*)(kpn + 16 * s); vr[s] = *(const u32x4*)(vpn + (size_t)s * 8 * LD); }
    float kp[16], be[16];
#pragma unroll
    for (int r = 0; r < 16; ++r) { const float z = __builtin_amdgcn_fmed3f(p[r], -80.f, 3.0e38f);
        const float t = __builtin_amdgcn_exp2f(z * -LOG2E); be[r] = __builtin_amdgcn_rcpf(1.f + t); kp[r] = t * be[r];
        if (DIAG) { const bool msk = crow(r, hi) >= r32; kp[r] = msk ? 1.f : kp[r]; be[r] = msk ? 0.f : be[r]; } }
    float se[16], G[4], oth[4], T[4];
#pragma unroll
    for (int g = 0; g < 4; ++g) { se[4 * g + 3] = 1.f; se[4 * g + 2] = kp[4 * g + 3]; se[4 * g + 1] = se[4 * g + 2] * kp[4 * g + 2]; se[4 * g] = se[4 * g + 1] * kp[4 * g + 1]; G[g] = se[4 * g] * kp[4 * g]; }
#pragma unroll
    for (int g = 0; g < 4; ++g) {
        const auto rr = __builtin_amdgcn_permlane32_swap(__float_as_uint(G[g]), __float_as_uint(G[g]), false, false);
        oth[g] = __uint_as_float(rr[1]); T[g] = __uint_as_float(rr[0]) * __uint_as_float(rr[1]); }
    const float C = __builtin_amdgcn_exp2f(carry2);
    float base[4]; const float a2 = T[3], a1 = T[3] * T[2], a0 = a1 * T[1];
    base[3] = C; base[2] = C * a2; base[1] = C * a1; base[0] = C * a0;
    if (hi == 0) {
#pragma unroll
        for (int g = 0; g < 4; ++g) base[g] *= oth[g]; }
    carry2 += __builtin_amdgcn_logf(a0 * T[0]);
    float a[16];
#pragma unroll
    for (int r = 0; r < 16; ++r) a[r] = be[r] * (se[r] * base[r >> 2]);
    u32x4 pw0, pw1;
    pw0.x = cvtpk(a[0], a[1]); pw0.y = cvtpk(a[2], a[3]); pw0.z = cvtpk(a[4], a[5]); pw0.w = cvtpk(a[6], a[7]);
    pw1.x = cvtpk(a[8], a[9]); pw1.y = cvtpk(a[10], a[11]); pw1.z = cvtpk(a[12], a[13]); pw1.w = cvtpk(a[14], a[15]);
    const bf16x8 pf0 = __builtin_bit_cast(bf16x8, pw0), pf1 = __builtin_bit_cast(bf16x8, pw1);
    asm volatile("" ::: "memory");
#pragma unroll
    for (int dh = 0; dh < 2; ++dh)
#pragma unroll
        for (int s = 0; s < 2; ++s) {
            const v4i16_t lo = tr_read(vcur + troff + (16 * s) * 192 + dh * 64), h4 = tr_read(vcur + troff + (16 * s + 8) * 192 + dh * 64);
            const bf16x8 vf = (bf16x8){lo[0], lo[1], lo[2], lo[3], h4[0], h4[1], h4[2], h4[3]};
            if (dh == 0) o0 = __builtin_amdgcn_mfma_f32_32x32x16_bf16(vf, s == 0 ? pf0 : pf1, o0, 0, 0, 0);
            else o1 = __builtin_amdgcn_mfma_f32_32x32x16_bf16(vf, s == 0 ? pf0 : pf1, o1, 0, 0, 0);
        }
    asm volatile("" ::: "memory");
#pragma unroll
    for (int it = 0; it < 4; ++it) *(LAS u32x4*)(vnxt + (it * 8 + strow) * 192 + stch * 16) = vr[it];
    asm volatile("" ::: "memory");
}
__device__ __forceinline__ void attn_phase(bf16* QKV, bf16* Oout, int ldo, LAS unsigned char* lds, int wave, int lane) {
    constexpr int LD = NQKV;
    const int r32 = lane & 31, hi = lane >> 5;
    LAS unsigned char* vb = lds + wave * 12288;
    const int vcu = (gridDim.x % 8 == 0) ? (int)((blockIdx.x & 7) * (gridDim.x >> 3) + (blockIdx.x >> 3)) : (int)blockIdx.x;
    const int gw = vcu * NWAVES + wave, ngw = gridDim.x * NWAVES;
    const int troff = (4 * hi + ((lane & 15) >> 2)) * 192 + (16 * ((lane >> 4) & 1) + 4 * (lane & 3)) * 2;
    const int strow = lane >> 3, stch = lane & 7;
#define ATT_UNIT(unit_) const int bh = (unit_) >> 6, qb = ((unit_) + 8 * (bh >> 5)) & 63, h = bh & 15, b = bh >> 4;     \
        const size_t rowbase = (size_t)b * SEQ; \
        const bf16* qp = QKV + (rowbase + qb * 32 + r32) * LD + h * 64; \
        const bf16* kbase = QKV + (rowbase + r32) * LD + 1024 + h * 64 + 8 * hi; \
        const bf16* vbase = QKV + (rowbase + strow) * LD + 2048 + h * 64 + stch * 8;
#define ATT_LOAD(Q_) do { const bf16* kp = kbase + (size_t)qb * 32 * LD; const bf16* vp = vbase + (size_t)qb * 32 * LD; \
        _Pragma("unroll") for (int s = 0; s < 4; ++s) Q_[s] = *(const bf16x8*)(qp + 16 * s + 8 * hi); \
        _Pragma("unroll") for (int s = 0; s < 4; ++s) { kf[s] = *(const bf16x8*)(kp + 16 * s); vr[s] = *(const u32x4*)(vp + (size_t)s * 8 * LD); } } while (0)
    const int nunits = BATCH * 16 * 64;
    bf16x8 qr[4], kf[4]; u32x4 vr[4];
    if (gw < nunits) { ATT_UNIT(gw) ATT_LOAD(qr); }
    for (int unit = gw; unit < nunits; unit += ngw) {
        ATT_UNIT(unit)
        f32x16 o0 = {}, o1 = {};
        float carry2 = 0.f;
#pragma unroll
        for (int it = 0; it < 4; ++it) *(LAS u32x4*)(vb + (it * 8 + strow) * 192 + stch * 16) = vr[it];
        asm volatile("" ::: "memory");
        attn_tile<true>(o0, o1, carry2, qr, kf, vr, kbase + (size_t)(qb > 0 ? qb - 1 : 0) * 32 * LD, vbase + (size_t)(qb > 0 ? qb - 1 : 0) * 32 * LD, qb > 0, vb, vb + 6144, troff, strow, stch, r32, hi);
        int buf = 1;
        for (int kt = qb - 1; kt >= 0; --kt) {
            if (__all(carry2 <= -150.f)) break;
            attn_tile<false>(o0, o1, carry2, qr, kf, vr, kbase + (size_t)(kt > 0 ? kt - 1 : 0) * 32 * LD, vbase + (size_t)(kt > 0 ? kt - 1 : 0) * 32 * LD, kt > 0, vb + buf * 6144, vb + (buf ^ 1) * 6144, troff, strow, stch, r32, hi);
            buf ^= 1;
        }
        if (unit + ngw < nunits) { const int nu = unit + ngw; { ATT_UNIT(nu) ATT_LOAD(qr); } }
        bf16* op = Oout + (rowbase + qb * 32 + r32) * ldo + h * 64;
#pragma unroll
        for (int j = 0; j < 2; ++j) {
            u32x2 e0, e1, f0, f1;
            e0.x = cvtpk(o0[8 * j], o0[8 * j + 1]); e0.y = cvtpk(o0[8 * j + 2], o0[8 * j + 3]); f0.x = cvtpk(o0[8 * j + 4], o0[8 * j + 5]); f0.y = cvtpk(o0[8 * j + 6], o0[8 * j + 7]);
            e1.x = cvtpk(o1[8 * j], o1[8 * j + 1]); e1.y = cvtpk(o1[8 * j + 2], o1[8 * j + 3]); f1.x = cvtpk(o1[8 * j + 4], o1[8 * j + 5]); f1.y = cvtpk(o1[8 * j + 6], o1[8 * j + 7]);
            const auto a0 = __builtin_amdgcn_permlane32_swap(e0.x, f0.x, false, false), a1 = __builtin_amdgcn_permlane32_swap(e0.y, f0.y, false, false);
            const auto b0 = __builtin_amdgcn_permlane32_swap(e1.x, f1.x, false, false), b1 = __builtin_amdgcn_permlane32_swap(e1.y, f1.y, false, false);
            u32x4 w0, w1; w0.x = a0[0]; w0.y = a1[0]; w0.z = a0[1]; w0.w = a1[1]; w1.x = b0[0]; w1.y = b1[0]; w1.z = b0[1]; w1.w = b1[1];
            *(u32x4*)(op + 16 * j + 8 * hi) = w0; *(u32x4*)(op + 32 + 16 * j + 8 * hi) = w1;
        }
    }
#undef ATT_UNIT
#undef ATT_LOAD
}

#define XB_TMO      128
#define XB_XCNT(j)  (256  + 64 * (j))
#define XB_XSUB(j)  (1280 + 64 * (j))
#define XB_XGEN(j)  (2304 + 64 * (j))
#define XB_TOP      3328
#define XB_TOPGEN   3392
#define XCD_BAR_WORDS 3456
#define XB_SPIN_CAP (1u << 18)

__device__ __forceinline__ unsigned xb_ld(unsigned* p)              { return __hip_atomic_load(p, __ATOMIC_RELAXED, __HIP_MEMORY_SCOPE_AGENT); }
__device__ __forceinline__ unsigned xb_add(unsigned* p, unsigned v) { return __hip_atomic_fetch_add(p, v, __ATOMIC_RELAXED, __HIP_MEMORY_SCOPE_AGENT); }
__device__ __forceinline__ unsigned xb_xcc_id() { return (unsigned)__builtin_amdgcn_s_getreg((3 << 11) | 20) & 0xFu; }
#define XB_SPIN(cond, bar) do { unsigned _sp = 0; while (cond) { __builtin_amdgcn_s_sleep(1); \
    if ((++_sp & 255u) == 0u) { if (xb_ld(&(bar)[XB_TMO])) break; if (_sp > XB_SPIN_CAP) { atomicAdd(&(bar)[XB_TMO], 1u); break; } } } } while (0)

struct XcdBarrier {
    unsigned* bar; unsigned x;
    volatile LAS unsigned* st;
};

__device__ __forceinline__ XcdBarrier xcd_barrier_post(unsigned* bar, volatile LAS unsigned* st) {
    XcdBarrier b; b.bar = bar; b.x = xb_xcc_id(); b.st = st;
    if (threadIdx.x == 0) (void)xb_add(&bar[XB_XCNT(b.x)], 1u);
    return b;
}
__device__ __forceinline__ void xcd_barrier_complete(unsigned* bar, unsigned x, unsigned& nloc, unsigned& nx) {
    const unsigned G = gridDim.x * gridDim.y * gridDim.z;
    unsigned sum, cnt, mine, sp = 0u;
    for (;;) {
        sum = 0u; cnt = 0u; mine = 0u;
#pragma unroll
        for (unsigned j = 0; j < 16; ++j) { const unsigned c = xb_ld(&bar[XB_XCNT(j)]); sum += c; cnt += (c > 0u) ? 1u : 0u; mine = (j == x) ? c : mine; }
        if (sum == G) break;
        __builtin_amdgcn_s_sleep(1);
        if ((++sp & 255u) == 0u) { if (xb_ld(&bar[XB_TMO])) break; if (sp > XB_SPIN_CAP) { atomicAdd(&bar[XB_TMO], 1u); break; } }
    }
    nloc = mine > 0u ? mine : 1u; nx = cnt > 0u ? cnt : 1u;
}

__device__ __forceinline__ void xcd_barrier(const XcdBarrier& b) {
    asm volatile("s_waitcnt vmcnt(0)" ::: "memory");
    __syncthreads();
    if (threadIdx.x == 0) {
        unsigned* bar = b.bar;
        __builtin_amdgcn_s_waitcnt(0);
        unsigned nloc = b.st[0], nx = b.st[1];
        if (nloc == 0u) { xcd_barrier_complete(bar, b.x, nloc, nx); b.st[0] = nloc; b.st[1] = nx; }
        const unsigned old = xb_add(&bar[XB_XSUB(b.x)], 1u);
        const unsigned gen = old / nloc;
        if (old + 1u == (gen + 1u) * nloc) {
            __builtin_amdgcn_fence(__ATOMIC_RELEASE, "agent");
            asm volatile("s_waitcnt vmcnt(0)" ::: "memory");
            const unsigned og = xb_add(&bar[XB_TOP], 1u);
            const unsigned tg = og / nx;
            if (og + 1u == (tg + 1u) * nx) xb_add(&bar[XB_TOPGEN], 1u);
            else XB_SPIN(xb_ld(&bar[XB_TOPGEN]) == tg, bar);
            __builtin_amdgcn_fence(__ATOMIC_ACQUIRE, "agent");
            xb_add(&bar[XB_XGEN(b.x)], 1u);
            asm volatile("s_waitcnt vmcnt(0)" ::: "memory");
        } else {
            XB_SPIN(xb_ld(&bar[XB_XGEN(b.x)]) == gen, bar);
            __builtin_amdgcn_fence(__ATOMIC_ACQUIRE, "agent");
            asm volatile("s_waitcnt vmcnt(0)" ::: "memory");
        }
    }
    __syncthreads();
}

struct Params { const float* in[15]; float* out; unsigned char* ws; };

__global__ void __launch_bounds__(NWAVES * 64, 2) fwd_kernel(Params p) {
    extern __shared__ __attribute__((aligned(16))) unsigned char lds_raw[];
    cg::grid_group grid = cg::this_grid();
    LAS unsigned char* lds = (LAS unsigned char*)lds_raw;
    unsigned char* ws = p.ws;
    const float* x = p.in[0]; const float* n_mix_pre = p.in[1]; const float* n_mix_post = p.in[2]; const float* n_ffn_pre = p.in[3]; const float* n_ffn_post = p.in[4];
    const float* a_v_g = p.in[6]; const float* a_v_b = p.in[7]; const float* a_w_s = p.in[8]; const float* a_b_s = p.in[9];
    bf16* Win_t = (bf16*)(ws + WS_WIN); bf16* Wouta_t = (bf16*)(ws + WS_WOUTA); bf16* Wqkv_t = (bf16*)(ws + WS_WQKV); bf16* Wob_t = (bf16*)(ws + WS_WOB);
    bf16* W1_t = (bf16*)(ws + WS_W1); bf16* W2_t = (bf16*)(ws + WS_W2); bf16* Wc = (bf16*)(ws + WS_WC);
    bf16* XB = (bf16*)(ws + WS_HN); bf16* Z = (bf16*)(ws + WS_Z); float* STAT = (float*)(ws + WS_STAT);
    float* XCH = (float*)(ws + WS_XCH); float* XCH2 = (float*)(ws + WS_XCH2); float* XSTAT = (float*)(ws + WS_XSTAT); unsigned* CNT = (unsigned*)(ws + WS_CNT);
    float* out = p.out;
    unsigned* barw = (unsigned*)(ws + WS_BAR);
    volatile LAS unsigned* bst = (volatile LAS unsigned*)(lds + LDS_BST);
    if (threadIdx.x == 0) { bst[0] = 0u; bst[1] = 0u; }
    if (blockIdx.x == 0) for (int i = threadIdx.x; i < XCD_BAR_WORDS; i += NWAVES * 64) __hip_atomic_store(barw + i, 0u, __ATOMIC_RELAXED, __HIP_MEMORY_SCOPE_AGENT);
    __syncthreads();

    {
        const int tid = threadIdx.x, lane = tid & 63, wave = __builtin_amdgcn_readfirstlane(tid >> 6);
        const int gw = blockIdx.x * NWAVES + wave, ngw = gridDim.x * NWAVES;
        for (int i = blockIdx.x * 512 + tid; i < 16 * 256 * 64; i += gridDim.x * 512) __hip_atomic_store(CNT + i, 0u, __ATOMIC_RELAXED, __HIP_MEMORY_SCOPE_AGENT);
        LAS float* scr = (LAS float*)(lds + wave * 16384);
        if (ngw >= 2048) {
            float ra[32], rb[32];
#define TRM_W(m)  ((m) < 8 ? (((m) & 3) == 0 ? p.in[5] + (size_t)((m) >> 2) * 1024 * 4096 : ((m) & 3) == 1 ? p.in[10] + (size_t)((m) >> 2) * 2048 * 1024 : ((m) & 3) == 2 ? p.in[11] + (size_t)((m) >> 2) * 1024 * 3072 : p.in[12] + (size_t)((m) >> 2) * 1024 * 1024) \
                           : (m) < 12 ? p.in[13] + (size_t)((m) - 8) * 1024 * 4096 : p.in[14] + (size_t)((m) - 12) * 4096 * 1024)
#define TRM_K(m)  ((m) < 8 ? (((m) & 3) == 1 ? 2048 : 1024) : (m) < 12 ? 1024 : 4096)
#define TRM_N(m)  ((m) < 8 ? (((m) & 3) == 0 ? 4096 : ((m) & 3) == 1 ? 1024 : ((m) & 3) == 2 ? 3072 : 1024) : (m) < 12 ? 4096 : 1024)
#define TRM_G(m)  ((m) < 8 ? (((m) & 3) == 0 ? n_mix_pre + (2 * ((m) >> 2)) * 1024 : ((m) & 3) == 2 ? n_mix_pre + (2 * ((m) >> 2) + 1) * 1024 : (const float*)nullptr) : (m) < 12 ? n_ffn_pre + ((m) - 8) * 1024 : (const float*)nullptr)
#define TRM_T(m)  ((m) < 8 ? (((m) & 3) == 0 ? Win_t + (size_t)((m) >> 2) * 4096 * 1024 : ((m) & 3) == 1 ? Wouta_t + (size_t)((m) >> 2) * 1024 * 2048 : ((m) & 3) == 2 ? Wqkv_t + (size_t)((m) >> 2) * 3072 * 1024 : Wob_t + (size_t)((m) >> 2) * 1024 * 1024) \
                           : (m) < 12 ? W1_t + (size_t)((m) - 8) * 4096 * 1024 : W2_t + (size_t)((m) - 12) * 1024 * 4096)
#define TRM_HAS(m) (gw < (TRM_K(m) / 64) * (TRM_N(m) / 32))
            if (TRM_HAS(0)) tr_load(ra, TRM_W(0), TRM_N(0), gw, lane);
#pragma unroll
            for (int m = 0; m < 16; m += 2) {
                if (TRM_HAS(m + 1)) tr_load(rb, TRM_W(m + 1), TRM_N(m + 1), gw, lane);
                if (TRM_HAS(m)) tr_finish(ra, TRM_G(m), TRM_K(m), TRM_N(m), TRM_T(m), scr, gw, lane);
                if (m + 2 < 16) { if (TRM_HAS(m + 2)) tr_load(ra, TRM_W(m + 2), TRM_N(m + 2), gw, lane); }
                if (TRM_HAS(m + 1)) tr_finish(rb, TRM_G(m + 1), TRM_K(m + 1), TRM_N(m + 1), TRM_T(m + 1), scr, gw, lane);
            }
#undef TRM_W
#undef TRM_K
#undef TRM_N
#undef TRM_G
#undef TRM_T
#undef TRM_HAS
        } else {
        for (int l = 0; l < 2; ++l) {
            transpose_matrix(p.in[5] + (size_t)l * 1024 * 4096, n_mix_pre + (2 * l) * 1024, 1024, 4096, Win_t + (size_t)l * 4096 * 1024, scr, gw, ngw, lane);
            transpose_matrix(p.in[10] + (size_t)l * 2048 * 1024, nullptr, 2048, 1024, Wouta_t + (size_t)l * 1024 * 2048, scr, gw, ngw, lane);
            transpose_matrix(p.in[11] + (size_t)l * 1024 * 3072, n_mix_pre + (2 * l + 1) * 1024, 1024, 3072, Wqkv_t + (size_t)l * 3072 * 1024, scr, gw, ngw, lane);
            transpose_matrix(p.in[12] + (size_t)l * 1024 * 1024, nullptr, 1024, 1024, Wob_t + (size_t)l * 1024 * 1024, scr, gw, ngw, lane);
        }
        for (int l = 0; l < 4; ++l) {
            transpose_matrix(p.in[13] + (size_t)l * 1024 * 4096, n_ffn_pre + l * 1024, 1024, 4096, W1_t + (size_t)l * 4096 * 1024, scr, gw, ngw, lane);
            transpose_matrix(p.in[14] + (size_t)l * 4096 * 1024, nullptr, 4096, 1024, W2_t + (size_t)l * 1024 * 4096, scr, gw, ngw, lane);
        }
        }
        for (int i = blockIdx.x * 512 + tid; i < 2 * 8 * 128 * 128; i += gridDim.x * 512) { const int s = i & 127, t = (i >> 7) & 127; Wc[i] = (s <= t) ? (bf16)(cvtpk(a_w_s[i], 0.f) & 0xffffu) : (bf16)0; }
        x_to_bf16(x, XB, XSTAT, wave, lane);
    }
    grid.sync();
    const XcdBarrier xbar = xcd_barrier_post(barw, bst);

#pragma unroll 1
    for (int ph = 0; ph < 20; ++ph) {
        const int layer = ph / 5, step = ph % 5, j = layer >> 1; const bool even = (layer & 1) == 0;
        int tid = threadIdx.x; asm volatile("" : "+v"(tid));
        const int lane = tid & 63, wave = __builtin_amdgcn_readfirstlane(tid >> 6);
        if (step == 0 || step == 3) {
            pg8::Gemm g; EpiAct E; E.stat = STAT; E.rowstat = XSTAT; g.A = XB; g.lda = 1024; g.K = 1024; g.M = MTOK; E.O = Z;
            if (step == 0) { g.N = even ? 4096 : 3072; g.Bt = even ? Win_t + (size_t)j * 4096 * 1024 : Wqkv_t + (size_t)j * 3072 * 1024; E.ldc = g.N; E.act = even ? 1 : 3; }
            else { g.N = 4096; g.Bt = W1_t + (size_t)layer * 4096 * 1024; E.ldc = 4096; E.act = 2; }
            pg8::StaticOrder S; S.init(g.M, g.N, (int)gridDim.x, (int)blockIdx.x);
            pg8::gemm_phase<EpiAct, pg8::StaticOrder, true, true>(lds, g, S, E);
        } else if (step == 2 || step == 4) {
            pg8::Gemm g; EpiRes E; g.A = Z; g.M = MTOK; g.N = 1024;
            if (step == 2) { g.lda = even ? 4096 : 3072; g.K = even ? 2048 : 1024; g.Bt = even ? Wouta_t + (size_t)j * 1024 * 2048 : Wob_t + (size_t)j * 1024 * 1024; }
            else { g.lda = 4096; g.K = 4096; g.Bt = W2_t + (size_t)layer * 1024 * 4096; }
            const int bank = layer * 2 + (step == 4 ? 1 : 0);
            E.XB = XB; E.outf = (ph == 19) ? out : nullptr; E.xch = XCH; E.xch2 = XCH2; E.cnt = CNT + (size_t)bank * 256 * 64; E.cnt2 = CNT + (size_t)(8 + bank) * 256 * 64; E.rs = XSTAT; E.lds = lds;
            pg8::StaticOrder S; S.init(g.M, g.N, (int)gridDim.x, (int)blockIdx.x);
            pg8::gemm_phase<EpiRes, pg8::StaticOrder, true, true>(lds, g, S, E);
        } else {
#if PROBE_MIX
            if (even) { mix_phase(Z, (bf16*)(ws + 900 * MiB), 2048, STAT, a_v_g + (size_t)j * 2048, a_v_b + (size_t)j * 2048, Wc + (size_t)j * 8 * 128 * 128, a_b_s + (size_t)j * 8 * 128, lds, tid, wave, lane); __syncthreads(); }
#endif
#if PROBE_ATTN
            if (!even) attn_phase(Z, (bf16*)(ws + 900 * MiB), 1024, lds, wave, lane);
#endif
            if (even) mix_phase(Z, Z, 4096, STAT, a_v_g + (size_t)j * 2048, a_v_b + (size_t)j * 2048, Wc + (size_t)j * 8 * 128 * 128, a_b_s + (size_t)j * 8 * 128, lds, tid, wave, lane);
            else attn_phase(Z, Z, NQKV, lds, wave, lane);
        }
        if (step == 1 || step == 3) {
            const float* gsrc = (step == 1 ? n_mix_post : n_ffn_post) + layer * 1024;
            for (int i = tid; i < 1024; i += NWAVES * 64) ((LAS float*)(lds + LDS_G))[i] = gsrc[i];
        }
        if (ph != 19) xcd_barrier(xbar);
    }
}

extern "C" void kernel_launch(void* const* d_in, const int* in_sizes, int n_in, void* d_out, int out_size, void* d_ws, size_t ws_size, hipStream_t stream) {
    static int grid = 0;
    if (grid == 0) {
        if (n_in != 15 || out_size != MTOK * D_MODEL || ws_size < WS_END) { fprintf(stderr, "kernel_launch: unexpected sizes (n_in %d out %d ws %zu)\n", n_in, out_size, ws_size); grid = -1; return; }
        int dev = 0, cus = 0, per_cu = 0;
        hipGetDevice(&dev); hipDeviceGetAttribute(&cus, hipDeviceAttributeMultiprocessorCount, dev);
        if (hipFuncSetAttribute((const void*)fwd_kernel, hipFuncAttributeMaxDynamicSharedMemorySize, LDS_BYTES) != hipSuccess) fprintf(stderr, "kernel_launch: hipFuncSetAttribute failed\n");
        if (hipOccupancyMaxActiveBlocksPerMultiprocessor(&per_cu, (const void*)fwd_kernel, NWAVES * 64, LDS_BYTES) != hipSuccess || per_cu < 1) { fprintf(stderr, "kernel_launch: occupancy query gave %d\n", per_cu); per_cu = 1; }
        (void)hipGetLastError();
        grid = cus * per_cu;
    }
    if (grid < 0) return;
    Params p{};
    for (int i = 0; i < 15; ++i) p.in[i] = (const float*)d_in[i];
    p.out = (float*)d_out; p.ws = (unsigned char*)d_ws;
    void* args[] = {&p};
    hipError_t e = hipLaunchCooperativeKernel((const void*)fwd_kernel, dim3(grid), dim3(NWAVES * 64), args, LDS_BYTES, stream);
    if (e != hipSuccess) fprintf(stderr, "kernel_launch: cooperative launch failed: %s (grid %d)\n", hipGetErrorString(e), grid);
}
```
